# Optimizing an MI355X kernel written in HIP

```python
import math
import jax, jax.numpy as jnp
from jax import lax
import numpy as np

D_MODEL = 1024
BATCH = 4
SEQ = 4096
DEPTH = 1
DEC_BATCH = 16
DEC_SEQ = 16
PAST_LEN = 2048

CHUNK = 64
GLA_HEADS = 4
GLA_DK = 128
GLA_DV = 256
GLA_RANK = 16
GLA_TAU = 16.0
SWA_HEADS = 16
SWA_KV_HEADS = 4
SWA_HD = 64
SWA_GROUP = SWA_HEADS // SWA_KV_HEADS
WINDOW = 128
WIN_CHUNKS = WINDOW // CHUNK
SWA_KEYS = (WIN_CHUNKS + 1) * CHUNK
N_BUCKETS = 32
MAX_DISTANCE = 128
D_FF = 2816
EPS = 1e-6

GLA_QK = GLA_HEADS * GLA_DK
GLA_V = GLA_HEADS * GLA_DV
SWA_Q = SWA_HEADS * SWA_HD
SWA_KV = SWA_KV_HEADS * SWA_HD
IN_SPLITS = (GLA_QK, GLA_QK, GLA_V, GLA_V, GLA_RANK, SWA_Q, SWA_KV, SWA_KV, D_MODEL, D_MODEL)
IN_WIDTH = 2 * GLA_QK + 2 * GLA_V + GLA_RANK + SWA_Q + 2 * SWA_KV + 2 * D_MODEL

kernel_name = "hybrid_gla_swa_macaron_stream_step"


def rms_norm(x, g):
    xf = x.astype(jnp.float32)
    y = xf * lax.rsqrt(jnp.mean(xf * xf, axis=-1, keepdims=True) + EPS)
    return (y * g.astype(jnp.float32)).astype(x.dtype)


def swiglu_ffn(x, w_up, w_down):
    a, b = jnp.split(x @ w_up, 2, axis=-1)
    return (jax.nn.silu(a) * b) @ w_down


def t5_bucket(rel):
    nb = N_BUCKETS // 2
    ret = jnp.where(rel > 0, nb, 0)
    n = jnp.abs(rel)
    max_exact = nb // 2
    nf = jnp.maximum(n, 1).astype(jnp.float32)
    large = max_exact + (jnp.log(nf / max_exact) / math.log(MAX_DISTANCE / max_exact)
                         * (nb - max_exact)).astype(jnp.int32)
    large = jnp.minimum(large, nb - 1)
    return ret + jnp.where(n < max_exact, n, large)


def rel_pos_bias(rel_bias, qpos, kpos):
    bucket = t5_bucket(kpos[None, :] - qpos[:, None])
    b = jnp.transpose(rel_bias[bucket], (2, 0, 1)).astype(jnp.float32)
    return b.reshape(SWA_KV_HEADS, SWA_GROUP, qpos.shape[0], kpos.shape[0])


def window_mask(qpos, kpos):
    qc = (qpos // CHUNK)[..., :, None]
    kc = (kpos // CHUNK)[..., None, :]
    return (kpos[..., None, :] >= 0) & (kc <= qc) & (kc >= qc - WIN_CHUNKS)


def sink_attention(q, k, v, bias, sinks, mask):
    qg = q.reshape(q.shape[:-2] + (SWA_KV_HEADS, SWA_GROUP, SWA_HD))
    s = jnp.einsum('...qkgd,...skd->...kgqs', qg, k).astype(jnp.float32) * (SWA_HD ** -0.5) + bias
    s = jnp.where(mask, s, -jnp.inf)
    sink = sinks.astype(jnp.float32).reshape(SWA_KV_HEADS, SWA_GROUP, 1, 1)
    m = jnp.maximum(jnp.max(s, axis=-1, keepdims=True), sink)
    p = jnp.exp(s - m)
    probs = p / (jnp.sum(p, axis=-1, keepdims=True) + jnp.exp(sink - m))
    out = jnp.einsum('...kgqs,...skd->...qkgd', probs.astype(v.dtype), v)
    return out.reshape(out.shape[:-3] + (SWA_Q,))


def gla_chunk(S, q, k, v, g):
    L = q.shape[1]
    b = jnp.cumsum(g, axis=1)
    inter = jnp.einsum('blhk,bhkv->blhv', q * jnp.exp(b), S)
    causal = jnp.tril(jnp.ones((L, L), dtype=bool))[None, :, :, None, None]
    diff = b[:, :, None] - b[:, None, :]
    decay = jnp.exp(jnp.where(causal, diff, -jnp.inf))
    A = jnp.einsum('bthk,bshk,btshk->btsh', q, k, decay)
    intra = jnp.einsum('btsh,bshv->bthv', A, v)
    b_last = b[:, -1]
    k_dec = k * jnp.exp(b_last[:, None] - b)
    S_new = jnp.exp(b_last)[..., None] * S + jnp.einsum('bshk,bshv->bhkv', k_dec, v)
    return S_new, inter + intra


def mixer_project(h, w_in, gla_w_alpha, gla_b_alpha, q_norm, k_norm):
    lead = h.shape[:-1]
    offs = np.cumsum(IN_SPLITS)[:-1].tolist()
    gq, gk, gv, gr, ga, sq, sk, sv, gate_a, gate_b = jnp.split(h @ w_in, offs, axis=-1)
    f32 = jnp.float32
    q = gq.astype(f32).reshape(lead + (GLA_HEADS, GLA_DK)) * (GLA_DK ** -0.5)
    k = gk.astype(f32).reshape(lead + (GLA_HEADS, GLA_DK))
    v = gv.astype(f32).reshape(lead + (GLA_HEADS, GLA_DV))
    la = (jax.nn.log_sigmoid((ga @ gla_w_alpha + gla_b_alpha).astype(f32)) / GLA_TAU)
    la = la.reshape(lead + (GLA_HEADS, GLA_DK))
    sq = rms_norm(sq.reshape(lead + (SWA_HEADS, SWA_HD)), q_norm)
    sk = rms_norm(sk.reshape(lead + (SWA_KV_HEADS, SWA_HD)), k_norm)
    sv = sv.reshape(lead + (SWA_KV_HEADS, SWA_HD))
    return q, k, v, la, gr, sq, sk, sv, gate_a, gate_b


def mixer_merge(o_gla, gr, o_swa, gate_a, gate_b, gla_head_norm, w_branch, w_out):
    lead = o_swa.shape[:-1]
    o = rms_norm(o_gla, gla_head_norm).reshape(lead + (GLA_V,))
    o = (o * jax.nn.silu(gr.astype(jnp.float32))).astype(o_swa.dtype)
    y_a = o @ w_branch[:GLA_V]
    y_b = o_swa @ w_branch[GLA_V:]
    m = jax.nn.sigmoid(gate_a) * y_a + jax.nn.sigmoid(gate_b) * y_b
    return m @ w_out


def setup_inputs(seed: int = 0) -> dict:
    key = jax.random.key(seed)
    ks = jax.random.split(key, 24)
    f32 = jnp.float32

    def nrm(k, shape, scale):
        return jax.random.normal(k, shape, f32) * scale

    n_cache = min(WINDOW, PAST_LEN)
    return {
        "x_prompt": nrm(ks[0], (BATCH, SEQ, D_MODEL), 1.0),
        "x_sample": nrm(ks[1], (DEC_BATCH, DEC_SEQ, D_MODEL), 1.0),
        "cache_swa_k": nrm(ks[2], (DEPTH, DEC_BATCH, n_cache, SWA_KV_HEADS, SWA_HD), 1.0),
        "cache_swa_v": nrm(ks[3], (DEPTH, DEC_BATCH, n_cache, SWA_KV_HEADS, SWA_HD), 1.0),
        "state_gla": nrm(ks[4], (DEPTH, DEC_BATCH, GLA_HEADS, GLA_DK, GLA_DV), 0.5),
        "ffn1_norm": 1.0 + nrm(ks[5], (DEPTH, D_MODEL), 0.02),
        "ffn1_w_up": nrm(ks[6], (DEPTH, D_MODEL, 2 * D_FF), D_MODEL ** -0.5),
        "ffn1_w_down": nrm(ks[7], (DEPTH, D_FF, D_MODEL), D_FF ** -0.5),
        "mix_norm": 1.0 + nrm(ks[8], (DEPTH, D_MODEL), 0.02),
        "w_in": nrm(ks[9], (DEPTH, D_MODEL, IN_WIDTH), D_MODEL ** -0.5),
        "gla_w_alpha": nrm(ks[10], (DEPTH, GLA_RANK, GLA_QK), GLA_RANK ** -0.5),
        "gla_b_alpha": nrm(ks[11], (DEPTH, GLA_QK), 0.1),
        "gla_head_norm": 1.0 + nrm(ks[12], (DEPTH, GLA_DV), 0.02),
        "q_norm": 1.0 + nrm(ks[13], (DEPTH, SWA_HD), 0.02),
        "k_norm": 1.0 + nrm(ks[14], (DEPTH, SWA_HD), 0.02),
        "attn_sinks": nrm(ks[15], (DEPTH, SWA_HEADS), 0.5),
        "rel_bias": nrm(ks[16], (N_BUCKETS, SWA_HEADS), 0.1),
        "w_branch": nrm(ks[17], (DEPTH, GLA_V + SWA_Q, D_MODEL), GLA_V ** -0.5),
        "w_out": nrm(ks[18], (DEPTH, D_MODEL, D_MODEL), D_MODEL ** -0.5),
        "ffn2_norm": 1.0 + nrm(ks[19], (DEPTH, D_MODEL), 0.02),
        "ffn2_w_up": nrm(ks[20], (DEPTH, D_MODEL, 2 * D_FF), D_MODEL ** -0.5),
        "ffn2_w_down": nrm(ks[21], (DEPTH, D_FF, D_MODEL), D_FF ** -0.5),
        "final_norm": 1.0 + nrm(ks[22], (DEPTH, D_MODEL), 0.02),
    }


def reference(x_prompt, x_sample, cache_swa_k, cache_swa_v, state_gla,
              ffn1_norm, ffn1_w_up, ffn1_w_down, mix_norm, w_in, gla_w_alpha, gla_b_alpha,
              gla_head_norm, q_norm, k_norm, attn_sinks, rel_bias, w_branch, w_out,
              ffn2_norm, ffn2_w_up, ffn2_w_down, final_norm):
    B, S, _ = x_prompt.shape
    NC = S // CHUNK
    DB, L, _ = x_sample.shape
    n_cache = cache_swa_k.shape[2]

    q_loc = jnp.arange(CHUNK)
    k_loc = jnp.arange(SWA_KEYS) - WIN_CHUNKS * CHUNK
    blk = jnp.arange(NC)[:, None] * CHUNK
    mask_p = window_mask(blk + q_loc[None], blk + k_loc[None])[None, :, None, None]
    bias_p = rel_pos_bias(rel_bias, q_loc, k_loc)
    qpos_s = PAST_LEN + jnp.arange(L)
    kpos_s = jnp.concatenate([PAST_LEN - n_cache + jnp.arange(n_cache), qpos_s])
    mask_s = window_mask(qpos_s, kpos_s)
    bias_s = rel_pos_bias(rel_bias, qpos_s, kpos_s)

    def to_chunks(t):
        return jnp.moveaxis(t.reshape((B, NC, CHUNK) + t.shape[2:]), 1, 0)

    def gla_body(state, inp):
        return gla_chunk(state, *inp)

    xp, xs = x_prompt, x_sample
    kp_l, vp_l, sp_l, ks_l, vs_l, ss_l = [], [], [], [], [], []
    for l in range(DEPTH):
        xp = xp + 0.5 * swiglu_ffn(rms_norm(xp, ffn1_norm[l]), ffn1_w_up[l], ffn1_w_down[l])
        xs = xs + 0.5 * swiglu_ffn(rms_norm(xs, ffn1_norm[l]), ffn1_w_up[l], ffn1_w_down[l])

        q, k, v, la, gr, sq, sk, sv, ga, gb = mixer_project(
            rms_norm(xp, mix_norm[l]), w_in[l], gla_w_alpha[l], gla_b_alpha[l], q_norm[l], k_norm[l])
        S0 = jnp.zeros((B, GLA_HEADS, GLA_DK, GLA_DV), jnp.float32)
        S_fin, o_ch = lax.scan(gla_body, S0, (to_chunks(q), to_chunks(k), to_chunks(v), to_chunks(la)))
        o_gla = jnp.moveaxis(o_ch, 0, 1).reshape(B, S, GLA_HEADS, GLA_DV)
        qb = sq.reshape(B, NC, CHUNK, SWA_HEADS, SWA_HD)
        pad = jnp.zeros((B, WIN_CHUNKS, CHUNK, SWA_KV_HEADS, SWA_HD), sk.dtype)
        kpad = jnp.concatenate([pad, sk.reshape(B, NC, CHUNK, SWA_KV_HEADS, SWA_HD)], axis=1)
        vpad = jnp.concatenate([pad, sv.reshape(B, NC, CHUNK, SWA_KV_HEADS, SWA_HD)], axis=1)
        kb = jnp.concatenate([kpad[:, i:i + NC] for i in range(WIN_CHUNKS + 1)], axis=2)
        vb = jnp.concatenate([vpad[:, i:i + NC] for i in range(WIN_CHUNKS + 1)], axis=2)
        o_swa = sink_attention(qb, kb, vb, bias_p, attn_sinks[l], mask_p).reshape(B, S, SWA_Q)
        xp = xp + mixer_merge(o_gla, gr, o_swa, ga, gb, gla_head_norm[l], w_branch[l], w_out[l])
        n_keep = min(WINDOW, S)
        kp_l.append(sk[:, S - n_keep:])
        vp_l.append(sv[:, S - n_keep:])
        sp_l.append(S_fin.astype(state_gla.dtype))

        q, k, v, la, gr, sq, sk, sv, ga, gb = mixer_project(
            rms_norm(xs, mix_norm[l]), w_in[l], gla_w_alpha[l], gla_b_alpha[l], q_norm[l], k_norm[l])
        S_new, o_gla = gla_chunk(state_gla[l].astype(jnp.float32), q, k, v, la)
        k_all = jnp.concatenate([cache_swa_k[l].astype(sk.dtype), sk], axis=1)
        v_all = jnp.concatenate([cache_swa_v[l].astype(sv.dtype), sv], axis=1)
        o_swa = sink_attention(sq, k_all, v_all, bias_s, attn_sinks[l], mask_s)
        xs = xs + mixer_merge(o_gla, gr, o_swa, ga, gb, gla_head_norm[l], w_branch[l], w_out[l])
        ks_l.append(sk)
        vs_l.append(sv)
        ss_l.append(S_new.astype(state_gla.dtype))

        xp = xp + 0.5 * swiglu_ffn(rms_norm(xp, ffn2_norm[l]), ffn2_w_up[l], ffn2_w_down[l])
        xs = xs + 0.5 * swiglu_ffn(rms_norm(xs, ffn2_norm[l]), ffn2_w_up[l], ffn2_w_down[l])
        xp = rms_norm(xp, final_norm[l])
        xs = rms_norm(xs, final_norm[l])

    y_prompt = xp
    y_sample = xs
    new_k_prompt = jnp.stack(kp_l)
    new_v_prompt = jnp.stack(vp_l)
    new_gla_prompt = jnp.stack(sp_l)
    new_k_sample = jnp.stack(ks_l)
    new_v_sample = jnp.stack(vs_l)
    new_gla_sample = jnp.stack(ss_l)
    return (y_prompt, y_sample, new_k_prompt, new_v_prompt, new_gla_prompt, new_k_sample, new_v_sample, new_gla_sample)
```

```cpp
#include <hip/hip_runtime.h>
#include <cstdio>
#include <cstdint>

#define LAS __attribute__((address_space(3)))
typedef unsigned short bf16_t;
typedef short bf16x8 __attribute__((ext_vector_type(8)));
typedef short s16x4 __attribute__((ext_vector_type(4)));
typedef float f32x4 __attribute__((ext_vector_type(4)));
typedef float f32x16 __attribute__((ext_vector_type(16)));
typedef unsigned u32x4 __attribute__((ext_vector_type(4)));
typedef unsigned u32x2 __attribute__((ext_vector_type(2)));
typedef float f32x2_t __attribute__((ext_vector_type(2)));
typedef __bf16 bf16x2_t __attribute__((ext_vector_type(2)));

constexpr int D = 1024, SEQ = 4096, NBATCH = 4, MP = NBATCH * SEQ, DBATCH = 16, DSEQ = 16, MS = DBATCH * DSEQ, M = MP + MS;
constexpr int FF = 2816, NUP = 2 * FF, NIN_V = 27 * 256;
constexpr int NCACHE = 128;
constexpr float EPS = 1e-6f;
constexpr float LOG2E = 1.4426950408889634f;

constexpr size_t MiB = 1u << 20;
constexpr size_t WS_CTL = 0, CTL_ZERO_BYTES = 64 * 1024;
constexpr size_t SSQ_BYTES = (size_t)M * 16 * 4;
constexpr size_t WS_SSQ = 65536, SSQ_STRIDE = SSQ_BYTES;
constexpr size_t WS_GA = WS_SSQ + 4 * SSQ_STRIDE;
constexpr size_t WS_DV = WS_GA + SSQ_BYTES;
constexpr size_t WS_XA = 5 * MiB + 512 * 1024;
constexpr size_t WS_QK = WS_XA + (size_t)M * 1024 * 2;
constexpr size_t WS_V = WS_QK + (size_t)M * 1024 * 2;
constexpr size_t WS_G = WS_V + (size_t)M * 1024 * 2;
constexpr size_t WS_AB = WS_G + (size_t)M * 2048 * 2;
constexpr size_t WS_SKV = WS_AB + (size_t)M * 2048 * 2;
constexpr size_t WS_WDN2 = WS_SKV + (size_t)M * 512 * 2;
constexpr size_t WS_END = WS_WDN2 + (size_t)1024 * FF * 2;
constexpr size_t WS_H = WS_V;
static_assert(WS_DV + 240 * 128 * 4 <= WS_XA && WS_XA + (size_t)M * 1024 * 2 <= WS_QK && WS_END <= 256 * MiB && (WS_GA % 16) == 0 && (WS_DV % 16) == 0 && (WS_WDN2 % 256) == 0, "ws map");
static_assert(WS_H + (size_t)M * FF * 2 <= WS_AB, "hidden overlay");
constexpr size_t OUT_Y = 0, OUT_KP = (size_t)M * D, OUT_VP = OUT_KP + 131072, OUT_GP = OUT_VP + 131072, OUT_KS = OUT_GP + 524288, OUT_VS = OUT_KS + 65536, OUT_GS = OUT_VS + 65536;
constexpr size_t OW_UP1 = 0, OW_DN1 = 11 * MiB, OW_IN = OW_DN1 + 5 * MiB + 512 * 1024, OW_BR = 30 * MiB, OW_OUT = 34 * MiB, OW_UP2 = 36 * MiB, OW_DN2 = 47 * MiB;
constexpr size_t O_DS = 0;
static_assert(OW_IN + (size_t)NIN_V * 1024 * 2 <= OW_BR && OW_DN2 + (size_t)1024 * FF * 2 <= (size_t)M * D * 4 && 240ull * 32768 * 4 <= OW_BR, "out map");

__device__ __forceinline__ unsigned cvtpk(float lo, float hi) { f32x2_t v = {lo, hi}; bf16x2_t b = __builtin_convertvector(v, bf16x2_t); return __builtin_bit_cast(unsigned, b); }
__device__ __forceinline__ float bf2f(unsigned short x) { return __uint_as_float((unsigned)x << 16); }
__device__ __forceinline__ float bflo(unsigned w) { return __uint_as_float(w << 16); }
__device__ __forceinline__ float bfhi(unsigned w) { return __uint_as_float(w & 0xffff0000u); }
__device__ __forceinline__ unsigned short f2bf(float f) { return (unsigned short)(cvtpk(f, 0.f) & 0xffffu); }
__device__ __forceinline__ float fast_exp(float x) { return __builtin_amdgcn_exp2f(x * LOG2E); }
__device__ __forceinline__ float sigmoidf_(float x) { return __builtin_amdgcn_rcpf(1.f + fast_exp(-x)); }
__device__ __forceinline__ float siluf_(float x) { return x * sigmoidf_(x); }
__device__ __forceinline__ int crow(int r, int hi) { return (r & 3) + 8 * (r >> 2) + 4 * hi; }
#if defined(__HIP_DEVICE_COMPILE__)
template <class T> __device__ __forceinline__ LAS T* opq(LAS T* p) { unsigned a = __builtin_bit_cast(unsigned, p); asm volatile("" : "+v"(a)); return __builtin_bit_cast(LAS T*, a); }
template <class T> __device__ __forceinline__ LAS T* opq_after(LAS T* p, float dep) { unsigned a = __builtin_bit_cast(unsigned, p); asm volatile("" : "+v"(a) : "v"(dep)); return __builtin_bit_cast(LAS T*, a); }
#else
template <class T> __device__ __forceinline__ LAS T* opq(LAS T* p) { return p; }
template <class T> __device__ __forceinline__ LAS T* opq_after(LAS T* p, float) { return p; }
#endif
#define LDS_WAIT() asm volatile("s_waitcnt lgkmcnt(0)" ::: "memory")
#define VM_WAIT() asm volatile("s_waitcnt vmcnt(0)" ::: "memory")
#define MFMA32(a, b, c) __builtin_amdgcn_mfma_f32_32x32x16_bf16((a), (b), (c), 0, 0, 0)

__device__ __forceinline__ float row_rstd(const float* ssq, int row) {
    const f32x4* p = (const f32x4*)(ssq + (size_t)row * 16);
    const f32x4 a = p[0], b = p[1], c = p[2], d = p[3];
    const float s = ((a[0] + a[1]) + (a[2] + a[3])) + ((b[0] + b[1]) + (b[2] + b[3])) + ((c[0] + c[1]) + (c[2] + c[3])) + ((d[0] + d[1]) + (d[2] + d[3]));
    return __builtin_amdgcn_rsqf(s * (1.0f / D) + EPS);
}


#define XC_SPIN_CAP (1u << 22)
__device__ __forceinline__ void xchg_rstd(float mine, LAS float* S, int nrows, float* slots, int myslot, int nslots, unsigned* cnt, unsigned need) {
    const int tid = threadIdx.x;
    if (tid < nrows) __hip_atomic_store((unsigned*)(slots + (size_t)tid * 16 + myslot), __float_as_uint(mine), __ATOMIC_RELAXED, __HIP_MEMORY_SCOPE_AGENT);
    asm volatile("s_waitcnt vmcnt(0)" ::: "memory");
    __syncthreads();
    if (tid < 64) {
        if (tid == 0) (void)__hip_atomic_fetch_add(cnt, 1u, __ATOMIC_RELAXED, __HIP_MEMORY_SCOPE_AGENT);
        unsigned sp = 0;
        while ((unsigned)__builtin_amdgcn_readfirstlane(__hip_atomic_load(cnt, __ATOMIC_RELAXED, __HIP_MEMORY_SCOPE_AGENT)) < need) { __builtin_amdgcn_s_sleep(2); if (++sp > XC_SPIN_CAP) break; }
        __builtin_amdgcn_fence(__ATOMIC_ACQUIRE, "agent");
        asm volatile("s_waitcnt vmcnt(0)" ::: "memory");
    }
    __syncthreads();
    if (tid < nrows) {
        float t = 0.f;
        for (int j = 0; j < nslots; ++j) t += __uint_as_float(__hip_atomic_load((unsigned*)(slots + (size_t)tid * 16 + j), __ATOMIC_RELAXED, __HIP_MEMORY_SCOPE_AGENT));
        S[tid] = __builtin_amdgcn_rsqf(t * (1.0f / D) + EPS);
    }
    __syncthreads();
}

namespace pg8 {
constexpr int BM = 256, BK = 64, HALF = 128, HTB = HALF * BK * 2, STAGE_BYTES = 8 * HTB, NXCD = 8, WGM = 4;
__host__ __device__ __forceinline__ int lds_byte(int r, int c) { const int st = (r >> 4) * 2 + (c >> 5), rr = r & 15, cc = c & 31, ob = rr * 64 + cc * 2; return st * 1024 + (ob ^ (((ob >> 9) & 1) << 5)); }
__host__ __device__ __forceinline__ void stage_rc(int b, int& R, int& C) { const int st = b / 1024, sb = b % 1024, swz = sb ^ (((sb >> 9) & 1) << 5); R = (st >> 1) * 16 + swz / 64; C = (st & 1) * 32 + (swz % 64) / 2; }
__host__ __device__ __forceinline__ int perm32(int rho) { const int n = rho >> 4, i = rho & 15; return 8 * (i >> 2) + 4 * n + (i & 3); }

struct Unit { int pm, pn, part, idx; };
struct Gemm { const bf16_t* A; const bf16_t* Bt; int lda, ldb, K; int koff; };

struct Sched {
    int nM, nN, nwg, G, c, psh;
    __device__ __forceinline__ void init(int M_, int N_, int G_, int c_, int psh_) { nM = M_ / BM; nN = N_ / BM; nwg = nM * nN; G = G_; c = c_; psh = psh_; }
    __device__ __forceinline__ bool next(int i, Unit& u) const {
        const long L = (long)(i >> psh) * G + c; if (L >= nwg) return false;
        int wgid = (int)L; { const int q = nwg / NXCD, r = nwg % NXCD, xcd = wgid % NXCD, off = wgid / NXCD; wgid = (xcd < r ? xcd * (q + 1) : r * (q + 1) + (xcd - r) * q) + off; }
        const int nig = WGM * nN, gid = wgid / nig, fm = gid * WGM, gsz = (nM - fm) < WGM ? (nM - fm) : WGM;
        u.pm = fm + ((wgid % nig) % gsz); u.pn = (wgid % nig) / gsz; u.part = i & ((1 << psh) - 1); u.idx = i; return true;
    }
};

typedef f32x4 Acc[2][2][4][2];

template <class Epi>
__device__ __forceinline__ void gemm_phase(LAS unsigned char* lds, const Gemm g, const Sched& S, const Epi& E) {
    const int tid = threadIdx.x, wid = __builtin_amdgcn_readfirstlane(tid >> 6), lane = tid & 63, wr = wid >> 2, wc = wid & 3, fr = lane & 15, fq = lane >> 4;
    const int K = g.K, nt = K / BK;
    unsigned voffA[2], voffB[2];
#pragma unroll
    for (int i = 0; i < 2; ++i) { int R, C; stage_rc(tid * 16 + i * 8192, R, C); const int Rb = (R & ~31) + perm32(R & 31);
        voffA[i] = (unsigned)(R * g.lda + C) * 2u; voffB[i] = (unsigned)(Rb * g.ldb + C) * 2u; }
    const size_t kstep = (size_t)(BK * 2);
    const size_t hstepA = (size_t)HALF * g.lda * 2, hstepB = (size_t)HALF * g.ldb * 2;
    const size_t tstepA = 2 * hstepA, tstepB = 2 * hstepB;
    const unsigned ldsw = (unsigned)wid * 1024u;
    const int aoff = lds_byte(wr * 64 + fr, fq * 8), boff = lds_byte(wc * 32 + fr, fq * 8);
#define PG8_SA(b, h) (((b) * 2 + (h)) * HTB)
#define PG8_SB(b, h) ((4 + (b) * 2 + (h)) * HTB)
#define PG8_STAGE(bufoff, gbase, voff) do { _Pragma("unroll") for (int _i = 0; _i < 2; ++_i) \
        __builtin_amdgcn_global_load_lds((const unsigned*)((const char*)(gbase) + (voff)[_i]), (LAS unsigned*)(lds + (bufoff) + ldsw + _i * 8192), 16, 0, 0); } while (0)
#define PG8_LDA(dst, b, h) do { _Pragma("unroll") for (int m = 0; m < 4; ++m) _Pragma("unroll") for (int k = 0; k < 2; ++k) dst[m][k] = *(const LAS bf16x8*)(lds + PG8_SA(b, h) + aoff + m * 2048 + k * 1024); } while (0)
#define PG8_LDB(dst, b, h) do { _Pragma("unroll") for (int n = 0; n < 2; ++n) _Pragma("unroll") for (int k = 0; k < 2; ++k) dst[n][k] = *(const LAS bf16x8*)(lds + PG8_SB(b, h) + boff + n * 2048 + k * 1024); } while (0)
#define PG8_MMA(ai, bj, At, Bt) do { __builtin_amdgcn_s_setprio(1); _Pragma("unroll") for (int m = 0; m < 4; ++m) _Pragma("unroll") for (int n = 0; n < 2; ++n) _Pragma("unroll") for (int k = 0; k < 2; ++k) \
        acc[ai][bj][m][n] = __builtin_amdgcn_mfma_f32_16x16x32_bf16(Bt[n][k], At[m][k], acc[ai][bj][m][n], 0, 0, 0); __builtin_amdgcn_s_setprio(0); } while (0)
#define PG8_WAIT_V(n) asm volatile("s_waitcnt vmcnt(" #n ")" ::: "memory")
#define PG8_WAIT_L(n) asm volatile("s_waitcnt lgkmcnt(" #n ")" ::: "memory")
#define PG8_BAR __builtin_amdgcn_s_barrier()
#define PG8_SCHED __builtin_amdgcn_sched_barrier(0)
    Unit cur, nxt; int ui = 0;
    if (!S.next(0, cur)) return;
    Acc acc;
#pragma unroll
    for (int a = 0; a < 2; ++a)
#pragma unroll
        for (int b = 0; b < 2; ++b)
#pragma unroll
            for (int m = 0; m < 4; ++m)
#pragma unroll
                for (int n = 0; n < 2; ++n) acc[a][b][m][n] = (f32x4){0.f, 0.f, 0.f, 0.f};
    bf16x8 At[4][2], B0[2][2], B1[2][2];
    const char* cA = (const char*)g.A + (size_t)cur.pm * tstepA + (size_t)cur.part * g.koff * 2; const char* cB = (const char*)g.Bt + (size_t)cur.pn * tstepB + (size_t)cur.part * g.koff * 2;
    PG8_STAGE(PG8_SB(0, 0), cB, voffB); PG8_STAGE(PG8_SB(0, 1), cB + hstepB, voffB); PG8_STAGE(PG8_SA(0, 0), cA, voffA); PG8_STAGE(PG8_SA(0, 1), cA + hstepA, voffA);
    if (wr == 1) PG8_BAR;
    PG8_WAIT_V(2); PG8_BAR;
    PG8_STAGE(PG8_SB(1, 0), cB + kstep, voffB); PG8_STAGE(PG8_SA(1, 0), cA + kstep, voffA); PG8_STAGE(PG8_SB(1, 1), cB + hstepB + kstep, voffB);
    PG8_WAIT_V(6); PG8_BAR;
    for (;;) {
        const bool has_next = S.next(ui + 1, nxt);
        const char* nA = has_next ? (const char*)g.A + (size_t)nxt.pm * tstepA + (size_t)nxt.part * g.koff * 2 : cA; const char* nB = has_next ? (const char*)g.Bt + (size_t)nxt.pn * tstepB + (size_t)nxt.part * g.koff * 2 : cB;
        for (int t = 0; t < nt; t += 2) {
            const bool last = (t == nt - 2);
            const char* a1 = cA + (size_t)(t + 1) * kstep;
            const char* a2 = last ? nA : cA + (size_t)(t + 2) * kstep; const char* b2 = last ? nB : cB + (size_t)(t + 2) * kstep;
            const char* a3 = a2 + kstep; const char* b3 = b2 + kstep;
            PG8_LDB(B0, 0, 0); PG8_LDB(B1, 0, 1); PG8_SCHED; PG8_LDA(At, 0, 0); PG8_STAGE(PG8_SA(1, 1), a1 + hstepA, voffA);
            PG8_WAIT_V(8); PG8_WAIT_L(0); PG8_BAR; PG8_MMA(0, 0, At, B0); PG8_MMA(0, 1, At, B1); PG8_BAR; PG8_SCHED;
            PG8_LDA(At, 0, 1); PG8_STAGE(PG8_SB(0, 0), b2, voffB); PG8_STAGE(PG8_SB(0, 1), b2 + hstepB, voffB); PG8_STAGE(PG8_SA(0, 0), a2, voffA);
            PG8_WAIT_V(8); PG8_WAIT_L(0); PG8_BAR; PG8_MMA(1, 0, At, B0); PG8_MMA(1, 1, At, B1); PG8_BAR; PG8_SCHED;
            PG8_LDB(B0, 1, 0); PG8_LDB(B1, 1, 1); PG8_SCHED; PG8_LDA(At, 1, 0); PG8_STAGE(PG8_SA(0, 1), a2 + hstepA, voffA);
            PG8_WAIT_V(8); PG8_WAIT_L(0); PG8_BAR; PG8_MMA(0, 0, At, B0); PG8_MMA(0, 1, At, B1); PG8_BAR; PG8_SCHED;
            PG8_LDA(At, 1, 1); PG8_STAGE(PG8_SB(1, 0), b3, voffB); PG8_STAGE(PG8_SB(1, 1), b3 + hstepB, voffB); PG8_STAGE(PG8_SA(1, 0), a3, voffA);
            PG8_WAIT_V(8); PG8_WAIT_L(0); PG8_BAR; PG8_MMA(1, 0, At, B0); PG8_MMA(1, 1, At, B1); PG8_BAR; PG8_SCHED;
        }
        if (wr == 0) PG8_BAR;
        if constexpr (!Epi::AFTER_DRAIN) E(acc, cur, wr, wc, fr, fq);
        if (!has_next) break;
        if (!(Epi::KEEP_PART0 && cur.part == 0))
#pragma unroll
        for (int a = 0; a < 2; ++a)
#pragma unroll
            for (int b = 0; b < 2; ++b)
#pragma unroll
                for (int m = 0; m < 4; ++m)
#pragma unroll
                    for (int n = 0; n < 2; ++n) acc[a][b][m][n] = (f32x4){0.f, 0.f, 0.f, 0.f};
        cur = nxt; cA = nA; cB = nB; ++ui;
        if (wr == 1) PG8_BAR;
    }
    PG8_WAIT_V(0);
    PG8_BAR;
    if constexpr (Epi::AFTER_DRAIN) E.fused(acc, cur, wr, wc, fr, fq, lds);
#undef PG8_SA
#undef PG8_SB
#undef PG8_STAGE
#undef PG8_LDA
#undef PG8_LDB
#undef PG8_MMA
#undef PG8_WAIT_V
#undef PG8_WAIT_L
#undef PG8_BAR
#undef PG8_SCHED
}

__device__ __forceinline__ u32x4 pack8(const f32x4 a, const f32x4 b) { u32x4 w; w.x = cvtpk(a[0], a[1]); w.y = cvtpk(a[2], a[3]); w.z = cvtpk(b[0], b[1]); w.w = cvtpk(b[2], b[3]); return w; }
__device__ __forceinline__ void unpack8(const u32x4 w, f32x4& a, f32x4& b) { a = (f32x4){bflo(w.x), bfhi(w.x), bflo(w.y), bfhi(w.y)}; b = (f32x4){bflo(w.z), bfhi(w.z), bflo(w.w), bfhi(w.w)}; }

struct EpiSwiglu {
    static constexpr bool AFTER_DRAIN = false, KEEP_PART0 = false;
    bf16_t* H; const LAS float* rtab;
    __device__ __forceinline__ void operator()(const Acc& acc, const Unit& u, int wr, int wc, int fr, int fq) const {
        const int col0 = u.pn * 128 + wc * 32 + 8 * fq;
        const LAS float* rt = rtab + u.idx * 256 + wr * 64 + fr;
#pragma unroll
        for (int ai = 0; ai < 2; ++ai)
#pragma unroll
            for (int m = 0; m < 4; ++m) {
                const int row = u.pm * BM + ai * HALF + wr * 64 + m * 16 + fr; const float r = rt[ai * HALF + m * 16];
                f32x4 h0, h1;
#pragma unroll
                for (int e = 0; e < 4; ++e) { h0[e] = siluf_(acc[ai][0][m][0][e] * r) * (acc[ai][1][m][0][e] * r); h1[e] = siluf_(acc[ai][0][m][1][e] * r) * (acc[ai][1][m][1][e] * r); }
                *(u32x4*)(H + (size_t)row * FF + col0) = pack8(h0, h1);
            }
    }
};
template <bool BASE_BF16, bool OUT_F32, bool OUT_BF16> struct EpiResidual {
    static constexpr bool AFTER_DRAIN = false, KEEP_PART0 = false;
    static_assert(BASE_BF16, "the residual stream is bf16");
    const void* base; const void* base_s; float* outf; bf16_t* outb; float* ssq; float scale;
    __device__ __forceinline__ void operator()(const Acc& acc, const Unit& u, int wr, int wc, int fr, int fq) const {
        const size_t off0 = (size_t)(u.pm * BM + wr * 64 + fr) * D + u.pn * BM + wc * 32 + 8 * fq;
        u32x4 bw[2][4][2];
#pragma unroll
        for (int ai = 0; ai < 2; ++ai)
#pragma unroll
            for (int m = 0; m < 4; ++m)
#pragma unroll
                for (int bj = 0; bj < 2; ++bj) bw[ai][m][bj] = *(const u32x4*)((const bf16_t*)base + off0 + (size_t)(ai * HALF + m * 16) * D + bj * HALF);
#pragma unroll
        for (int ai = 0; ai < 2; ++ai)
#pragma unroll
            for (int m = 0; m < 4; ++m) {
                const int row = u.pm * BM + ai * HALF + wr * 64 + m * 16 + fr; float s = 0.f;
#pragma unroll
                for (int bj = 0; bj < 2; ++bj) {
                    const size_t off = off0 + (size_t)(ai * HALF + m * 16) * D + bj * HALF;
                    f32x4 b0, b1; unpack8(bw[ai][m][bj], b0, b1);
                    const f32x4 v0 = b0 + acc[ai][bj][m][0] * scale, v1 = b1 + acc[ai][bj][m][1] * scale;
                    s += (v0[0] * v0[0] + v0[1] * v0[1]) + (v0[2] * v0[2] + v0[3] * v0[3]) + (v1[0] * v1[0] + v1[1] * v1[1]) + (v1[2] * v1[2] + v1[3] * v1[3]);
                    if (OUT_F32) { *(f32x4*)(outf + off) = v0; *(f32x4*)(outf + off + 4) = v1; }
                    if (OUT_BF16) *(u32x4*)(outb + off) = pack8(v0, v1);
                }
                s += __shfl_xor(s, 16); s += __shfl_xor(s, 32);
                if (fq == 0) ssq[(size_t)row * 16 + u.pn * 4 + wc] = s;
            }
    }
};
struct EpiIn {
    static constexpr bool AFTER_DRAIN = false, KEEP_PART0 = false;
    bf16_t *QK, *V, *G, *AB, *SKV; float* GA; const LAS float* rtab; const float *qn, *kn; float* out;
    __device__ __forceinline__ void operator()(const Acc& acc, const Unit& u, int wr, int wc, int fr, int fq) const {
        const int pn = u.pn, cpos = wc * 32 + 8 * fq;
        const LAS float* rt = rtab + u.idx * 256 + wr * 64 + fr;
        f32x4 gq[2][2];
        { const float* gn = pn < 16 ? qn : kn;
#pragma unroll
          for (int bj = 0; bj < 2; ++bj) { gq[bj][0] = *(const f32x4*)(gn + bj * 32 + 8 * fq); gq[bj][1] = *(const f32x4*)(gn + bj * 32 + 8 * fq + 4); } }
#pragma unroll
        for (int ai = 0; ai < 2; ++ai)
#pragma unroll
            for (int m = 0; m < 4; ++m) {
                const int row = u.pm * BM + ai * HALF + wr * 64 + m * 16 + fr; const float r = rt[ai * HALF + m * 16];
                f32x4 v[2][2];
#pragma unroll
                for (int bj = 0; bj < 2; ++bj)
#pragma unroll
                    for (int n = 0; n < 2; ++n) v[bj][n] = acc[ai][bj][m][n] * r;
                if (pn >= 18 && pn < 26) {
                    bf16_t* dst = G + (size_t)row * 2048 + (pn - 18) * 128 + cpos;
                    f32x4 r0, r1, s0, s1;
#pragma unroll
                    for (int e = 0; e < 4; ++e) {
                        const float ea0 = fast_exp(-v[0][0][e]), ea1 = fast_exp(-v[0][1][e]), eb0 = fast_exp(-v[1][0][e]), eb1 = fast_exp(-v[1][1][e]);
                        s0[e] = __builtin_amdgcn_rcpf(1.f + eb0); s1[e] = __builtin_amdgcn_rcpf(1.f + eb1);
                        r0[e] = (1.f + eb0) * __builtin_amdgcn_rcpf(1.f + ea0); r1[e] = (1.f + eb1) * __builtin_amdgcn_rcpf(1.f + ea1);
                    }
                    *(u32x4*)dst = pack8(r0, r1); *(u32x4*)(dst + 1024) = pack8(s0, s1);
                } else if (pn < 12 || pn == 17) {
                    bf16_t* dst; float sc = 1.f;
                    if (pn < 4) { dst = QK + (size_t)row * 1024 + pn * 256; if (pn < 2) sc = 0.08838834764831845f; }
                    else if (pn < 8) dst = V + (size_t)row * 1024 + (pn - 4) * 256;
                    else if (pn < 12) dst = AB + (size_t)row * 2048 + (pn - 8) * 256;
                    else dst = SKV + (size_t)row * 512 + 256;
#pragma unroll
                    for (int bj = 0; bj < 2; ++bj) *(u32x4*)(dst + bj * HALF + cpos) = pack8(v[bj][0] * sc, v[bj][1] * sc);
                    if (pn == 17) {
                        float* o = nullptr;
                        if (u.pm == 64) o = out + OUT_VS + (size_t)(row - MP) * 256;
                        else if ((u.pm & 15) == 15 && ai == 1) o = out + OUT_VP + (size_t)((row >> 12) * 128 + ((row & 4095) - 3968)) * 256;
                        if (o) {
#pragma unroll
                            for (int bj = 0; bj < 2; ++bj) { *(f32x4*)(o + bj * HALF + cpos) = v[bj][0]; *(f32x4*)(o + bj * HALF + cpos + 4) = v[bj][1]; }
                        }
                    }
                } else if (pn < 17) {
                    float s = 0.f;
#pragma unroll
                    for (int bj = 0; bj < 2; ++bj)
#pragma unroll
                        for (int n = 0; n < 2; ++n) s += (v[bj][n][0] * v[bj][n][0] + v[bj][n][1] * v[bj][n][1]) + (v[bj][n][2] * v[bj][n][2] + v[bj][n][3] * v[bj][n][3]);
                    s += __shfl_xor(s, 16); s += __shfl_xor(s, 32);
                    const float hr = __builtin_amdgcn_rsqf(s * (1.0f / 64.0f) + EPS);
                    const bool isq = pn < 16; const float sc = isq ? (0.125f * LOG2E) * hr : hr;
                    bf16_t* dst = isq ? AB + (size_t)row * 2048 + 1024 + ((pn - 12) * 4 + wc) * 64 : SKV + (size_t)row * 512 + wc * 64;
                    float* o = nullptr;
                    if (!isq) { if (u.pm == 64) o = out + OUT_KS + (size_t)(row - MP) * 256 + wc * 64;
                                else if ((u.pm & 15) == 15 && ai == 1) o = out + OUT_KP + (size_t)((row >> 12) * 128 + ((row & 4095) - 3968)) * 256 + wc * 64; }
#pragma unroll
                    for (int bj = 0; bj < 2; ++bj) {
                        const int ch = bj * 32 + 8 * fq;
                        const f32x4 w0 = v[bj][0] * sc * gq[bj][0], w1 = v[bj][1] * sc * gq[bj][1];
                        *(u32x4*)(dst + ch) = pack8(w0, w1);
                        if (o) { *(f32x4*)(o + ch) = w0; *(f32x4*)(o + ch + 4) = w1; }
                    }
                } else {
                    if (wc == 0 && fq < 2) { *(f32x4*)(GA + (size_t)row * 16 + 8 * fq) = v[0][0]; *(f32x4*)(GA + (size_t)row * 16 + 8 * fq + 4) = v[0][1]; }
                }
            }
    }
};
struct EpiMerge {
    static constexpr bool AFTER_DRAIN = false, KEEP_PART0 = true;
    bf16_t* G; bf16_t* Go; int omask;
    __device__ __forceinline__ void operator()(Acc& acc, const Unit& u, int wr, int wc, int fr, int fq) const {
        const size_t off0 = (size_t)(u.pm * BM + wr * 64 + fr) * 2048 + u.pn * BM + wc * 32 + 8 * fq + (u.part ? 1024 : 0);
        u32x4 gw[2][4][2];
#pragma unroll
        for (int ai = 0; ai < 2; ++ai)
#pragma unroll
            for (int m = 0; m < 4; ++m)
#pragma unroll
                for (int bj = 0; bj < 2; ++bj) gw[ai][m][bj] = *(const u32x4*)(G + off0 + (size_t)(ai * HALF + m * 16) * 2048 + bj * HALF);
#pragma unroll
        for (int ai = 0; ai < 2; ++ai)
#pragma unroll
            for (int m = 0; m < 4; ++m) {
                const int row = u.pm * BM + ai * HALF + wr * 64 + m * 16 + fr;
#pragma unroll
                for (int bj = 0; bj < 2; ++bj) {
                    f32x4 a0, a1; unpack8(gw[ai][m][bj], a0, a1);
                    if (u.part == 0) { acc[ai][bj][m][0] *= a0; acc[ai][bj][m][1] *= a1; }
                    else {
                        bf16_t* po = Go + (size_t)(row & omask) * 2048 + u.pn * BM + bj * HALF + wc * 32 + 8 * fq;
                        *(u32x4*)po = pack8(a0 * acc[ai][bj][m][0], a1 * acc[ai][bj][m][1]);
                    }
                }
            }
    }
};
struct EpiFinal {
    static constexpr bool AFTER_DRAIN = true, KEEP_PART0 = false;
    const bf16_t* base; float* out; const float* gain; float* slots; unsigned* cnt; float scale;
    __device__ __forceinline__ void fused(Acc& acc, const Unit& u, int wr, int wc, int fr, int fq, LAS unsigned char* lds) const {
        LAS float* Pw = (LAS float*)lds; LAS float* S = (LAS float*)(lds + 4096);
#pragma unroll
        for (int ai = 0; ai < 2; ++ai)
#pragma unroll
            for (int m = 0; m < 4; ++m) {
                const int rt = ai * HALF + wr * 64 + m * 16 + fr; const int row = u.pm * BM + rt; float s = 0.f;
#pragma unroll
                for (int bj = 0; bj < 2; ++bj) {
                    const size_t off = (size_t)row * D + u.pn * BM + bj * HALF + wc * 32 + 8 * fq;
                    f32x4 b0, b1; unpack8(*(const u32x4*)(base + off), b0, b1);
                    const f32x4 v0 = b0 + acc[ai][bj][m][0] * scale, v1 = b1 + acc[ai][bj][m][1] * scale;
                    acc[ai][bj][m][0] = v0; acc[ai][bj][m][1] = v1;
                    s += (v0[0] * v0[0] + v0[1] * v0[1]) + (v0[2] * v0[2] + v0[3] * v0[3]) + (v1[0] * v1[0] + v1[1] * v1[1]) + (v1[2] * v1[2] + v1[3] * v1[3]);
                }
                s += __shfl_xor(s, 16); s += __shfl_xor(s, 32);
                if (fq == 0) Pw[rt * 4 + wc] = s;
            }
        __syncthreads();
        float mine = 0.f;
        if (threadIdx.x < 256) { const f32x4 p = *(const LAS f32x4*)(Pw + threadIdx.x * 4); mine = (p[0] + p[1]) + (p[2] + p[3]); }
        xchg_rstd(mine, S, 256, slots + (size_t)u.pm * BM * 16, u.pn, 4, cnt + 64 * u.pm, 4u);
        f32x4 gg[2][2];
#pragma unroll
        for (int bj = 0; bj < 2; ++bj) { const int col = u.pn * BM + bj * HALF + wc * 32 + 8 * fq; gg[bj][0] = *(const f32x4*)(gain + col); gg[bj][1] = *(const f32x4*)(gain + col + 4); }
#pragma unroll
        for (int ai = 0; ai < 2; ++ai)
#pragma unroll
            for (int m = 0; m < 4; ++m) {
                const int rt = ai * HALF + wr * 64 + m * 16 + fr; const int row = u.pm * BM + rt; const float rs = S[rt];
#pragma unroll
                for (int bj = 0; bj < 2; ++bj) {
                    const int col = u.pn * BM + bj * HALF + wc * 32 + 8 * fq; const size_t off = (size_t)row * D + col;
                    *(f32x4*)(out + off) = acc[ai][bj][m][0] * rs * gg[bj][0]; *(f32x4*)(out + off + 4) = acc[ai][bj][m][1] * rs * gg[bj][1];
                }
            }
    }
};
}

#define XB_TMO      128
#define XB_XCNT(j)  (256  + 64 * (j))
#define XB_XSUB(j)  (1280 + 64 * (j))
#define XB_XGEN(j)  (2304 + 64 * (j))
#define XB_TOP      3328
#define XB_TOPGEN   3392
#define XCD_BAR_WORDS 3456
#define XB_SPIN_CAP (1u << 20)
__device__ __forceinline__ unsigned xb_ld(unsigned* p)              { return __hip_atomic_load(p, __ATOMIC_RELAXED, __HIP_MEMORY_SCOPE_AGENT); }
__device__ __forceinline__ unsigned xb_add(unsigned* p, unsigned v) { return __hip_atomic_fetch_add(p, v, __ATOMIC_RELAXED, __HIP_MEMORY_SCOPE_AGENT); }
__device__ __forceinline__ unsigned xb_xcc_id() { return (unsigned)__builtin_amdgcn_s_getreg((3 << 11) | 20) & 0xFu; }
#define XB_SPIN(cond, bar) do { unsigned _sp = 0; while (cond) { __builtin_amdgcn_s_sleep(1); \
    if ((++_sp & 255u) == 0u) { if (xb_ld(&(bar)[XB_TMO])) break; if (_sp > XB_SPIN_CAP) { atomicAdd(&(bar)[XB_TMO], 1u); break; } } } } while (0)
struct XcdBarrier { unsigned* bar; unsigned x; volatile LAS unsigned* st; };
__device__ __forceinline__ XcdBarrier xcd_barrier_post(unsigned* bar, volatile LAS unsigned* st) {
    XcdBarrier b; b.bar = bar; b.x = xb_xcc_id(); b.st = st;
    if (threadIdx.x == 0) (void)xb_add(&bar[XB_XCNT(b.x)], 1u);
    return b;
}
__device__ __forceinline__ void xcd_barrier_complete(unsigned* bar, unsigned x, unsigned& nloc, unsigned& nx) {
    const unsigned G = gridDim.x * gridDim.y * gridDim.z;
    unsigned sum, cnt, mine, sp = 0u;
    for (;;) {
        sum = 0u; cnt = 0u; mine = 0u;
#pragma unroll
        for (unsigned j = 0; j < 16; ++j) { const unsigned c = xb_ld(&bar[XB_XCNT(j)]); sum += c; cnt += (c > 0u) ? 1u : 0u; mine = (j == x) ? c : mine; }
        if (sum == G) break;
        __builtin_amdgcn_s_sleep(1);
        if ((++sp & 255u) == 0u) { if (xb_ld(&bar[XB_TMO])) break; if (sp > XB_SPIN_CAP) { atomicAdd(&bar[XB_TMO], 1u); break; } }
    }
    nloc = mine > 0u ? mine : 1u; nx = cnt > 0u ? cnt : 1u;
}
__device__ __forceinline__ void xcd_barrier(const XcdBarrier& b) {
    asm volatile("s_waitcnt vmcnt(0)" ::: "memory");
    __syncthreads();
    if (threadIdx.x == 0) {
        unsigned* bar = b.bar;
        __builtin_amdgcn_s_waitcnt(0);
        unsigned nloc = b.st[0], nx = b.st[1];
        if (nloc == 0u) { xcd_barrier_complete(bar, b.x, nloc, nx); b.st[0] = nloc; b.st[1] = nx; }
        const unsigned old = xb_add(&bar[XB_XSUB(b.x)], 1u);
        const unsigned gen = old / nloc;
        if (old + 1u == (gen + 1u) * nloc) {
            __builtin_amdgcn_fence(__ATOMIC_RELEASE, "agent");
            asm volatile("s_waitcnt vmcnt(0)" ::: "memory");
            const unsigned og = xb_add(&bar[XB_TOP], 1u);
            const unsigned tg = og / nx;
            if (og + 1u == (tg + 1u) * nx) xb_add(&bar[XB_TOPGEN], 1u);
            else XB_SPIN(xb_ld(&bar[XB_TOPGEN]) == tg, bar);
            __builtin_amdgcn_fence(__ATOMIC_ACQUIRE, "agent");
            xb_add(&bar[XB_XGEN(b.x)], 1u);
            asm volatile("s_waitcnt vmcnt(0)" ::: "memory");
        } else {
            XB_SPIN(xb_ld(&bar[XB_XGEN(b.x)]) == gen, bar);
            __builtin_amdgcn_fence(__ATOMIC_ACQUIRE, "agent");
            asm volatile("s_waitcnt vmcnt(0)" ::: "memory");
        }
    }
    __syncthreads();
}

constexpr int NWAVES = 8, NTHREADS = 512;
constexpr int RING_BYTES = 131072;
constexpr int MISC_OFF = RING_BYTES + 320;
constexpr int LDS_BYTES = 147456;

struct Params {
    const float* in[23]; float* out; unsigned char* ws; int ph_lo, ph_hi;
};

__device__ __forceinline__ float wave_sum(float v) {
#pragma unroll
    for (int o = 1; o < 64; o <<= 1) v += __shfl_xor(v, o);
    return v;
}

__device__ __forceinline__ int vgroup_src(int kind, int g, int& cnt) {
    cnt = 32;
    if (kind == 0) return g * 32;
    if (kind == 1) { const int pn = g >> 3, tg = g & 7; return (tg >> 2) * FF + pn * 128 + (tg & 3) * 32; }
    const int tile = g >> 3, tg = g & 7;
    if (tile < 12) return g * 32;
    if (tile < 17) { const int bj = tg >> 2, wc = tg & 3; const int base = tile < 16 ? 3088 + (tile - 12) * 256 : 4112; return base + 64 * wc + 32 * bj; }
    if (tile == 17) return 4368 + tg * 32;
    if (tile < 26) return 4624 + (tg >> 2) * 1024 + (tile - 18) * 128 + (tg & 3) * 32;
    if (tg == 0) { cnt = 16; return 3072; }
    cnt = 0; return 0;
}
__device__ __forceinline__ void p0_transpose_item(const float* W, int K, int Norig, int kind, const float* gain, bf16_t* WT, LAS float* scr, int item, int ngroups, int lane) {
    const int kb = item / ngroups, g = item % ngroups, k0 = 64 * kb;
    int cnt; const int src = vgroup_src(kind, g, cnt);
    const int n = lane & 31;
    const int ks = lane >> 3, n4 = (lane & 7) * 4; const bool okc = n4 < cnt;
    const float* wp = W + (size_t)(k0 + ks) * Norig + src + (okc ? n4 : 0);
    f32x4 v[8];
#pragma unroll
    for (int i = 0; i < 8; ++i) v[i] = *(const f32x4*)(wp + (size_t)(8 * i) * Norig);
    const int c = lane & 7;
    f32x4 g0 = (f32x4){1.f, 1.f, 1.f, 1.f}, g1 = g0;
    if (gain) { g0 = *(const f32x4*)(gain + k0 + 8 * c); g1 = *(const f32x4*)(gain + k0 + 8 * c + 4); }
#pragma unroll
    for (int i = 0; i < 8; ++i) { LAS float* sp = scr + (8 * i + ks) * 33 + n4;
#pragma unroll
        for (int e = 0; e < 4; ++e) sp[e] = okc ? v[i][e] : 0.f; }
    LDS_WAIT(); asm volatile("" ::: "memory");
#pragma unroll
    for (int j = 0; j < 4; ++j) { const int nn = (lane >> 3) + 8 * j; const LAS float* sr = scr + (8 * c) * 33 + nn;
        u32x4 o; o.x = cvtpk(sr[0 * 33] * g0[0], sr[1 * 33] * g0[1]); o.y = cvtpk(sr[2 * 33] * g0[2], sr[3 * 33] * g0[3]); o.z = cvtpk(sr[4 * 33] * g1[0], sr[5 * 33] * g1[1]); o.w = cvtpk(sr[6 * 33] * g1[2], sr[7 * 33] * g1[3]);
        *(u32x4*)(WT + (size_t)(g * 32 + nn) * K + k0 + 8 * c) = o; }
    LDS_WAIT(); asm volatile("" ::: "memory");
}

namespace swa {
constexpr int KST = 72, VSS = 96;
constexpr int OFF_K = 0, OFF_V = 192 * KST * 2, OFF_TBL = OFF_V + 192 * VSS * 2, LDS_USED = OFF_TBL + 4 * 256 * 4;
typedef short v4i16_t __attribute__((ext_vector_type(4)));
__device__ __forceinline__ s16x4 tr16(const LAS bf16_t* p) { return __builtin_bit_cast(s16x4, __builtin_amdgcn_ds_read_tr16_b64_v4i16((LAS v4i16_t*)p)); }
__device__ __forceinline__ int t5_bucket(int rel) {
    const int n = rel < 0 ? -rel : rel; const int ret = rel > 0 ? 16 : 0;
    if (n < 8) return ret + n;
    int large = 8 + (int)(2.0f * __log2f((float)n * 0.125f) + 1e-4f); if (large > 15) large = 15;
    return ret + large;
}
struct Item { int b, kh, c, kvmin, kvmax; bool samp; };
__device__ __forceinline__ Item decode(int item) {
    Item t; t.samp = item >= 1024;
    if (!t.samp) { t.b = item >> 8; t.kh = (item >> 6) & 3; t.c = item & 63; } else { const int s = item - 1024; t.b = s >> 2; t.kh = s & 3; t.c = 0; }
    t.kvmin = t.samp ? 0 : (t.c >= 2 ? 0 : 128 - 64 * t.c); t.kvmax = t.samp ? 144 : 192; return t;
}
__device__ __forceinline__ void fetch(const Item& t, const bf16_t* SKV, const float* cache_k, const float* cache_v, u32x4 (&kw)[3], u32x4 (&vw)[3]) {
    const int tid = threadIdx.x, ch = tid & 7;
#pragma unroll
    for (int i = 0; i < 3; ++i) {
        const int kv = (tid >> 3) + 64 * i;
        kw[i] = (u32x4){0u, 0u, 0u, 0u}; vw[i] = kw[i];
        if (t.samp && i < 2) {
            const float* pk = cache_k + ((size_t)(t.b * 128 + kv) * 4 + t.kh) * 64 + ch * 8; const float* pv = cache_v + ((size_t)(t.b * 128 + kv) * 4 + t.kh) * 64 + ch * 8;
            const f32x4 k0 = *(const f32x4*)pk, k1 = *(const f32x4*)(pk + 4), v0 = *(const f32x4*)pv, v1 = *(const f32x4*)(pv + 4);
            kw[i] = pg8::pack8(k0, k1); vw[i] = pg8::pack8(v0, v1);
        } else {
            const int kvc = kv < t.kvmin ? t.kvmin : (kv >= t.kvmax ? t.kvmax - 1 : kv);
            const size_t row = t.samp ? (size_t)(MP + t.b * 16 + (kvc - 128)) : (size_t)(t.b * SEQ + 64 * (t.c - 2) + kvc);
            const bf16_t* p = SKV + row * 512 + t.kh * 64 + ch * 8;
            const u32x4 k4 = *(const u32x4*)p, v4 = *(const u32x4*)(p + 256);
            const bool ok = kv >= t.kvmin && kv < t.kvmax;
            kw[i] = ok ? k4 : kw[i]; vw[i] = ok ? v4 : vw[i];
        }
    }
}
__device__ __forceinline__ void phase(LAS unsigned char* lds, int bx, int G, bf16_t* AB, bf16_t* dummy, const bf16_t* SKV, const float* cache_k, const float* cache_v, const float* sinks, const float* rel_bias) {
    const int tid = threadIdx.x, lane = tid & 63, r = lane & 31, h = lane >> 5; const int w = __builtin_amdgcn_readfirstlane(tid >> 6);
    LAS bf16_t* Ks = (LAS bf16_t*)(lds + OFF_K); LAS bf16_t* Vs = (LAS bf16_t*)(lds + OFF_V); LAS float* tbl = (LAS float*)(lds + OFF_TBL);
    constexpr int NITEMS = 1024 + 64;
    if (bx >= NITEMS) return;
    int cur_kh = -1;
    u32x4 kw[3], vw[3]; bf16x8 qn[4];
#define SWA_QFETCH(tt) do { size_t qrow_; int g_; if (!(tt).samp) { g_ = w >> 1; qrow_ = (size_t)((tt).b * SEQ + 64 * (tt).c + 32 * (w & 1) + r); } \
        else { const int ir_ = (32 * w + r) & 63; g_ = ir_ >> 4; qrow_ = (size_t)(MP + (tt).b * 16 + (ir_ & 15)); } \
        const bf16_t* Qp_ = AB + qrow_ * 2048 + 1024 + (4 * (tt).kh + g_) * 64; \
        _Pragma("unroll") for (int s_ = 0; s_ < 4; ++s_) qn[s_] = *(const bf16x8*)(Qp_ + 16 * s_ + 8 * h); } while (0)
    { const Item t0 = decode(bx); fetch(t0, SKV, cache_k, cache_v, kw, vw); SWA_QFETCH(t0); }
    for (int item = bx; item < NITEMS; item += G) {
        const Item t = decode(item);
        const bool samp = t.samp; const int b = t.b, kh = t.kh, c = t.c, kvmin = t.kvmin, kvmax = t.kvmax;
        {
            LAS bf16_t* kwp = opq(Ks + (tid >> 3) * KST + (tid & 7) * 8); LAS bf16_t* vwp = opq(Vs + (tid >> 3) * VSS + (tid & 7) * 8);
#pragma unroll
            for (int i = 0; i < 3; ++i) { *(LAS u32x4*)(kwp + 64 * i * KST) = kw[i]; *(LAS u32x4*)(vwp + 64 * i * VSS) = vw[i]; }
            if (kh != cur_kh) {
                LAS float* twp = opq(tbl + tid);
#pragma unroll
                for (int i = 0; i < 2; ++i) { const int idx = tid + 512 * i, g = idx >> 8, ii = idx & 255; twp[512 * i] = LOG2E * rel_bias[t5_bucket(ii - 191) * 16 + 4 * kh + g]; }
                cur_kh = kh;
            }
        }
        __syncthreads();
        const bool active = !samp || w < 2;
        int g = 0, tq = 0;
        if (!samp) { g = w >> 1; tq = 32 * (w & 1) + r; }
        else { const int ir = (32 * w + r) & 63; g = ir >> 4; tq = ir & 15; }
        bf16x8 qf[4];
#pragma unroll
        for (int s = 0; s < 4; ++s) qf[s] = qn[s];
        if (item + G < NITEMS) { const Item tn = decode(item + G); fetch(tn, SKV, cache_k, cache_v, kw, vw); SWA_QFETCH(tn); }
        if (active) {
            f32x16 sc[6];
            {
                const LAS bf16_t* krp = opq(Ks + r * KST + 8 * h);
#pragma unroll
                for (int blk = 0; blk < 6; ++blk) {
                    f32x16 a = {0.f, 0.f, 0.f, 0.f, 0.f, 0.f, 0.f, 0.f, 0.f, 0.f, 0.f, 0.f, 0.f, 0.f, 0.f, 0.f};
#pragma unroll
                    for (int s = 0; s < 4; ++s) { const bf16x8 kf = *(const LAS bf16x8*)(krp + (32 * blk) * KST + 16 * s); a = MFMA32(kf, qf[s], a); }
                    sc[blk] = a;
                }
            }
            const float sink = LOG2E * sinks[4 * kh + g];
            const LAS float* tb = opq(tbl + g * 256 + 63 - tq + 4 * h);
            const unsigned vm = (kvmax >= 192 ? 0xffffffu : ((1u << (kvmax >> 3)) - 1u)) & ~((1u << (kvmin >> 3)) - 1u);
            float mx = sink;
#pragma unroll
            for (int blk = 0; blk < 6; ++blk) {
#pragma unroll
                for (int i = 0; i < 16; ++i) { const float v = sc[blk][i] + tb[32 * blk + (i & 3) + 8 * (i >> 2)]; sc[blk][i] = v; mx = fmaxf(mx, v); }
                __builtin_amdgcn_sched_barrier(0);
            }
            mx = fmaxf(mx, __shfl_xor(mx, 32));
            float l = 0.f;
#pragma unroll
            for (int blk = 0; blk < 6; ++blk)
#pragma unroll
                for (int q4 = 0; q4 < 4; ++q4) {
                    const float vf = (float)((vm >> (4 * blk + q4)) & 1u);
                    float ps = 0.f;
#pragma unroll
                    for (int e = 0; e < 4; ++e) { const float p = __builtin_amdgcn_exp2f(sc[blk][4 * q4 + e] - mx) * vf; sc[blk][4 * q4 + e] = p; ps += p; }
                    l += ps;
                }
            l += __shfl_xor(l, 32);
            l += __builtin_amdgcn_exp2f(sink - mx);
            const float inv = 1.0f / l;
            f32x16 o[2];
#pragma unroll
            for (int d = 0; d < 2; ++d) o[d] = (f32x16){0.f, 0.f, 0.f, 0.f, 0.f, 0.f, 0.f, 0.f, 0.f, 0.f, 0.f, 0.f, 0.f, 0.f, 0.f, 0.f};
            const LAS bf16_t* vrp = opq_after(Vs + (4 * h + ((lane & 15) >> 2)) * VSS + 16 * ((lane >> 4) & 1) + 4 * (lane & 3), inv);
#pragma unroll
            for (int blk = 0; blk < 6; ++blk) {
#pragma unroll
                for (int s2 = 0; s2 < 2; ++s2) {
                    u32x4 pw; pw.x = cvtpk(sc[blk][8 * s2 + 0] * inv, sc[blk][8 * s2 + 1] * inv); pw.y = cvtpk(sc[blk][8 * s2 + 2] * inv, sc[blk][8 * s2 + 3] * inv);
                    pw.z = cvtpk(sc[blk][8 * s2 + 4] * inv, sc[blk][8 * s2 + 5] * inv); pw.w = cvtpk(sc[blk][8 * s2 + 6] * inv, sc[blk][8 * s2 + 7] * inv);
                    const bf16x8 pa = __builtin_bit_cast(bf16x8, pw);
#pragma unroll
                    for (int d = 0; d < 2; ++d) {
                        const LAS bf16_t* vp = vrp + (32 * blk + 16 * s2) * VSS + 32 * d;
                        const s16x4 lo = tr16(vp), hi = tr16(vp + 8 * VSS);
                        const bf16x8 vb = __builtin_shufflevector(lo, hi, 0, 1, 2, 3, 4, 5, 6, 7);
                        o[d] = MFMA32(pa, vb, o[d]);
                    }
                }
                __builtin_amdgcn_sched_barrier(0);
            }
            {
                const size_t orow0 = samp ? (size_t)(MP + b * 16) : (size_t)(b * SEQ + 64 * c + 32 * (w & 1));
                const int og0 = samp ? 2 * w : (w >> 1);
                bf16_t* ub = (dummy ? dummy + (orow0 & 2047) * 2048 : AB + orow0 * 2048) + 1024 + (4 * kh + og0) * 64;
                const unsigned lo = (unsigned)(4 * h * 2048 + r);
#pragma unroll
                for (int i = 0; i < 16; ++i) {
                    const int ro = samp ? ((i & 3) + 8 * ((i >> 2) & 1)) * 2048 + (i >> 3) * 64 : ((i & 3) + 8 * (i >> 2)) * 2048;
                    (ub + ro)[lo] = f2bf(o[0][i]); (ub + ro + 32)[lo] = f2bf(o[1][i]);
                }
            }
        }
        __syncthreads();
    }
#undef SWA_QFETCH
}
}

namespace gla {
constexpr int QST = 136, TST = 72, VST = 288;
constexpr int OFF_QS = 0, OFF_KS = OFF_QS + 64 * QST * 2, OFF_KDT = OFF_KS + 64 * QST * 2, OFF_A = OFF_KDT + 128 * TST * 2, OFF_VS = OFF_A + 64 * TST * 2;
constexpr int OFF_GA = OFF_VS + 64 * VST * 2, OFF_EB = OFF_GA + 16 * 68 * 4, OFF_CS = OFF_EB + 512, OFF_PART = OFF_CS + 2048, LDS_USED = OFF_PART + 2048;
static_assert(LDS_USED <= RING_BYTES && (OFF_VS % 16) == 0, "gla lds");
typedef short v4i16_t __attribute__((ext_vector_type(4)));
__device__ __forceinline__ s16x4 tr16(const LAS bf16_t* p) { return __builtin_bit_cast(s16x4, __builtin_amdgcn_ds_read_tr16_b64_v4i16((LAS v4i16_t*)p)); }
__device__ __forceinline__ float log_sigmoid(float z) { const float az = fabsf(z); return fminf(z, 0.f) - 0.6931471805599453f * __builtin_amdgcn_logf(1.f + __builtin_amdgcn_exp2f(-az * LOG2E)); }

template <bool FULL, bool PARTIAL  >
__device__ __forceinline__ void span(LAS unsigned char* lds, int row0, int nch, int nvalid_, int hd, const bf16_t* QK, const bf16_t* V, bf16_t* AB, const float* GA,
                                     const float* w_alpha, const float* b_alpha, const float* head_norm, const float* S0, float* Sout, float* Dout, bf16_t* dummy = nullptr) {
    const int tid = threadIdx.x, lane = tid & 63, r = lane & 31, h = lane >> 5; const int w = __builtin_amdgcn_readfirstlane(tid >> 6);
    const int kk = tid & 127, tg = tid >> 7;
    const int nvalid = PARTIAL ? nvalid_ : 64;
    LAS bf16_t* QS = (LAS bf16_t*)(lds + OFF_QS); LAS bf16_t* KS = (LAS bf16_t*)(lds + OFF_KS); LAS bf16_t* KdT = (LAS bf16_t*)(lds + OFF_KDT); LAS bf16_t* Ab = (LAS bf16_t*)(lds + OFF_A);
    LAS bf16_t* VS = (LAS bf16_t*)(lds + OFF_VS); LAS float* GAs = (LAS float*)(lds + OFF_GA); LAS float* EB = (LAS float*)(lds + OFF_EB); LAS float* CS = (LAS float*)(lds + OFF_CS);
    LAS float* PART = (LAS float*)(lds + OFF_PART);
    float wal[16];
#pragma unroll
    for (int i = 0; i < 16; ++i) wal[i] = w_alpha[i * 512 + hd * 128 + kk];
    const float bal = b_alpha[hd * 128 + kk];
    f32x16 Sacc[4];
    if (FULL && S0) {
        const float* s0p = S0 + (size_t)(4 * h) * 256 + 32 * w + r;
#pragma unroll
        for (int kb = 0; kb < 4; ++kb)
#pragma unroll
            for (int i = 0; i < 16; ++i) Sacc[kb][i] = s0p[(32 * kb + (i & 3) + 8 * (i >> 2)) * 256];
    } else {
#pragma unroll
        for (int kb = 0; kb < 4; ++kb)
#pragma unroll
            for (int i = 0; i < 16; ++i) Sacc[kb][i] = 0.f;
    }
    float dsum = 0.f;
    f32x4 raw_ga; u32x4 raw_k[2], raw_q[2];
    const int nv1 = nvalid - 1;
    const u32x4 z4 = (u32x4){0u, 0u, 0u, 0u};
#define GLA_FETCH_KG(cc) do { const int crow_ = row0 + 64 * (cc); int t_ = tid; asm volatile("" : "+v"(t_)); \
        const float* gau_ = GA + (size_t)crow_ * 16; const bf16_t* qku_ = QK + (size_t)crow_ * 1024 + hd * 128; \
        raw_ga = *(const f32x4*)(gau_ + (unsigned)(min(t_ >> 2, nv1) * 16 + (t_ & 3) * 4)); if ((t_ >> 2) >= nvalid) raw_ga = (f32x4){0.f, 0.f, 0.f, 0.f}; \
        _Pragma("unroll") for (int i_ = 0; i_ < 2; ++i_) { raw_k[i_] = *(const u32x4*)(qku_ + 512 + (unsigned)(min((t_ >> 4) + 32 * i_, nv1) * 1024 + (t_ & 15) * 8)); raw_k[i_] = ((t_ >> 4) + 32 * i_ < nvalid) ? raw_k[i_] : z4; \
            if (FULL) { raw_q[i_] = *(const u32x4*)(qku_ + (unsigned)(min((t_ >> 4) + 32 * i_, nv1) * 1024 + (t_ & 15) * 8)); raw_q[i_] = ((t_ >> 4) + 32 * i_ < nvalid) ? raw_q[i_] : z4; } } } while (0)
#define GLA_FETCH_QV(cc) do { const int crow_ = row0 + 64 * (cc); int t_ = tid; asm volatile("" : "+v"(t_)); \
        const bf16_t* vu_ = V + (size_t)crow_ * 1024 + hd * 256; const bf16_t* qku_ = QK + (size_t)crow_ * 1024 + hd * 128; \
        _Pragma("unroll") for (int i_ = 0; i_ < 4; ++i_) { raw_v[i_] = *(const u32x4*)(vu_ + (unsigned)(min((t_ >> 5) + 16 * i_, nv1) * 1024 + (t_ & 31) * 8)); raw_v[i_] = ((t_ >> 5) + 16 * i_ < nvalid) ? raw_v[i_] : z4; } } while (0)
    GLA_FETCH_KG(0);
    for (int c = 0; c < nch; ++c) {
        const int crow0 = row0 + 64 * c;
        if (tid < 256) { LAS float* gp_ = GAs + ((tid & 3) * 4) * 68 + (tid >> 2); gp_[0] = raw_ga[0]; gp_[68] = raw_ga[1]; gp_[136] = raw_ga[2]; gp_[204] = raw_ga[3]; }
        {
            LAS bf16_t* ks_st = opq(KS + (tid >> 4) * QST + (tid & 15) * 8);
#pragma unroll
            for (int i = 0; i < 2; ++i) { *(LAS u32x4*)(ks_st + 32 * i * QST) = raw_k[i]; if (FULL) *(LAS u32x4*)(ks_st - 64 * QST + 32 * i * QST) = raw_q[i]; }
        }
        u32x4 raw_v[4];
        GLA_FETCH_QV(c);
        __syncthreads();
        float bc[16]; float run = 0.f;
        const LAS float* ga_r = opq(GAs + 16 * tg);
        LAS float* cs_p = opq(CS + kk);
#pragma unroll
        for (int j = 0; j < 16; ++j) bc[j] = bal;
#pragma unroll
        for (int r2 = 0; r2 < 16; ++r2)
#pragma unroll
            for (int q4 = 0; q4 < 4; ++q4) { const f32x4 gq = *(const LAS f32x4*)(ga_r + r2 * 68 + q4 * 4);
#pragma unroll
                for (int e = 0; e < 4; ++e) bc[4 * q4 + e] += gq[e] * wal[r2]; }
#pragma unroll
        for (int j = 0; j < 16; ++j) { float la = log_sigmoid(bc[j]) * 0.0625f; if (PARTIAL) la = (16 * tg + j < nvalid) ? la : 0.f; run += la; bc[j] = run; }
        cs_p[tg * 128] = run;
        __syncthreads();
        float offs = 0.f, blast = 0.f;
#pragma unroll
        for (int g2 = 0; g2 < 4; ++g2) { const float cs = cs_p[g2 * 128]; blast += cs; if (g2 < tg) offs += cs; }
        const float eblast = fast_exp(blast);
        if (tg == 0) { EB[kk] = eblast; dsum += blast; }
        {
            LAS bf16_t* qs_e = opq(QS + (16 * tg) * QST + kk); LAS bf16_t* ks_e = qs_e + 64 * QST;
            LAS bf16_t* kdt_w = opq(KdT + kk * TST + 16 * tg);
            unsigned kdw[8];
#pragma unroll
            for (int j = 0; j < 16; j += 2) {
                const float b0 = bc[j] + offs, b1 = bc[j + 1] + offs;
                const float k0 = bf2f(ks_e[j * QST]), k1 = bf2f(ks_e[(j + 1) * QST]);
                const float e0 = fast_exp(b0), e1 = fast_exp(b1), r0 = __builtin_amdgcn_rcpf(e0), r1 = __builtin_amdgcn_rcpf(e1);
                const float kt0 = k0 * r0, kt1 = k1 * r1;
                kdw[j >> 1] = cvtpk(kt0 * eblast, kt1 * eblast);
                if (FULL) {
                    const float q0 = bf2f(qs_e[j * QST]), q1 = bf2f(qs_e[(j + 1) * QST]);
                    qs_e[j * QST] = f2bf(q0 * e0); qs_e[(j + 1) * QST] = f2bf(q1 * e1);
                    ks_e[j * QST] = f2bf(kt0); ks_e[(j + 1) * QST] = f2bf(kt1);
                }
            }
            *(LAS u32x4*)(kdt_w) = (u32x4){kdw[0], kdw[1], kdw[2], kdw[3]};
            *(LAS u32x4*)(kdt_w + 8) = (u32x4){kdw[4], kdw[5], kdw[6], kdw[7]};
        }
        {
            LAS bf16_t* vs_st = opq(VS + (tid >> 5) * VST + (tid & 31) * 8);
#pragma unroll
            for (int i = 0; i < 4; ++i) *(LAS u32x4*)(vs_st + 16 * i * VST) = raw_v[i];
        }
        if (c + 1 < nch) GLA_FETCH_KG(c + 1);
        __syncthreads();
        f32x16 oT[2]; u32x2 grv[2][4]; f32x4 hn[4];
        bf16x8 vfr[4];
        if (FULL) {
            if (w < 3) {
                const int tb = w == 0 ? 0 : 1, sb = w == 2 ? 1 : 0;
                const LAS bf16_t* qa_r = opq(QS + (32 * tb + r) * QST + 8 * h); const LAS bf16_t* kb_r = opq(KS + (32 * sb + r) * QST + 8 * h);
                f32x16 a = {0.f, 0.f, 0.f, 0.f, 0.f, 0.f, 0.f, 0.f, 0.f, 0.f, 0.f, 0.f, 0.f, 0.f, 0.f, 0.f};
#pragma unroll
                for (int s = 0; s < 8; ++s) {
                    const bf16x8 qa = *(const LAS bf16x8*)(qa_r + 16 * s);
                    const bf16x8 kb2 = *(const LAS bf16x8*)(kb_r + 16 * s);
                    a = MFMA32(qa, kb2, a);
                }
                LAS bf16_t* ab_w = opq(Ab + (32 * tb + 4 * h) * TST + 32 * sb + r);
                const int dl = 32 * sb + r - 32 * tb - 4 * h;
#pragma unroll
                for (int i = 0; i < 16; ++i) ab_w[((i & 3) + 8 * (i >> 2)) * TST] = f2bf(dl <= (i & 3) + 8 * (i >> 2) ? a[i] : 0.f);
            }
            const LAS bf16_t* qt_r4 = opq(QS + r * QST + 4 * h);
#pragma unroll
            for (int tb = 0; tb < 2; ++tb) oT[tb] = (f32x16){0.f, 0.f, 0.f, 0.f, 0.f, 0.f, 0.f, 0.f, 0.f, 0.f, 0.f, 0.f, 0.f, 0.f, 0.f, 0.f};
#pragma unroll
            for (int kb = 0; kb < 4; ++kb) {
#pragma unroll
                for (int s2 = 0; s2 < 2; ++s2) {
                    u32x4 sw; sw.x = cvtpk(Sacc[kb][8 * s2 + 0], Sacc[kb][8 * s2 + 1]); sw.y = cvtpk(Sacc[kb][8 * s2 + 2], Sacc[kb][8 * s2 + 3]);
                    sw.z = cvtpk(Sacc[kb][8 * s2 + 4], Sacc[kb][8 * s2 + 5]); sw.w = cvtpk(Sacc[kb][8 * s2 + 6], Sacc[kb][8 * s2 + 7]);
                    const bf16x8 sb = __builtin_bit_cast(bf16x8, sw);
#pragma unroll
                    for (int tb = 0; tb < 2; ++tb) {
                        const LAS bf16_t* qp = qt_r4 + (32 * tb) * QST + 32 * kb + 16 * s2;
                        const s16x4 lo = *(const LAS s16x4*)qp, hi = *(const LAS s16x4*)(qp + 8);
                        const bf16x8 qa = __builtin_shufflevector(lo, hi, 0, 1, 2, 3, 4, 5, 6, 7);
                        oT[tb] = MFMA32(sb, qa, oT[tb]);
                    }
                }
                __builtin_amdgcn_sched_barrier(0);
            }
            __syncthreads();
            {
                const LAS bf16_t* vt_r = opq(VS + (8 * h + ((lane & 15) >> 2)) * VST + 32 * w + 16 * ((lane >> 4) & 1) + 4 * (lane & 3));
#pragma unroll
                for (int s4 = 0; s4 < 4; ++s4) { const s16x4 vlo = tr16(vt_r + (16 * s4) * VST), vhi = tr16(vt_r + (16 * s4 + 4) * VST); vfr[s4] = __builtin_shufflevector(vlo, vhi, 0, 1, 2, 3, 4, 5, 6, 7); }
            }
#pragma unroll
            for (int tb = 0; tb < 2; ++tb)
#pragma unroll
                for (int q4 = 0; q4 < 4; ++q4) grv[tb][q4] = *(const u32x2*)(AB + (size_t)crow0 * 2048 + hd * 256 + 32 * w + 8 * q4 + (unsigned)(min(32 * tb + r, nv1) * 2048 + 4 * h));
#pragma unroll
            for (int q4 = 0; q4 < 4; ++q4) hn[q4] = *(const f32x4*)(head_norm + 32 * w + 4 * h + 8 * q4);
            const LAS bf16_t* ab_r = opq(Ab + r * TST + 8 * h);
#pragma unroll
            for (int tb = 0; tb < 2; ++tb)
#pragma unroll
                for (int sb = 0; sb < 2; ++sb) {
                    if (sb > tb) continue;
#pragma unroll
                    for (int s2 = 0; s2 < 2; ++s2) {
                        const bf16x8 aa = *(const LAS bf16x8*)(ab_r + (32 * tb) * TST + 32 * sb + 16 * s2);
                        oT[tb] = MFMA32(vfr[2 * sb + s2], aa, oT[tb]);
                    }
                }
        }
        const LAS bf16_t* kdt_r = opq(KdT + r * TST + 8 * h);
        if (!FULL) {
            const LAS bf16_t* vt_r2 = opq(VS + (8 * h + ((lane & 15) >> 2)) * VST + 32 * w + 16 * ((lane >> 4) & 1) + 4 * (lane & 3));
#pragma unroll
            for (int s4 = 0; s4 < 4; ++s4) { const s16x4 vlo = tr16(vt_r2 + (16 * s4) * VST), vhi = tr16(vt_r2 + (16 * s4 + 4) * VST); vfr[s4] = __builtin_shufflevector(vlo, vhi, 0, 1, 2, 3, 4, 5, 6, 7); }
        }
        const LAS float* eb_r = opq(EB + 4 * h);
#pragma unroll
        for (int kb = 0; kb < 4; ++kb) {
#pragma unroll
            for (int q4 = 0; q4 < 4; ++q4) { const f32x4 e = *(const LAS f32x4*)(eb_r + 32 * kb + 8 * q4);
#pragma unroll
                for (int e2 = 0; e2 < 4; ++e2) Sacc[kb][4 * q4 + e2] *= e[e2]; }
#pragma unroll
            for (int s = 0; s < 4; ++s) {
                const bf16x8 ka = *(const LAS bf16x8*)(kdt_r + (32 * kb) * TST + 16 * s);
                Sacc[kb] = MFMA32(ka, vfr[s], Sacc[kb]);
            }
            __builtin_amdgcn_sched_barrier(0);
        }
        LAS float* part_p = opq(PART + r);
        if (FULL) {
#pragma unroll
            for (int tb = 0; tb < 2; ++tb) { float p = 0.f;
#pragma unroll
                for (int i = 0; i < 16; ++i) p += oT[tb][i] * oT[tb][i];
                p += __shfl_xor(p, 32);
                if (h == 0) part_p[w * 64 + 32 * tb] = p; }
        }
        __syncthreads();
        if (FULL) {
#pragma unroll
            for (int tb = 0; tb < 2; ++tb) {
                float tot = 0.f;
#pragma unroll
                for (int w2 = 0; w2 < 8; ++w2) tot += part_p[w2 * 64 + 32 * tb];
                const float rs = __builtin_amdgcn_rsqf(tot * (1.0f / 256.0f) + EPS);
                if (32 * tb + r < nvalid) {
                    bf16_t* gp = (dummy ? dummy + (size_t)((crow0 + 32 * tb) & 2047) * 2048 : AB + (size_t)(crow0 + 32 * tb) * 2048) + hd * 256 + 32 * w + (unsigned)(r * 2048 + 4 * h);
#pragma unroll
                    for (int q4 = 0; q4 < 4; ++q4) {
                        const f32x4 g4 = (f32x4){bflo(grv[tb][q4].x), bfhi(grv[tb][q4].x), bflo(grv[tb][q4].y), bfhi(grv[tb][q4].y)};
                        f32x4 y;
#pragma unroll
                        for (int e = 0; e < 4; ++e) y[e] = oT[tb][4 * q4 + e] * rs * hn[q4][e] * siluf_(g4[e]);
                        *(u32x2*)(gp + 8 * q4) = (u32x2){cvtpk(y[0], y[1]), cvtpk(y[2], y[3])};
                    }
                }
            }
        }
    }
#undef GLA_FETCH_KG
#undef GLA_FETCH_QV
    if (Sout) {
#pragma unroll
        for (int kb = 0; kb < 4; ++kb)
#pragma unroll
            for (int i = 0; i < 16; ++i) Sout[(size_t)(32 * kb + crow(i, h)) * 256 + 32 * w + r] = Sacc[kb][i];
    }
    if (!FULL && tg == 0) Dout[kk] = fast_exp(dsum);
    __syncthreads();
}
}


namespace skinny {
typedef float f32x4v __attribute__((ext_vector_type(4)));
template <int NPARTS, int STEPS  , bool FINAL, class Epi>
__device__ __forceinline__ void phase(LAS unsigned char* lds, const bf16_t* A, int lda, const bf16_t* Bt, int ldb, int koff, float* ssq, int G, int bx, const Epi& E,
                                      const float* gain = nullptr, float* out = nullptr, unsigned* cnt = nullptr) {
    const int tid = threadIdx.x, lane = tid & 63, fr = lane & 15, fq = lane >> 4; const int w = __builtin_amdgcn_readfirstlane(tid >> 6);
    LAS f32x4* red = (LAS f32x4*)lds;
    LAS float* sred = (LAS float*)(lds + 8 * NPARTS * 4 * 64 * 16);
    constexpr int UB = STEPS > 4 ? 4 : STEPS;
    for (int pi = bx; pi < 256; pi += G) {
        const int rg = pi >> 4, cg = pi & 15;
        f32x4 acc[NPARTS][4];
#pragma unroll
        for (int p = 0; p < NPARTS; ++p) {
#pragma unroll
            for (int nt = 0; nt < 4; ++nt) acc[p][nt] = (f32x4){0.f, 0.f, 0.f, 0.f};
            const bf16_t* wp = Bt + (size_t)(64 * cg + fr) * ldb + p * koff + w * (STEPS * 32) + 8 * fq;
            const bf16_t* ap = A + (size_t)(MP + 16 * rg + fr) * lda + p * koff + w * (STEPS * 32) + 8 * fq;
            constexpr int NB = (STEPS + UB - 1) / UB;
            bf16x8 af[2][UB], wf[2][UB][4];
#define SK_LOAD(b_, s0_) do { _Pragma("unroll") for (int u = 0; u < UB; ++u) if ((s0_) + u < STEPS) { af[b_][u] = *(const bf16x8*)(ap + ((s0_) + u) * 32); \
                _Pragma("unroll") for (int nt = 0; nt < 4; ++nt) wf[b_][u][nt] = *(const bf16x8*)(wp + (size_t)(16 * nt) * ldb + ((s0_) + u) * 32); } } while (0)
#define SK_MMA(b_, s0_) do { _Pragma("unroll") for (int u = 0; u < UB; ++u) if ((s0_) + u < STEPS) { \
                _Pragma("unroll") for (int nt = 0; nt < 4; ++nt) acc[p][nt] = __builtin_amdgcn_mfma_f32_16x16x32_bf16(wf[b_][u][nt], af[b_][u], acc[p][nt], 0, 0, 0); } } while (0)
            SK_LOAD(0, 0);
#pragma unroll
            for (int b = 0; b < NB; ++b) {
                if (b + 1 < NB) { if ((b & 1) == 0) SK_LOAD(1, (b + 1) * UB); else SK_LOAD(0, (b + 1) * UB); }
                if ((b & 1) == 0) SK_MMA(0, b * UB); else SK_MMA(1, b * UB);
            }
#undef SK_LOAD
#undef SK_MMA
        }
#pragma unroll
        for (int p = 0; p < NPARTS; ++p)
#pragma unroll
            for (int nt = 0; nt < 4; ++nt) red[((w * NPARTS + p) * 4 + nt) * 64 + lane] = acc[p][nt];
        __syncthreads();
        f32x4 o = (f32x4){0.f, 0.f, 0.f, 0.f};
        if (w < 4) {
            f32x4 a2[NPARTS];
#pragma unroll
            for (int p = 0; p < NPARTS; ++p) { a2[p] = (f32x4){0.f, 0.f, 0.f, 0.f};
#pragma unroll
                for (int w2 = 0; w2 < 8; ++w2) a2[p] += red[((w2 * NPARTS + p) * 4 + w) * 64 + lane]; }
            const int row = MP + 16 * rg + fr, c0 = 64 * cg + 16 * w + 4 * fq;
            o = E(row, c0, a2);
            float s = (o[0] * o[0] + o[1] * o[1]) + (o[2] * o[2] + o[3] * o[3]);
            s += __shfl_xor(s, 16); s += __shfl_xor(s, 32);
            if (fq == 0) sred[w * 16 + fr] = s;
        }
        __syncthreads();
        if constexpr (FINAL) {
            float mine = 0.f; if (tid < 16) mine = (sred[tid] + sred[16 + tid]) + (sred[32 + tid] + sred[48 + tid]);
            LAS float* S = sred + 64;
            xchg_rstd(mine, S, 16, ssq + (size_t)(MP + 16 * rg) * 16, cg, 16, cnt + 64 * rg, 16u);
            if (w < 4) { const int row = MP + 16 * rg + fr, c0 = 64 * cg + 16 * w + 4 * fq; const f32x4 g4 = *(const f32x4*)(gain + c0); *(f32x4*)(out + (size_t)row * D + c0) = o * S[fr] * g4; }
        } else {
            if (ssq && tid < 16) ssq[(size_t)(MP + 16 * rg + tid) * 16 + cg] = (sred[tid] + sred[16 + tid]) + (sred[32 + tid] + sred[48 + tid]);
        }
        __syncthreads();
    }
}
__device__ __forceinline__ u32x2 pack4(const f32x4 v) { return (u32x2){cvtpk(v[0], v[1]), cvtpk(v[2], v[3])}; }
__device__ __forceinline__ f32x4 unpack4(const u32x2 w) { return (f32x4){bflo(w.x), bfhi(w.x), bflo(w.y), bfhi(w.y)}; }
template <bool BASE_BF16, bool OUT_F32, bool OUT_BF16> struct EpiResidual {
    const void* base; float* outf; bf16_t* outb; float scale;
    __device__ __forceinline__ f32x4 operator()(int row, int c0, const f32x4 (&acc)[1]) const {
        const size_t off = (size_t)row * D + c0;
        f32x4 b;
        if (BASE_BF16) b = unpack4(*(const u32x2*)((const bf16_t*)base + off)); else b = *(const f32x4*)((const float*)base + (off - (size_t)MP * D));
        const f32x4 v = b + acc[0] * scale;
        if (OUT_F32) *(f32x4*)(outf + off) = v;
        if (OUT_BF16) *(u32x2*)(outb + off) = pack4(v);
        return v;
    }
};
struct EpiMerge {
    bf16_t* G;
    __device__ __forceinline__ f32x4 operator()(int row, int c0, const f32x4 (&acc)[2]) const {
        bf16_t* pt = G + (size_t)row * 2048 + c0;
        const f32x4 rho = unpack4(*(const u32x2*)pt), sgb = unpack4(*(const u32x2*)(pt + 1024));
        const f32x4 m = sgb * (rho * acc[0] + acc[1]);
        *(u32x2*)pt = pack4(m);
        return m;
    }
};
}

__global__ void __launch_bounds__(NTHREADS, 2) fwd_kernel(Params P) {
    extern __shared__ __attribute__((aligned(16))) unsigned char lds_raw[];
    LAS unsigned char* lds = (LAS unsigned char*)lds_raw;
    volatile LAS unsigned* MISC = (volatile LAS unsigned*)(lds + MISC_OFF);
    const int tid = threadIdx.x, lane = tid & 63; const int wave = __builtin_amdgcn_readfirstlane(tid >> 6);
    const int G = gridDim.x, bx = blockIdx.x;
    unsigned char* ws = P.ws; float* out = P.out; unsigned char* outb = (unsigned char*)P.out;
    for (int u = tid; u < (LDS_BYTES - RING_BYTES) / 4; u += NTHREADS) ((LAS unsigned*)(lds + RING_BYTES))[u] = 0u;
    __syncthreads();
    const bool use_bar = (P.ph_hi - P.ph_lo) > 1;
    XcdBarrier bar; bar.bar = (unsigned*)(ws + WS_CTL); bar.x = 0; bar.st = nullptr;
    if (use_bar) bar = xcd_barrier_post((unsigned*)(ws + WS_CTL), MISC + 8);
    const int lo = P.ph_lo, hi = P.ph_hi;
#ifndef PHASE_MASK
#define PHASE_MASK 0xFFF
#endif
#define IN(k) (((PHASE_MASK >> (k)) & 1) && lo <= (k) && (k) < hi)
#define SEAM(k) do { if (IN(k) && IN((k) + 1)) xcd_barrier(bar); } while (0)
    float* ssq0 = (float*)(ws + WS_SSQ); float* ssq1 = (float*)(ws + WS_SSQ + SSQ_STRIDE); float* ssq2 = (float*)(ws + WS_SSQ + 2 * SSQ_STRIDE); float* ssq3 = (float*)(ws + WS_SSQ + 3 * SSQ_STRIDE);
    float* GA = (float*)(ws + WS_GA); float* DV = (float*)(ws + WS_DV);
    bf16_t* XA = (bf16_t*)(ws + WS_XA); bf16_t* QK = (bf16_t*)(ws + WS_QK); bf16_t* Vb = (bf16_t*)(ws + WS_V); bf16_t* Gb = (bf16_t*)(ws + WS_G); bf16_t* AB = (bf16_t*)(ws + WS_AB);
    bf16_t* SKV = (bf16_t*)(ws + WS_SKV); bf16_t* Hb = (bf16_t*)(ws + WS_H); float* X2F = (float*)(ws + WS_AB);
    bf16_t* Wup1 = (bf16_t*)(outb + OW_UP1); bf16_t* Wdn1 = (bf16_t*)(outb + OW_DN1); bf16_t* Win = (bf16_t*)(outb + OW_IN); bf16_t* Wbr = (bf16_t*)(outb + OW_BR);
    bf16_t* Wout = (bf16_t*)(outb + OW_OUT); bf16_t* Wup2 = (bf16_t*)(outb + OW_UP2); bf16_t* Wdn2 = (bf16_t*)(ws + WS_WDN2);
    float* DS = (float*)(outb + O_DS);
    const int gw = bx * NWAVES + wave, NGW = G * NWAVES;

    constexpr int G_UP = NUP / 32, G_DN = D / 32, G_IN = NIN_V / 32, G_BR = D / 32;
    constexpr int I_UP = (D / 64) * G_UP, I_DN = (FF / 64) * G_DN, I_IN = (D / 64) * G_IN, I_BR = (2048 / 64) * G_BR, I_OUT = (D / 64) * G_BR;
#define CONVERT_LIST(LIST, first_, stride_) do { LAS float* scr_ = (LAS float*)(lds + wave * 16384); \
        const int n_ = (LIST) == 0 ? I_UP : (LIST) == 1 ? I_DN + I_IN + I_BR + I_OUT : (LIST) == 2 ? I_UP : I_DN; \
        for (int it_ = (first_); it_ < n_; it_ += (stride_)) { int r_ = it_; \
            if ((LIST) == 0) { p0_transpose_item(P.in[6], D, NUP, 1, P.in[5], Wup1, scr_, r_, G_UP, lane); } \
            else if ((LIST) == 2) { p0_transpose_item(P.in[20], D, NUP, 1, P.in[19], Wup2, scr_, r_, G_UP, lane); } \
            else if ((LIST) == 3) { p0_transpose_item(P.in[21], FF, D, 0, nullptr, Wdn2, scr_, r_, G_DN, lane); } \
            else { if (r_ < I_DN) { p0_transpose_item(P.in[7], FF, D, 0, nullptr, Wdn1, scr_, r_, G_DN, lane); continue; } r_ -= I_DN; \
                   if (r_ < I_IN) { p0_transpose_item(P.in[9], D, 6672, 2, P.in[8], Win, scr_, r_, G_IN, lane); continue; } r_ -= I_IN; \
                   if (r_ < I_BR) { p0_transpose_item(P.in[17], 2048, D, 0, nullptr, Wbr, scr_, r_, G_BR, lane); continue; } r_ -= I_BR; \
                   p0_transpose_item(P.in[18], D, D, 0, nullptr, Wout, scr_, r_, G_BR, lane); } } } while (0)
#define CONVERT_ON_LIGHT(LIST, nwg_) do { const int rem_ = (nwg_) % G; const int nl_ = rem_ ? G - rem_ : G, lc_ = rem_ ? bx - rem_ : bx; \
        if (lc_ >= 0) CONVERT_LIST(LIST, lc_ * NWAVES + wave, nl_ * NWAVES); } while (0)
    const bool split_conv = (lo == 0 && hi == 12);
    if (IN(0)) {
        CONVERT_LIST(0, gw, NGW);
        if (!split_conv) { CONVERT_LIST(1, gw, NGW); CONVERT_LIST(2, gw, NGW); CONVERT_LIST(3, gw, NGW); }
        {
            f32x4 v[2][4], vn[2][4];
            auto xrow = [&](int m) -> const f32x4* { const float* xr = (m < MP) ? P.in[0] + (size_t)m * D : P.in[1] + (size_t)(m - MP) * D; return (const f32x4*)xr + lane; };
            int m0 = 2 * gw;
            if (m0 < M) {
#pragma unroll
                for (int q = 0; q < 2; ++q) { const f32x4* xv = xrow(m0 + q);
#pragma unroll
                    for (int j = 0; j < 4; ++j) v[q][j] = xv[64 * j]; }
            }
            for (; m0 < M; m0 += 2 * NGW) {
                const int mn = m0 + 2 * NGW; const bool more = mn < M;
                if (more) {
#pragma unroll
                    for (int q = 0; q < 2; ++q) { const f32x4* xv = xrow(mn + q);
#pragma unroll
                        for (int j = 0; j < 4; ++j) vn[q][j] = xv[64 * j]; }
                }
                float sq[2];
#pragma unroll
                for (int q = 0; q < 2; ++q) { float s2 = 0.f;
#pragma unroll
                    for (int j = 0; j < 4; ++j) s2 += (v[q][j][0] * v[q][j][0] + v[q][j][1] * v[q][j][1]) + (v[q][j][2] * v[q][j][2] + v[q][j][3] * v[q][j][3]);
                    sq[q] = wave_sum(s2); }
#pragma unroll
                for (int q = 0; q < 2; ++q) { const int m = m0 + q; u32x2* o8 = (u32x2*)(XA + (size_t)m * D) + lane;
#pragma unroll
                    for (int j = 0; j < 4; ++j) o8[64 * j] = (u32x2){cvtpk(v[q][j][0], v[q][j][1]), cvtpk(v[q][j][2], v[q][j][3])};
                    if (lane == 0) ssq0[(size_t)m * 16] = __builtin_amdgcn_rsqf(sq[q] * (1.0f / D) + EPS); }
                if (more) {
#pragma unroll
                    for (int q = 0; q < 2; ++q)
#pragma unroll
                        for (int j = 0; j < 4; ++j) v[q][j] = vn[q][j];
                }
            }
        }
    }
    SEAM(0);
    LAS float* rtab = (LAS float*)(lds + RING_BYTES + 2048);
#define RSTD_TABLE_FILL(S_, ssq_, DIRECT_) do { \
        for (int ui_ = 0; ui_ < 8; ++ui_) { pg8::Unit u_; if (!(S_).next(ui_, u_)) break; \
            if (tid < 256) { const int row_ = u_.pm * 256 + tid; rtab[ui_ * 256 + tid] = (DIRECT_) ? (ssq_)[(size_t)row_ * 16] : row_rstd((ssq_), row_); } } \
        __syncthreads(); } while (0)
    if (IN(1)) {
        pg8::Gemm g{XA, Wup1, D, D, D, 0}; pg8::Sched S; S.init(M, NUP, G, bx, 0);
        RSTD_TABLE_FILL(S, ssq0, true);
        pg8::EpiSwiglu E{Hb, rtab};
        pg8::gemm_phase(lds, g, S, E);
        if (split_conv) CONVERT_ON_LIGHT(1, (M / 256) * (NUP / 256));
    }
    SEAM(1);
    const bool stagger = (G == 256);
    const bool sk_early = stagger && ((bx >> 3) & 1) == 0;
    const int sk_piece = stagger ? (((bx >> 3) & 15) * 16 + 2 * (bx & 7) + (bx >> 7)) : bx;
    if (IN(2)) {
        pg8::Gemm g{Hb, Wdn1, FF, FF, FF, 0}; pg8::Sched S; S.init(MP, D, G, bx, 0);
        pg8::EpiResidual<true, false, true> E{XA, nullptr, nullptr, XA, ssq1, 0.5f};
        skinny::EpiResidual<true, false, true> Es{XA, nullptr, XA, 0.5f};
        if (sk_early) skinny::phase<1, FF / 256, false>(lds, Hb, FF, Wdn1, FF, 0, ssq1, G, sk_piece, Es);
        pg8::gemm_phase(lds, g, S, E);
        if (!sk_early) skinny::phase<1, FF / 256, false>(lds, Hb, FF, Wdn1, FF, 0, ssq1, G, sk_piece, Es);
    }
    SEAM(2);
    if (IN(3)) {
        pg8::Gemm g{XA, Win, D, D, D, 0}; pg8::Sched S; S.init(M, NIN_V, G, bx, 0);
        RSTD_TABLE_FILL(S, ssq1, false);
        pg8::EpiIn E{QK, Vb, Gb, AB, SKV, GA, rtab, P.in[13], P.in[14], out};
        pg8::gemm_phase(lds, g, S, E);
        if (split_conv) CONVERT_ON_LIGHT(2, (M / 256) * (NIN_V / 256));
    }
    SEAM(3);
    if (IN(4)) {
#ifndef P4_SKIP_GLA
#ifndef P4_SKIP_GLA_A
#if defined(PROBE_GLAA)
        for (int it = bx; it < 240; it += G) { const int bh = it / 15, sc = it % 15, b = bh >> 2, hd = bh & 3;
            gla::span<false, false>(lds, b * SEQ + sc * 256, 4, 64, hd, QK, Vb, AB, GA, P.in[10], P.in[11], P.in[12], nullptr, DS + (size_t)it * 32768, DV + (size_t)it * 128); }
#endif
        for (int it = bx; it < 240; it += G) { const int bh = it / 15, sc = it % 15, b = bh >> 2, hd = bh & 3;
            gla::span<false, false>(lds, b * SEQ + sc * 256, 4, 64, hd, QK, Vb, AB, GA, P.in[10], P.in[11], P.in[12], nullptr, DS + (size_t)it * 32768, DV + (size_t)it * 128); }
#endif
#ifndef P4_SKIP_GLA_S
        for (int s = (G - 1 - bx) ; s < 64; s += G) { const int db = s >> 2, hd = s & 3;
            gla::span<true, true>(lds, MP + db * 16, 1, 16, hd, QK, Vb, AB, GA, P.in[10], P.in[11], P.in[12], P.in[4] + (size_t)s * 32768, out + OUT_GS + (size_t)s * 32768, nullptr); }
#endif
#endif
#ifndef P4_SKIP_SWA
#if defined(PROBE_SWA)
        swa::phase(lds, bx, G, AB, (bf16_t*)(outb + 53 * MiB), SKV, P.in[2], P.in[3], P.in[15], P.in[16]);
#endif
        swa::phase(lds, bx, G, AB, nullptr, SKV, P.in[2], P.in[3], P.in[15], P.in[16]);
#endif
    }
    SEAM(4);
    if (IN(5)) {
        for (int gid = bx * NTHREADS + tid; gid < 16 * 8192; gid += G * NTHREADS) {
            const int bh = gid >> 13, e = gid & 8191, k = e >> 6;
            f32x4 ds[15]; float dd[15];
#pragma unroll
            for (int j = 0; j < 15; ++j) { ds[j] = *((const f32x4*)(DS + (size_t)(bh * 15 + j) * 32768) + e); dd[j] = DV[(size_t)(bh * 15 + j) * 128 + k]; }
            f32x4 Sv = (f32x4){0.f, 0.f, 0.f, 0.f};
#pragma unroll
            for (int j = 0; j < 15; ++j) { Sv = Sv * dd[j] + ds[j]; *((f32x4*)(DS + (size_t)(bh * 15 + j) * 32768) + e) = Sv; }
        }
    }
    SEAM(5);
    if (IN(6)) {
#if defined(PROBE_GLAC)
        for (int it = bx; it < 256; it += G) { const int bh = it >> 4, sc = it & 15, b = bh >> 2, hd = bh & 3;
            gla::span<true, false>(lds, b * SEQ + sc * 256, 4, 64, hd, QK, Vb, AB, GA, P.in[10], P.in[11], P.in[12], sc ? DS + (size_t)(bh * 15 + sc - 1) * 32768 : nullptr, nullptr, nullptr, (bf16_t*)(outb + 53 * MiB)); }
#endif
        for (int it = bx; it < 256; it += G) { const int bh = it >> 4, sc = it & 15, b = bh >> 2, hd = bh & 3;
            gla::span<true, false>(lds, b * SEQ + sc * 256, 4, 64, hd, QK, Vb, AB, GA, P.in[10], P.in[11], P.in[12], sc ? DS + (size_t)(bh * 15 + sc - 1) * 32768 : nullptr,
                            sc == 15 ? out + OUT_GP + (size_t)bh * 32768 : nullptr, nullptr); }
    }
    SEAM(6);
    if (IN(7)) {
        pg8::Gemm g{AB, Wbr, 2048, 2048, D, 1024}; pg8::Sched S; S.init(MP, D, G, bx, 1);
        pg8::EpiMerge E{Gb, Gb, 0x7fffffff};
        skinny::EpiMerge Es{Gb};
        if (sk_early) skinny::phase<2, D / 256, false>(lds, AB, 2048, Wbr, 2048, 1024, nullptr, G, sk_piece, Es);
        pg8::gemm_phase(lds, g, S, E);
        if (!sk_early) skinny::phase<2, D / 256, false>(lds, AB, 2048, Wbr, 2048, 1024, nullptr, G, sk_piece, Es);
    }
    SEAM(7);
    if (IN(8)) {
        pg8::Gemm g{Gb, Wout, 2048, D, D, 0}; pg8::Sched S; S.init(MP, D, G, bx, 0);
        pg8::EpiResidual<true, false, true> E{XA, nullptr, nullptr, QK, ssq2, 1.0f};
        skinny::EpiResidual<true, false, true> Es{XA, nullptr, QK, 1.0f};
        if (sk_early) skinny::phase<1, D / 256, false>(lds, Gb, 2048, Wout, D, 0, ssq2, G, sk_piece, Es);
        pg8::gemm_phase(lds, g, S, E);
        if (!sk_early) skinny::phase<1, D / 256, false>(lds, Gb, 2048, Wout, D, 0, ssq2, G, sk_piece, Es);
    }
    SEAM(8);
    if (IN(9)) {
        pg8::Gemm g{QK, Wup2, D, D, D, 0}; pg8::Sched S; S.init(M, NUP, G, bx, 0);
        RSTD_TABLE_FILL(S, ssq2, false);
        pg8::EpiSwiglu E{Hb, rtab};
        pg8::gemm_phase(lds, g, S, E);
        if (split_conv) CONVERT_ON_LIGHT(3, (M / 256) * (NUP / 256));
    }
    SEAM(9);
    const bool fuse_final = (G == 256) && IN(10) && IN(11);
    if (IN(10)) {
        pg8::Gemm g{Hb, Wdn2, FF, FF, FF, 0}; pg8::Sched S; S.init(MP, D, G, bx, 0);
        unsigned* xcnt = (unsigned*)(ws + WS_CTL) + 4096;
        if (fuse_final) {
            pg8::EpiFinal E{QK, out + OUT_Y, P.in[22], ssq3, xcnt, 0.5f};
            skinny::EpiResidual<true, false, false> Es{QK, nullptr, nullptr, 0.5f};
            if (sk_early) skinny::phase<1, FF / 256, true>(lds, Hb, FF, Wdn2, FF, 0, ssq3, G, sk_piece, Es, P.in[22], out + OUT_Y, xcnt + 64 * 64);
            pg8::gemm_phase(lds, g, S, E);
            if (!sk_early) skinny::phase<1, FF / 256, true>(lds, Hb, FF, Wdn2, FF, 0, ssq3, G, sk_piece, Es, P.in[22], out + OUT_Y, xcnt + 64 * 64);
        } else {
            pg8::EpiResidual<true, true, false> E{QK, nullptr, X2F, nullptr, ssq3, 0.5f};
            pg8::gemm_phase(lds, g, S, E);
            skinny::EpiResidual<true, true, false> Es{QK, X2F, nullptr, 0.5f};
            skinny::phase<1, FF / 256, false>(lds, Hb, FF, Wdn2, FF, 0, ssq3, G, bx, Es);
        }
    }
    if (!fuse_final) SEAM(10);
    if (IN(11) && !fuse_final) {
        const float* fn = P.in[22];
        for (int m = gw; m < M; m += NGW) {
            const float rs = row_rstd(ssq3, m);
            const f32x4* xv = (const f32x4*)(X2F + (size_t)m * D) + lane; f32x4* yv = (f32x4*)(out + OUT_Y + (size_t)m * D) + lane;
#pragma unroll
            for (int j = 0; j < 4; ++j) { const f32x4 g4 = *((const f32x4*)fn + lane + 64 * j); yv[64 * j] = xv[64 * j] * rs * g4; }
        }
    }
#undef IN
#undef SEAM
}

#ifndef N_LAUNCHES
#define N_LAUNCHES 1
#endif
extern "C" void kernel_launch(void* const* d_in, const int* in_sizes, int n_in, void* d_out, int out_size, void* d_ws, size_t ws_size, hipStream_t stream) {
    static int grid = 0;
    if (grid == 0) {
        if (n_in != 23 || ws_size < WS_END) { fprintf(stderr, "kernel_launch: unexpected inputs (n_in %d, ws %zu)\n", n_in, ws_size); grid = -1; return; }
        int dev = 0, cus = 0;
        if (hipGetDevice(&dev) != hipSuccess || hipDeviceGetAttribute(&cus, hipDeviceAttributeMultiprocessorCount, dev) != hipSuccess) { grid = -1; return; }
        if (hipFuncSetAttribute((const void*)fwd_kernel, hipFuncAttributeMaxDynamicSharedMemorySize, LDS_BYTES) != hipSuccess) { fprintf(stderr, "kernel_launch: hipFuncSetAttribute failed\n"); grid = -1; return; }
        (void)hipGetLastError();
        grid = cus;
    }
    if (grid < 0) return;
    (void)hipMemsetAsync((char*)d_ws + WS_CTL, 0, CTL_ZERO_BYTES, stream);
    Params p{};
    for (int i = 0; i < 23; ++i) p.in[i] = (const float*)d_in[i];
    p.out = (float*)d_out; p.ws = (unsigned char*)d_ws;
    if (N_LAUNCHES == 1) { p.ph_lo = 0; p.ph_hi = 12; hipLaunchKernelGGL(fwd_kernel, dim3(grid), dim3(NTHREADS), LDS_BYTES, stream, p); }
    else for (int k = 0; k < 12; ++k) { p.ph_lo = k; p.ph_hi = k + 1; hipLaunchKernelGGL(fwd_kernel, dim3(grid), dim3(NTHREADS), LDS_BYTES, stream, p); }
}
```

```cpp
#include <hip/hip_runtime.h>
#include <cstdio>
#include <cstdint>

#define LAS __attribute__((address_space(3)))
typedef unsigned short bf16_t;
typedef short bf16x8 __attribute__((ext_vector_type(8)));
typedef short s16x4 __attribute__((ext_vector_type(4)));
typedef float f32x4 __attribute__((ext_vector_type(4)));
typedef float f32x16 __attribute__((ext_vector_type(16)));
typedef unsigned u32x4 __attribute__((ext_vector_type(4)));
typedef unsigned u32x2 __attribute__((ext_vector_type(2)));
typedef float f32x2_t __attribute__((ext_vector_type(2)));
typedef __bf16 bf16x2_t __attribute__((ext_vector_type(2)));

constexpr int D = 1024, SEQ = 4096, NBATCH = 4, MP = NBATCH * SEQ, DBATCH = 16, DSEQ = 16, MS = DBATCH * DSEQ, M = MP + MS;
constexpr int FF = 2816, NUP = 2 * FF, NIN_V = 27 * 256;
constexpr int NCACHE = 128;
constexpr float EPS = 1e-6f;
constexpr float LOG2E = 1.4426950408889634f;

constexpr size_t MiB = 1u << 20;
constexpr size_t WS_CTL = 0, CTL_ZERO_BYTES = 64 * 1024;
constexpr size_t SSQ_BYTES = (size_t)M * 16 * 4;
constexpr size_t WS_SSQ = 65536, SSQ_STRIDE = SSQ_BYTES;
constexpr size_t WS_GA = WS_SSQ + 4 * SSQ_STRIDE;
constexpr size_t WS_DV = WS_GA + SSQ_BYTES;
constexpr size_t WS_XA = 5 * MiB + 512 * 1024;
constexpr size_t WS_QK = WS_XA + (size_t)M * 1024 * 2;
constexpr size_t WS_V = WS_QK + (size_t)M * 1024 * 2;
constexpr size_t WS_G = WS_V + (size_t)M * 1024 * 2;
constexpr size_t WS_AB = WS_G + (size_t)M * 2048 * 2;
constexpr size_t WS_SKV = WS_AB + (size_t)M * 2048 * 2;
constexpr size_t WS_WDN2 = WS_SKV + (size_t)M * 512 * 2;
constexpr size_t WS_END = WS_WDN2 + (size_t)1024 * FF * 2;
constexpr size_t WS_H = WS_V;
static_assert(WS_DV + 240 * 128 * 4 <= WS_XA && WS_XA + (size_t)M * 1024 * 2 <= WS_QK && WS_END <= 256 * MiB && (WS_GA % 16) == 0 && (WS_DV % 16) == 0 && (WS_WDN2 % 256) == 0, "ws map");
static_assert(WS_H + (size_t)M * FF * 2 <= WS_AB, "hidden overlay");
constexpr size_t OUT_Y = 0, OUT_KP = (size_t)M * D, OUT_VP = OUT_KP + 131072, OUT_GP = OUT_VP + 131072, OUT_KS = OUT_GP + 524288, OUT_VS = OUT_KS + 65536, OUT_GS = OUT_VS + 65536;
constexpr size_t OW_UP1 = 0, OW_DN1 = 11 * MiB, OW_IN = OW_DN1 + 5 * MiB + 512 * 1024, OW_BR = 30 * MiB, OW_OUT = 34 * MiB, OW_UP2 = 36 * MiB, OW_DN2 = 47 * MiB;
constexpr size_t O_DS = 0;
static_assert(OW_IN + (size_t)NIN_V * 1024 * 2 <= OW_BR && OW_DN2 + (size_t)1024 * FF * 2 <= (size_t)M * D * 4 && 240ull * 32768 * 4 <= OW_BR, "out map");

__device__ __forceinline__ unsigned cvtpk(float lo, float hi) { f32x2_t v = {lo, hi}; bf16x2_t b = __builtin_convertvector(v, bf16x2_t); return __builtin_bit_cast(unsigned, b); }
__device__ __forceinline__ float bf2f(unsigned short x) { return __uint_as_float((unsigned)x << 16); }
__device__ __forceinline__ float bflo(unsigned w) { return __uint_as_float(w << 16); }
__device__ __forceinline__ float bfhi(unsigned w) { return __uint_as_float(w & 0xffff0000u); }
__device__ __forceinline__ unsigned short f2bf(float f) { return (unsigned short)(cvtpk(f, 0.f) & 0xffffu); }
__device__ __forceinline__ float fast_exp(float x) { return __builtin_amdgcn_exp2f(x * LOG2E); }
__device__ __forceinline__ float sigmoidf_(float x) { return __builtin_amdgcn_rcpf(1.f + fast_exp(-x)); }
__device__ __forceinline__ float siluf_(float x) { return x * sigmoidf_(x); }
__device__ __forceinline__ int crow(int r, int hi) { return (r & 3) + 8 * (r >> 2) + 4 * hi; }
#if defined(__HIP_DEVICE_COMPILE__)
template <class T> __device__ __forceinline__ LAS T* opq(LAS T* p) { unsigned a = __builtin_bit_cast(unsigned, p); asm volatile("" : "+v"(a)); return __builtin_bit_cast(LAS T*, a); }
template <class T> __device__ __forceinline__ LAS T* opq_after(LAS T* p, float dep) { unsigned a = __builtin_bit_cast(unsigned, p); asm volatile("" : "+v"(a) : "v"(dep)); return __builtin_bit_cast(LAS T*, a); }
#else
template <class T> __device__ __forceinline__ LAS T* opq(LAS T* p) { return p; }
template <class T> __device__ __forceinline__ LAS T* opq_after(LAS T* p, float) { return p; }
#endif
#define LDS_WAIT() asm volatile("s_waitcnt lgkmcnt(0)" ::: "memory")
#define VM_WAIT() asm volatile("s_waitcnt vmcnt(0)" ::: "memory")
#define MFMA32(a, b, c) __builtin_amdgcn_mfma_f32_32x32x16_bf16((a), (b), (c), 0, 0, 0)

__device__ __forceinline__ float row_rstd(const float* ssq, int row) {
    const f32x4* p = (const f32x4*)(ssq + (size_t)row * 16);
    const f32x4 a = p[0], b = p[1], c = p[2], d = p[3];
    const float s = ((a[0] + a[1]) + (a[2] + a[3])) + ((b[0] + b[1]) + (b[2] + b[3])) + ((c[0] + c[1]) + (c[2] + c[3])) + ((d[0] + d[1]) + (d[2] + d[3]));
    return __builtin_amdgcn_rsqf(s * (1.0f / D) + EPS);
}


#define XC_SPIN_CAP (1u << 22)
__device__ __forceinline__ void xchg_rstd(float mine, LAS float* S, int nrows, float* slots, int myslot, int nslots, unsigned* cnt, unsigned need) {
    const int tid = threadIdx.x;
    if (tid < nrows) __hip_atomic_store((unsigned*)(slots + (size_t)tid * 16 + myslot), __float_as_uint(mine), __ATOMIC_RELAXED, __HIP_MEMORY_SCOPE_AGENT);
    asm volatile("s_waitcnt vmcnt(0)" ::: "memory");
    __syncthreads();
    if (tid < 64) {
        if (tid == 0) (void)__hip_atomic_fetch_add(cnt, 1u, __ATOMIC_RELAXED, __HIP_MEMORY_SCOPE_AGENT);
        unsigned sp = 0;
        while ((unsigned)__builtin_amdgcn_readfirstlane(__hip_atomic_load(cnt, __ATOMIC_RELAXED, __HIP_MEMORY_SCOPE_AGENT)) < need) { __builtin_amdgcn_s_sleep(2); if (++sp > XC_SPIN_CAP) break; }
        __builtin_amdgcn_fence(__ATOMIC_ACQUIRE, "agent");
        asm volatile("s_waitcnt vmcnt(0)" ::: "memory");
    }
    __syncthreads();
    if (tid < nrows) {
        float t = 0.f;
        for (int j = 0; j < nslots; ++j) t += __uint_as_float(__hip_atomic_load((unsigned*)(slots + (size_t)tid * 16 + j), __ATOMIC_RELAXED, __HIP_MEMORY_SCOPE_AGENT));
        S[tid] = __builtin_amdgcn_rsqf(t * (1.0f / D) + EPS);
    }
    __syncthreads();
}

namespace pg8 {
constexpr int BM = 256, BK = 64, HALF = 128, HTB = HALF * BK * 2, STAGE_BYTES = 8 * HTB, NXCD = 8, WGM = 4;
__host__ __device__ __forceinline__ int lds_byte(int r, int c) { const int st = (r >> 4) * 2 + (c >> 5), rr = r & 15, cc = c & 31, ob = rr * 64 + cc * 2; return st * 1024 + (ob ^ (((ob >> 9) & 1) << 5)); }
__host__ __device__ __forceinline__ void stage_rc(int b, int& R, int& C) { const int st = b / 1024, sb = b % 1024, swz = sb ^ (((sb >> 9) & 1) << 5); R = (st >> 1) * 16 + swz / 64; C = (st & 1) * 32 + (swz % 64) / 2; }
__host__ __device__ __forceinline__ int perm32(int rho) { const int n = rho >> 4, i = rho & 15; return 8 * (i >> 2) + 4 * n + (i & 3); }

struct Unit { int pm, pn, part, idx; };
struct Gemm { const bf16_t* A; const bf16_t* Bt; int lda, ldb, K; int koff; };

struct Sched {
    int nM, nN, nwg, G, c, psh;
    __device__ __forceinline__ void init(int M_, int N_, int G_, int c_, int psh_) { nM = M_ / BM; nN = N_ / BM; nwg = nM * nN; G = G_; c = c_; psh = psh_; }
    __device__ __forceinline__ bool next(int i, Unit& u) const {
        const long L = (long)(i >> psh) * G + c; if (L >= nwg) return false;
        int wgid = (int)L; { const int q = nwg / NXCD, r = nwg % NXCD, xcd = wgid % NXCD, off = wgid / NXCD; wgid = (xcd < r ? xcd * (q + 1) : r * (q + 1) + (xcd - r) * q) + off; }
        const int nig = WGM * nN, gid = wgid / nig, fm = gid * WGM, gsz = (nM - fm) < WGM ? (nM - fm) : WGM;
        u.pm = fm + ((wgid % nig) % gsz); u.pn = (wgid % nig) / gsz; u.part = i & ((1 << psh) - 1); u.idx = i; return true;
    }
};

typedef f32x4 Acc[2][2][4][2];

template <class Epi>
__device__ __forceinline__ void gemm_phase(LAS unsigned char* lds, const Gemm g, const Sched& S, const Epi& E) {
    const int tid = threadIdx.x, wid = __builtin_amdgcn_readfirstlane(tid >> 6), lane = tid & 63, wr = wid >> 2, wc = wid & 3, fr = lane & 15, fq = lane >> 4;
    const int K = g.K, nt = K / BK;
    unsigned voffA[2], voffB[2];
#pragma unroll
    for (int i = 0; i < 2; ++i) { int R, C; stage_rc(tid * 16 + i * 8192, R, C); const int Rb = (R & ~31) + perm32(R & 31);
        voffA[i] = (unsigned)(R * g.lda + C) * 2u; voffB[i] = (unsigned)(Rb * g.ldb + C) * 2u; }
    const size_t kstep = (size_t)(BK * 2);
    const size_t hstepA = (size_t)HALF * g.lda * 2, hstepB = (size_t)HALF * g.ldb * 2;
    const size_t tstepA = 2 * hstepA, tstepB = 2 * hstepB;
    const unsigned ldsw = (unsigned)wid * 1024u;
    const int aoff = lds_byte(wr * 64 + fr, fq * 8), boff = lds_byte(wc * 32 + fr, fq * 8);
#define PG8_SA(b, h) (((b) * 2 + (h)) * HTB)
#define PG8_SB(b, h) ((4 + (b) * 2 + (h)) * HTB)
#define PG8_STAGE(bufoff, gbase, voff) do { _Pragma("unroll") for (int _i = 0; _i < 2; ++_i) \
        __builtin_amdgcn_global_load_lds((const unsigned*)((const char*)(gbase) + (voff)[_i]), (LAS unsigned*)(lds + (bufoff) + ldsw + _i * 8192), 16, 0, 0); } while (0)
#define PG8_LDA(dst, b, h) do { _Pragma("unroll") for (int m = 0; m < 4; ++m) _Pragma("unroll") for (int k = 0; k < 2; ++k) dst[m][k] = *(const LAS bf16x8*)(lds + PG8_SA(b, h) + aoff + m * 2048 + k * 1024); } while (0)
#define PG8_LDB(dst, b, h) do { _Pragma("unroll") for (int n = 0; n < 2; ++n) _Pragma("unroll") for (int k = 0; k < 2; ++k) dst[n][k] = *(const LAS bf16x8*)(lds + PG8_SB(b, h) + boff + n * 2048 + k * 1024); } while (0)
#define PG8_MMA(ai, bj, At, Bt) do { __builtin_amdgcn_s_setprio(1); _Pragma("unroll") for (int m = 0; m < 4; ++m) _Pragma("unroll") for (int n = 0; n < 2; ++n) _Pragma("unroll") for (int k = 0; k < 2; ++k) \
        acc[ai][bj][m][n] = __builtin_amdgcn_mfma_f32_16x16x32_bf16(Bt[n][k], At[m][k], acc[ai][bj][m][n], 0, 0, 0); __builtin_amdgcn_s_setprio(0); } while (0)
#define PG8_WAIT_V(n) asm volatile("s_waitcnt vmcnt(" #n ")" ::: "memory")
#define PG8_WAIT_L(n) asm volatile("s_waitcnt lgkmcnt(" #n ")" ::: "memory")
#define PG8_BAR __builtin_amdgcn_s_barrier()
#define PG8_SCHED __builtin_amdgcn_sched_barrier(0)
    Unit cur, nxt; int ui = 0;
    if (!S.next(0, cur)) return;
    Acc acc;
#pragma unroll
    for (int a = 0; a < 2; ++a)
#pragma unroll
        for (int b = 0; b < 2; ++b)
#pragma unroll
            for (int m = 0; m < 4; ++m)
#pragma unroll
                for (int n = 0; n < 2; ++n) acc[a][b][m][n] = (f32x4){0.f, 0.f, 0.f, 0.f};
    bf16x8 At[4][2], B0[2][2], B1[2][2];
    const char* cA = (const char*)g.A + (size_t)cur.pm * tstepA + (size_t)cur.part * g.koff * 2; const char* cB = (const char*)g.Bt + (size_t)cur.pn * tstepB + (size_t)cur.part * g.koff * 2;
    PG8_STAGE(PG8_SB(0, 0), cB, voffB); PG8_STAGE(PG8_SB(0, 1), cB + hstepB, voffB); PG8_STAGE(PG8_SA(0, 0), cA, voffA); PG8_STAGE(PG8_SA(0, 1), cA + hstepA, voffA);
    if (wr == 1) PG8_BAR;
    PG8_WAIT_V(2); PG8_BAR;
    PG8_STAGE(PG8_SB(1, 0), cB + kstep, voffB); PG8_STAGE(PG8_SA(1, 0), cA + kstep, voffA); PG8_STAGE(PG8_SB(1, 1), cB + hstepB + kstep, voffB);
    PG8_WAIT_V(6); PG8_BAR;
    for (;;) {
        const bool has_next = S.next(ui + 1, nxt);
        const char* nA = has_next ? (const char*)g.A + (size_t)nxt.pm * tstepA + (size_t)nxt.part * g.koff * 2 : cA; const char* nB = has_next ? (const char*)g.Bt + (size_t)nxt.pn * tstepB + (size_t)nxt.part * g.koff * 2 : cB;
        for (int t = 0; t < nt; t += 2) {
            const bool last = (t == nt - 2);
            const char* a1 = cA + (size_t)(t + 1) * kstep;
            const char* a2 = last ? nA : cA + (size_t)(t + 2) * kstep; const char* b2 = last ? nB : cB + (size_t)(t + 2) * kstep;
            const char* a3 = a2 + kstep; const char* b3 = b2 + kstep;
            PG8_LDB(B0, 0, 0); PG8_LDB(B1, 0, 1); PG8_SCHED; PG8_LDA(At, 0, 0); PG8_STAGE(PG8_SA(1, 1), a1 + hstepA, voffA);
            PG8_WAIT_V(8); PG8_WAIT_L(0); PG8_BAR; PG8_MMA(0, 0, At, B0); PG8_MMA(0, 1, At, B1); PG8_BAR; PG8_SCHED;
            PG8_LDA(At, 0, 1); PG8_STAGE(PG8_SB(0, 0), b2, voffB); PG8_STAGE(PG8_SB(0, 1), b2 + hstepB, voffB); PG8_STAGE(PG8_SA(0, 0), a2, voffA);
            PG8_WAIT_V(8); PG8_WAIT_L(0); PG8_BAR; PG8_MMA(1, 0, At, B0); PG8_MMA(1, 1, At, B1); PG8_BAR; PG8_SCHED;
            PG8_LDB(B0, 1, 0); PG8_LDB(B1, 1, 1); PG8_SCHED; PG8_LDA(At, 1, 0); PG8_STAGE(PG8_SA(0, 1), a2 + hstepA, voffA);
            PG8_WAIT_V(8); PG8_WAIT_L(0); PG8_BAR; PG8_MMA(0, 0, At, B0); PG8_MMA(0, 1, At, B1); PG8_BAR; PG8_SCHED;
            PG8_LDA(At, 1, 1); PG8_STAGE(PG8_SB(1, 0), b3, voffB); PG8_STAGE(PG8_SB(1, 1), b3 + hstepB, voffB); PG8_STAGE(PG8_SA(1, 0), a3, voffA);
            PG8_WAIT_V(8); PG8_WAIT_L(0); PG8_BAR; PG8_MMA(1, 0, At, B0); PG8_MMA(1, 1, At, B1); PG8_BAR; PG8_SCHED;
        }
        if (wr == 0) PG8_BAR;
        if constexpr (!Epi::AFTER_DRAIN) E(acc, cur, wr, wc, fr, fq);
        if (!has_next) break;
        if (!(Epi::KEEP_PART0 && cur.part == 0))
#pragma unroll
        for (int a = 0; a < 2; ++a)
#pragma unroll
            for (int b = 0; b < 2; ++b)
#pragma unroll
                for (int m = 0; m < 4; ++m)
#pragma unroll
                    for (int n = 0; n < 2; ++n) acc[a][b][m][n] = (f32x4){0.f, 0.f, 0.f, 0.f};
        cur = nxt; cA = nA; cB = nB; ++ui;
        if (wr == 1) PG8_BAR;
    }
    PG8_WAIT_V(0);
    PG8_BAR;
    if constexpr (Epi::AFTER_DRAIN) E.fused(acc, cur, wr, wc, fr, fq, lds);
#undef PG8_SA
#undef PG8_SB
#undef PG8_STAGE
#undef PG8_LDA
#undef PG8_LDB
#undef PG8_MMA
#undef PG8_WAIT_V
#undef PG8_WAIT_L
#undef PG8_BAR
#undef PG8_SCHED
}

__device__ __forceinline__ u32x4 pack8(const f32x4 a, const f32x4 b) { u32x4 w; w.x = cvtpk(a[0], a[1]); w.y = cvtpk(a[2], a[3]); w.z = cvtpk(b[0], b[1]); w.w = cvtpk(b[2], b[3]); return w; }
__device__ __forceinline__ void unpack8(const u32x4 w, f32x4& a, f32x4& b) { a = (f32x4){bflo(w.x), bfhi(w.x), bflo(w.y), bfhi(w.y)}; b = (f32x4){bflo(w.z), bfhi(w.z), bflo(w.w), bfhi(w.w)}; }

struct EpiSwiglu {
    static constexpr bool AFTER_DRAIN = false, KEEP_PART0 = false;
    bf16_t* H; const LAS float* rtab;
    __device__ __forceinline__ void operator()(const Acc& acc, const Unit& u, int wr, int wc, int fr, int fq) const {
        const int col0 = u.pn * 128 + wc * 32 + 8 * fq;
        const LAS float* rt = rtab + u.idx * 256 + wr * 64 + fr;
#pragma unroll
        for (int ai = 0; ai < 2; ++ai)
#pragma unroll
            for (int m = 0; m < 4; ++m) {
                const int row = u.pm * BM + ai * HALF + wr * 64 + m * 16 + fr; const float r = rt[ai * HALF + m * 16];
                f32x4 h0, h1;
#pragma unroll
                for (int e = 0; e < 4; ++e) { h0[e] = siluf_(acc[ai][0][m][0][e] * r) * (acc[ai][1][m][0][e] * r); h1[e] = siluf_(acc[ai][0][m][1][e] * r) * (acc[ai][1][m][1][e] * r); }
                *(u32x4*)(H + (size_t)row * FF + col0) = pack8(h0, h1);
            }
    }
};
template <bool BASE_BF16, bool OUT_F32, bool OUT_BF16> struct EpiResidual {
    static constexpr bool AFTER_DRAIN = false, KEEP_PART0 = false;
    static_assert(BASE_BF16, "the residual stream is bf16");
    const void* base; const void* base_s; float* outf; bf16_t* outb; float* ssq; float scale;
    __device__ __forceinline__ void operator()(const Acc& acc, const Unit& u, int wr, int wc, int fr, int fq) const {
        const size_t off0 = (size_t)(u.pm * BM + wr * 64 + fr) * D + u.pn * BM + wc * 32 + 8 * fq;
        u32x4 bw[2][4][2];
#pragma unroll
        for (int ai = 0; ai < 2; ++ai)
#pragma unroll
            for (int m = 0; m < 4; ++m)
#pragma unroll
                for (int bj = 0; bj < 2; ++bj) bw[ai][m][bj] = *(const u32x4*)((const bf16_t*)base + off0 + (size_t)(ai * HALF + m * 16) * D + bj * HALF);
#pragma unroll
        for (int ai = 0; ai < 2; ++ai)
#pragma unroll
            for (int m = 0; m < 4; ++m) {
                const int row = u.pm * BM + ai * HALF + wr * 64 + m * 16 + fr; float s = 0.f;
#pragma unroll
                for (int bj = 0; bj < 2; ++bj) {
                    const size_t off = off0 + (size_t)(ai * HALF + m * 16) * D + bj * HALF;
                    f32x4 b0, b1; unpack8(bw[ai][m][bj], b0, b1);
                    const f32x4 v0 = b0 + acc[ai][bj][m][0] * scale, v1 = b1 + acc[ai][bj][m][1] * scale;
                    s += (v0[0] * v0[0] + v0[1] * v0[1]) + (v0[2] * v0[2] + v0[3] * v0[3]) + (v1[0] * v1[0] + v1[1] * v1[1]) + (v1[2] * v1[2] + v1[3] * v1[3]);
                    if (OUT_F32) { *(f32x4*)(outf + off) = v0; *(f32x4*)(outf + off + 4) = v1; }
                    if (OUT_BF16) *(u32x4*)(outb + off) = pack8(v0, v1);
                }
                s += __shfl_xor(s, 16); s += __shfl_xor(s, 32);
                if (fq == 0) ssq[(size_t)row * 16 + u.pn * 4 + wc] = s;
            }
    }
};
struct EpiIn {
    static constexpr bool AFTER_DRAIN = false, KEEP_PART0 = false;
    bf16_t *QK, *V, *G, *AB, *SKV; float* GA; const LAS float* rtab; const float *qn, *kn; float* out;
    __device__ __forceinline__ void operator()(const Acc& acc, const Unit& u, int wr, int wc, int fr, int fq) const {
        const int pn = u.pn, cpos = wc * 32 + 8 * fq;
        const LAS float* rt = rtab + u.idx * 256 + wr * 64 + fr;
        f32x4 gq[2][2];
        { const float* gn = pn < 16 ? qn : kn;
#pragma unroll
          for (int bj = 0; bj < 2; ++bj) { gq[bj][0] = *(const f32x4*)(gn + bj * 32 + 8 * fq); gq[bj][1] = *(const f32x4*)(gn + bj * 32 + 8 * fq + 4); } }
#pragma unroll
        for (int ai = 0; ai < 2; ++ai)
#pragma unroll
            for (int m = 0; m < 4; ++m) {
                const int row = u.pm * BM + ai * HALF + wr * 64 + m * 16 + fr; const float r = rt[ai * HALF + m * 16];
                f32x4 v[2][2];
#pragma unroll
                for (int bj = 0; bj < 2; ++bj)
#pragma unroll
                    for (int n = 0; n < 2; ++n) v[bj][n] = acc[ai][bj][m][n] * r;
                if (pn >= 18 && pn < 26) {
                    bf16_t* dst = G + (size_t)row * 2048 + (pn - 18) * 128 + cpos;
                    f32x4 r0, r1, s0, s1;
#pragma unroll
                    for (int e = 0; e < 4; ++e) {
                        const float ea0 = fast_exp(-v[0][0][e]), ea1 = fast_exp(-v[0][1][e]), eb0 = fast_exp(-v[1][0][e]), eb1 = fast_exp(-v[1][1][e]);
                        s0[e] = __builtin_amdgcn_rcpf(1.f + eb0); s1[e] = __builtin_amdgcn_rcpf(1.f + eb1);
                        r0[e] = (1.f + eb0) * __builtin_amdgcn_rcpf(1.f + ea0); r1[e] = (1.f + eb1) * __builtin_amdgcn_rcpf(1.f + ea1);
                    }
                    *(u32x4*)dst = pack8(r0, r1); *(u32x4*)(dst + 1024) = pack8(s0, s1);
                } else if (pn < 12 || pn == 17) {
                    bf16_t* dst; float sc = 1.f;
                    if (pn < 4) { dst = QK + (size_t)row * 1024 + pn * 256; if (pn < 2) sc = 0.08838834764831845f; }
                    else if (pn < 8) dst = V + (size_t)row * 1024 + (pn - 4) * 256;
                    else if (pn < 12) dst = AB + (size_t)row * 2048 + (pn - 8) * 256;
                    else dst = SKV + (size_t)row * 512 + 256;
#pragma unroll
                    for (int bj = 0; bj < 2; ++bj) *(u32x4*)(dst + bj * HALF + cpos) = pack8(v[bj][0] * sc, v[bj][1] * sc);
                    if (pn == 17) {
                        float* o = nullptr;
                        if (u.pm == 64) o = out + OUT_VS + (size_t)(row - MP) * 256;
                        else if ((u.pm & 15) == 15 && ai == 1) o = out + OUT_VP + (size_t)((row >> 12) * 128 + ((row & 4095) - 3968)) * 256;
                        if (o) {
#pragma unroll
                            for (int bj = 0; bj < 2; ++bj) { *(f32x4*)(o + bj * HALF + cpos) = v[bj][0]; *(f32x4*)(o + bj * HALF + cpos + 4) = v[bj][1]; }
                        }
                    }
                } else if (pn < 17) {
                    float s = 0.f;
#pragma unroll
                    for (int bj = 0; bj < 2; ++bj)
#pragma unroll
                        for (int n = 0; n < 2; ++n) s += (v[bj][n][0] * v[bj][n][0] + v[bj][n][1] * v[bj][n][1]) + (v[bj][n][2] * v[bj][n][2] + v[bj][n][3] * v[bj][n][3]);
                    s += __shfl_xor(s, 16); s += __shfl_xor(s, 32);
                    const float hr = __builtin_amdgcn_rsqf(s * (1.0f / 64.0f) + EPS);
                    const bool isq = pn < 16; const float sc = isq ? (0.125f * LOG2E) * hr : hr;
                    bf16_t* dst = isq ? AB + (size_t)row * 2048 + 1024 + ((pn - 12) * 4 + wc) * 64 : SKV + (size_t)row * 512 + wc * 64;
                    float* o = nullptr;
                    if (!isq) { if (u.pm == 64) o = out + OUT_KS + (size_t)(row - MP) * 256 + wc * 64;
                                else if ((u.pm & 15) == 15 && ai == 1) o = out + OUT_KP + (size_t)((row >> 12) * 128 + ((row & 4095) - 3968)) * 256 + wc * 64; }
#pragma unroll
                    for (int bj = 0; bj < 2; ++bj) {
                        const int ch = bj * 32 + 8 * fq;
                        const f32x4 w0 = v[bj][0] * sc * gq[bj][0], w1 = v[bj][1] * sc * gq[bj][1];
                        *(u32x4*)(dst + ch) = pack8(w0, w1);
                        if (o) { *(f32x4*)(o + ch) = w0; *(f32x4*)(o + ch + 4) = w1; }
                    }
                } else {
                    if (wc == 0 && fq < 2) { *(f32x4*)(GA + (size_t)row * 16 + 8 * fq) = v[0][0]; *(f32x4*)(GA + (size_t)row * 16 + 8 * fq + 4) = v[0][1]; }
                }
            }
    }
};
struct EpiMerge {
    static constexpr bool AFTER_DRAIN = false, KEEP_PART0 = true;
    bf16_t* G; bf16_t* Go; int omask;
    __device__ __forceinline__ void operator()(Acc& acc, const Unit& u, int wr, int wc, int fr, int fq) const {
        const size_t off0 = (size_t)(u.pm * BM + wr * 64 + fr) * 2048 + u.pn * BM + wc * 32 + 8 * fq + (u.part ? 1024 : 0);
        u32x4 gw[2][4][2];
#pragma unroll
        for (int ai = 0; ai < 2; ++ai)
#pragma unroll
            for (int m = 0; m < 4; ++m)
#pragma unroll
                for (int bj = 0; bj < 2; ++bj) gw[ai][m][bj] = *(const u32x4*)(G + off0 + (size_t)(ai * HALF + m * 16) * 2048 + bj * HALF);
#pragma unroll
        for (int ai = 0; ai < 2; ++ai)
#pragma unroll
            for (int m = 0; m < 4; ++m) {
                const int row = u.pm * BM + ai * HALF + wr * 64 + m * 16 + fr;
#pragma unroll
                for (int bj = 0; bj < 2; ++bj) {
                    f32x4 a0, a1; unpack8(gw[ai][m][bj], a0, a1);
                    if (u.part == 0) { acc[ai][bj][m][0] *= a0; acc[ai][bj][m][1] *= a1; }
                    else {
                        bf16_t* po = Go + (size_t)(row & omask) * 2048 + u.pn * BM + bj * HALF + wc * 32 + 8 * fq;
                        *(u32x4*)po = pack8(a0 * acc[ai][bj][m][0], a1 * acc[ai][bj][m][1]);
                    }
                }
            }
    }
};
struct EpiFinal {
    static constexpr bool AFTER_DRAIN = true, KEEP_PART0 = false;
    const bf16_t* base; float* out; const float* gain; float* slots; unsigned* cnt; float scale;
    __device__ __forceinline__ void fused(Acc& acc, const Unit& u, int wr, int wc, int fr, int fq, LAS unsigned char* lds) const {
        LAS float* Pw = (LAS float*)lds; LAS float* S = (LAS float*)(lds + 4096);
#pragma unroll
        for (int ai = 0; ai < 2; ++ai)
#pragma unroll
            for (int m = 0; m < 4; ++m) {
                const int rt = ai * HALF + wr * 64 + m * 16 + fr; const int row = u.pm * BM + rt; float s = 0.f;
#pragma unroll
                for (int bj = 0; bj < 2; ++bj) {
                    const size_t off = (size_t)row * D + u.pn * BM + bj * HALF + wc * 32 + 8 * fq;
                    f32x4 b0, b1; unpack8(*(const u32x4*)(base + off), b0, b1);
                    const f32x4 v0 = b0 + acc[ai][bj][m][0] * scale, v1 = b1 + acc[ai][bj][m][1] * scale;
                    acc[ai][bj][m][0] = v0; acc[ai][bj][m][1] = v1;
                    s += (v0[0] * v0[0] + v0[1] * v0[1]) + (v0[2] * v0[2] + v0[3] * v0[3]) + (v1[0] * v1[0] + v1[1] * v1[1]) + (v1[2] * v1[2] + v1[3] * v1[3]);
                }
                s += __shfl_xor(s, 16); s += __shfl_xor(s, 32);
                if (fq == 0) Pw[rt * 4 + wc] = s;
            }
        __syncthreads();
        float mine = 0.f;
        if (threadIdx.x < 256) { const f32x4 p = *(const LAS f32x4*)(Pw + threadIdx.x * 4); mine = (p[0] + p[1]) + (p[2] + p[3]); }
        xchg_rstd(mine, S, 256, slots + (size_t)u.pm * BM * 16, u.pn, 4, cnt + 64 * u.pm, 4u);
        f32x4 gg[2][2];
#pragma unroll
        for (int bj = 0; bj < 2; ++bj) { const int col = u.pn * BM + bj * HALF + wc * 32 + 8 * fq; gg[bj][0] = *(const f32x4*)(gain + col); gg[bj][1] = *(const f32x4*)(gain + col + 4); }
#pragma unroll
        for (int ai = 0; ai < 2; ++ai)
#pragma unroll
            for (int m = 0; m < 4; ++m) {
                const int rt = ai * HALF + wr * 64 + m * 16 + fr; const int row = u.pm * BM + rt; const float rs = S[rt];
#pragma unroll
                for (int bj = 0; bj < 2; ++bj) {
                    const int col = u.pn * BM + bj * HALF + wc * 32 + 8 * fq; const size_t off = (size_t)row * D + col;
                    *(f32x4*)(out + off) = acc[ai][bj][m][0] * rs * gg[bj][0]; *(f32x4*)(out + off + 4) = acc[ai][bj][m][1] * rs * gg[bj][1];
                }
            }
    }
};
}

#define XB_TMO      128
#define XB_XCNT(j)  (256  + 64 * (j))
#define XB_XSUB(j)  (1280 + 64 * (j))
#define XB_XGEN(j)  (2304 + 64 * (j))
#define XB_TOP      3328
#define XB_TOPGEN   3392
#define XCD_BAR_WORDS 3456
#define XB_SPIN_CAP (1u << 20)
__device__ __forceinline__ unsigned xb_ld(unsigned* p)              { return __hip_atomic_load(p, __ATOMIC_RELAXED, __HIP_MEMORY_SCOPE_AGENT); }
__device__ __forceinline__ unsigned xb_add(unsigned* p, unsigned v) { return __hip_atomic_fetch_add(p, v, __ATOMIC_RELAXED, __HIP_MEMORY_SCOPE_AGENT); }
__device__ __forceinline__ unsigned xb_xcc_id() { return (unsigned)__builtin_amdgcn_s_getreg((3 << 11) | 20) & 0xFu; }
#define XB_SPIN(cond, bar) do { unsigned _sp = 0; while (cond) { __builtin_amdgcn_s_sleep(1); \
    if ((++_sp & 255u) == 0u) { if (xb_ld(&(bar)[XB_TMO])) break; if (_sp > XB_SPIN_CAP) { atomicAdd(&(bar)[XB_TMO], 1u); break; } } } } while (0)
struct XcdBarrier { unsigned* bar; unsigned x; volatile LAS unsigned* st; };
__device__ __forceinline__ XcdBarrier xcd_barrier_post(unsigned* bar, volatile LAS unsigned* st) {
    XcdBarrier b; b.bar = bar; b.x = xb_xcc_id(); b.st = st;
    if (threadIdx.x == 0) (void)xb_add(&bar[XB_XCNT(b.x)], 1u);
    return b;
}
__device__ __forceinline__ void xcd_barrier_complete(unsigned* bar, unsigned x, unsigned& nloc, unsigned& nx) {
    const unsigned G = gridDim.x * gridDim.y * gridDim.z;
    unsigned sum, cnt, mine, sp = 0u;
    for (;;) {
        sum = 0u; cnt = 0u; mine = 0u;
#pragma unroll
        for (unsigned j = 0; j < 16; ++j) { const unsigned c = xb_ld(&bar[XB_XCNT(j)]); sum += c; cnt += (c > 0u) ? 1u : 0u; mine = (j == x) ? c : mine; }
        if (sum == G) break;
        __builtin_amdgcn_s_sleep(1);
        if ((++sp & 255u) == 0u) { if (xb_ld(&bar[XB_TMO])) break; if (sp > XB_SPIN_CAP) { atomicAdd(&bar[XB_TMO], 1u); break; } }
    }
    nloc = mine > 0u ? mine : 1u; nx = cnt > 0u ? cnt : 1u;
}
__device__ __forceinline__ void xcd_barrier(const XcdBarrier& b) {
    asm volatile("s_waitcnt vmcnt(0)" ::: "memory");
    __syncthreads();
    if (threadIdx.x == 0) {
        unsigned* bar = b.bar;
        __builtin_amdgcn_s_waitcnt(0);
        unsigned nloc = b.st[0], nx = b.st[1];
        if (nloc == 0u) { xcd_barrier_complete(bar, b.x, nloc, nx); b.st[0] = nloc; b.st[1] = nx; }
        const unsigned old = xb_add(&bar[XB_XSUB(b.x)], 1u);
        const unsigned gen = old / nloc;
        if (old + 1u == (gen + 1u) * nloc) {
            __builtin_amdgcn_fence(__ATOMIC_RELEASE, "agent");
            asm volatile("s_waitcnt vmcnt(0)" ::: "memory");
            const unsigned og = xb_add(&bar[XB_TOP], 1u);
            const unsigned tg = og / nx;
            if (og + 1u == (tg + 1u) * nx) xb_add(&bar[XB_TOPGEN], 1u);
            else XB_SPIN(xb_ld(&bar[XB_TOPGEN]) == tg, bar);
            __builtin_amdgcn_fence(__ATOMIC_ACQUIRE, "agent");
            xb_add(&bar[XB_XGEN(b.x)], 1u);
            asm volatile("s_waitcnt vmcnt(0)" ::: "memory");
        } else {
            XB_SPIN(xb_ld(&bar[XB_XGEN(b.x)]) == gen, bar);
            __builtin_amdgcn_fence(__ATOMIC_ACQUIRE, "agent");
            asm volatile("s_waitcnt vmcnt(0)" ::: "memory");
        }
    }
    __syncthreads();
}

constexpr int NWAVES = 8, NTHREADS = 512;
constexpr int RING_BYTES = 131072;
constexpr int MISC_OFF = RING_BYTES + 320;
constexpr int LDS_BYTES = 147456;

struct Params {
    const float* in[23]; float* out; unsigned char* ws; int ph_lo, ph_hi;
};

__device__ __forceinline__ float wave_sum(float v) {
#pragma unroll
    for (int o = 1; o < 64; o <<= 1) v += __shfl_xor(v, o);
    return v;
}

__device__ __forceinline__ int vgroup_src(int kind, int g, int& cnt) {
    cnt = 32;
    if (kind == 0) return g * 32;
    if (kind == 1) { const int pn = g >> 3, tg = g & 7; return (tg >> 2) * FF + pn * 128 + (tg & 3) * 32; }
    const int tile = g >> 3, tg = g & 7;
    if (tile < 12) return g * 32;
    if (tile < 17) { const int bj = tg >> 2, wc = tg & 3; const int base = tile < 16 ? 3088 + (tile - 12) * 256 : 4112; return base + 64 * wc + 32 * bj; }
    if (tile == 17) return 4368 + tg * 32;
    if (tile < 26) return 4624 + (tg >> 2) * 1024 + (tile - 18) * 128 + (tg & 3) * 32;
    if (tg == 0) { cnt = 16; return 3072; }
    cnt = 0; return 0;
}
__device__ __forceinline__ void p0_transpose_item(const float* W, int K, int Norig, int kind, const float* gain, bf16_t* WT, LAS float* scr, int item, int ngroups, int lane) {
    const int kb = item / ngroups, g = item % ngroups, k0 = 64 * kb;
    int cnt; const int src = vgroup_src(kind, g, cnt);
    const int n = lane & 31;
    const int ks = lane >> 3, n4 = (lane & 7) * 4; const bool okc = n4 < cnt;
    const float* wp = W + (size_t)(k0 + ks) * Norig + src + (okc ? n4 : 0);
    f32x4 v[8];
#pragma unroll
    for (int i = 0; i < 8; ++i) v[i] = *(const f32x4*)(wp + (size_t)(8 * i) * Norig);
    const int c = lane & 7;
    f32x4 g0 = (f32x4){1.f, 1.f, 1.f, 1.f}, g1 = g0;
    if (gain) { g0 = *(const f32x4*)(gain + k0 + 8 * c); g1 = *(const f32x4*)(gain + k0 + 8 * c + 4); }
#pragma unroll
    for (int i = 0; i < 8; ++i) { LAS float* sp = scr + (8 * i + ks) * 33 + n4;
#pragma unroll
        for (int e = 0; e < 4; ++e) sp[e] = okc ? v[i][e] : 0.f; }
    LDS_WAIT(); asm volatile("" ::: "memory");
#pragma unroll
    for (int j = 0; j < 4; ++j) { const int nn = (lane >> 3) + 8 * j; const LAS float* sr = scr + (8 * c) * 33 + nn;
        u32x4 o; o.x = cvtpk(sr[0 * 33] * g0[0], sr[1 * 33] * g0[1]); o.y = cvtpk(sr[2 * 33] * g0[2], sr[3 * 33] * g0[3]); o.z = cvtpk(sr[4 * 33] * g1[0], sr[5 * 33] * g1[1]); o.w = cvtpk(sr[6 * 33] * g1[2], sr[7 * 33] * g1[3]);
        *(u32x4*)(WT + (size_t)(g * 32 + nn) * K + k0 + 8 * c) = o; }
    LDS_WAIT(); asm volatile("" ::: "memory");
}

namespace swa {
constexpr int KST = 72, VSS = 96;
constexpr int OFF_K = 0, OFF_V = 192 * KST * 2, OFF_TBL = OFF_V + 192 * VSS * 2, LDS_USED = OFF_TBL + 4 * 256 * 4;
typedef short v4i16_t __attribute__((ext_vector_type(4)));
__device__ __forceinline__ s16x4 tr16(const LAS bf16_t* p) { return __builtin_bit_cast(s16x4, __builtin_amdgcn_ds_read_tr16_b64_v4i16((LAS v4i16_t*)p)); }
__device__ __forceinline__ int t5_bucket(int rel) {
    const int n = rel < 0 ? -rel : rel; const int ret = rel > 0 ? 16 : 0;
    if (n < 8) return ret + n;
    int large = 8 + (int)(2.0f * __log2f((float)n * 0.125f) + 1e-4f); if (large > 15) large = 15;
    return ret + large;
}
struct Item { int b, kh, c, kvmin, kvmax; bool samp; };
__device__ __forceinline__ Item decode(int item) {
    Item t; t.samp = item >= 1024;
    if (!t.samp) { t.b = item >> 8; t.kh = (item >> 6) & 3; t.c = item & 63; } else { const int s = item - 1024; t.b = s >> 2; t.kh = s & 3; t.c = 0; }
    t.kvmin = t.samp ? 0 : (t.c >= 2 ? 0 : 128 - 64 * t.c); t.kvmax = t.samp ? 144 : 192; return t;
}
__device__ __forceinline__ void fetch(const Item& t, const bf16_t* SKV, const float* cache_k, const float* cache_v, u32x4 (&kw)[3], u32x4 (&vw)[3]) {
    const int tid = threadIdx.x, ch = tid & 7;
#pragma unroll
    for (int i = 0; i < 3; ++i) {
        const int kv = (tid >> 3) + 64 * i;
        kw[i] = (u32x4){0u, 0u, 0u, 0u}; vw[i] = kw[i];
        if (t.samp && i < 2) {
            const float* pk = cache_k + ((size_t)(t.b * 128 + kv) * 4 + t.kh) * 64 + ch * 8; const float* pv = cache_v + ((size_t)(t.b * 128 + kv) * 4 + t.kh) * 64 + ch * 8;
            const f32x4 k0 = *(const f32x4*)pk, k1 = *(const f32x4*)(pk + 4), v0 = *(const f32x4*)pv, v1 = *(const f32x4*)(pv + 4);
            kw[i] = pg8::pack8(k0, k1); vw[i] = pg8::pack8(v0, v1);
        } else {
            const int kvc = kv < t.kvmin ? t.kvmin : (kv >= t.kvmax ? t.kvmax - 1 : kv);
            const size_t row = t.samp ? (size_t)(MP + t.b * 16 + (kvc - 128)) : (size_t)(t.b * SEQ + 64 * (t.c - 2) + kvc);
            const bf16_t* p = SKV + row * 512 + t.kh * 64 + ch * 8;
            kw[i] = *(const u32x4*)p; vw[i] = *(const u32x4*)(p + 256);
        }
    }
}
__device__ __forceinline__ void phase(LAS unsigned char* lds, int bx, int G, bf16_t* AB, bf16_t* dummy, const bf16_t* SKV, const float* cache_k, const float* cache_v, const float* sinks, const float* rel_bias) {
    const int tid = threadIdx.x, lane = tid & 63, r = lane & 31, h = lane >> 5; const int w = __builtin_amdgcn_readfirstlane(tid >> 6);
    LAS bf16_t* Ks = (LAS bf16_t*)(lds + OFF_K); LAS bf16_t* Vs = (LAS bf16_t*)(lds + OFF_V); LAS float* tbl = (LAS float*)(lds + OFF_TBL);
    constexpr int NITEMS = 1024 + 64;
    if (bx >= NITEMS) return;
    int cur_kh = -1;
    u32x4 kw[3], vw[3]; bf16x8 qn[4];
#define SWA_QFETCH(tt) do { size_t qrow_; int g_; if (!(tt).samp) { g_ = w >> 1; qrow_ = (size_t)((tt).b * SEQ + 64 * (tt).c + 32 * (w & 1) + r); } \
        else { const int ir_ = (32 * w + r) & 63; g_ = ir_ >> 4; qrow_ = (size_t)(MP + (tt).b * 16 + (ir_ & 15)); } \
        const bf16_t* Qp_ = AB + qrow_ * 2048 + 1024 + (4 * (tt).kh + g_) * 64; \
        _Pragma("unroll") for (int s_ = 0; s_ < 4; ++s_) qn[s_] = *(const bf16x8*)(Qp_ + 16 * s_ + 8 * h); } while (0)
    { const Item t0 = decode(bx); fetch(t0, SKV, cache_k, cache_v, kw, vw); SWA_QFETCH(t0); }
    asm volatile("" :: "v"(kw[0]), "v"(kw[1]), "v"(kw[2]), "v"(vw[0]), "v"(vw[1]), "v"(vw[2]));
    asm volatile("" :: "v"(qn[0]), "v"(qn[1]), "v"(qn[2]), "v"(qn[3]));
    for (int item = bx; item < NITEMS; item += G) {
        const Item t = decode(item);
        const bool samp = t.samp; const int b = t.b, kh = t.kh, c = t.c, kvmin = t.kvmin, kvmax = t.kvmax;
        {
            LAS bf16_t* kwp = opq(Ks + (tid >> 3) * KST + (tid & 7) * 8); LAS bf16_t* vwp = opq(Vs + (tid >> 3) * VSS + (tid & 7) * 8);
#pragma unroll
            for (int i = 0; i < 3; ++i) { const int kv = (tid >> 3) + 64 * i; const bool ok = kv >= kvmin && kv < kvmax; const u32x4 z4 = (u32x4){0u, 0u, 0u, 0u};
                *(LAS u32x4*)(kwp + 64 * i * KST) = ok ? kw[i] : z4; *(LAS u32x4*)(vwp + 64 * i * VSS) = ok ? vw[i] : z4; }
            if (kh != cur_kh) {
                LAS float* twp = opq(tbl + tid);
#pragma unroll
                for (int i = 0; i < 2; ++i) { const int idx = tid + 512 * i, g = idx >> 8, ii = idx & 255; twp[512 * i] = ii == 255 ? LOG2E * sinks[4 * kh + g] : LOG2E * rel_bias[t5_bucket(ii - 191) * 16 + 4 * kh + g]; }
                cur_kh = kh;
            }
        }
        __syncthreads();
        const bool active = !samp || w < 2;
        int g = 0, tq = 0;
        if (!samp) { g = w >> 1; tq = 32 * (w & 1) + r; }
        else { const int ir = (32 * w + r) & 63; g = ir >> 4; tq = ir & 15; }
        bf16x8 qf[4];
#pragma unroll
        for (int s = 0; s < 4; ++s) qf[s] = qn[s];
        if (item + G < NITEMS) { const Item tn = decode(item + G); fetch(tn, SKV, cache_k, cache_v, kw, vw); SWA_QFETCH(tn); }
        if (active) {
            f32x16 sc[6];
            {
                const LAS bf16_t* krp = opq(Ks + r * KST + 8 * h);
#pragma unroll
                for (int blk = 0; blk < 6; ++blk) {
                    f32x16 a = {0.f, 0.f, 0.f, 0.f, 0.f, 0.f, 0.f, 0.f, 0.f, 0.f, 0.f, 0.f, 0.f, 0.f, 0.f, 0.f};
#pragma unroll
                    for (int s = 0; s < 4; ++s) { const bf16x8 kf = *(const LAS bf16x8*)(krp + (32 * blk) * KST + 16 * s); a = MFMA32(kf, qf[s], a); }
                    sc[blk] = a;
                }
            }
            const float sink = tbl[g * 256 + 255];
            const LAS float* tb = opq(tbl + g * 256 + 63 - tq + 4 * h);
            const unsigned vm = (kvmax >= 192 ? 0xffffffu : ((1u << (kvmax >> 3)) - 1u)) & ~((1u << (kvmin >> 3)) - 1u);
            float mx = sink;
#pragma unroll
            for (int blk = 0; blk < 6; ++blk) {
#pragma unroll
                for (int i = 0; i < 16; ++i) { const float v = sc[blk][i] + tb[32 * blk + (i & 3) + 8 * (i >> 2)]; sc[blk][i] = v; mx = fmaxf(mx, v); }
                __builtin_amdgcn_sched_barrier(0);
            }
            mx = fmaxf(mx, __shfl_xor(mx, 32));
            float l = 0.f;
#pragma unroll
            for (int blk = 0; blk < 6; ++blk)
#pragma unroll
                for (int q4 = 0; q4 < 4; ++q4) {
                    const float vf = (float)((vm >> (4 * blk + q4)) & 1u);
                    float ps = 0.f;
#pragma unroll
                    for (int e = 0; e < 4; ++e) { const float p = __builtin_amdgcn_exp2f(sc[blk][4 * q4 + e] - mx) * vf; sc[blk][4 * q4 + e] = p; ps += p; }
                    l += ps;
                }
            l += __shfl_xor(l, 32);
            l += __builtin_amdgcn_exp2f(sink - mx);
            const float inv = 1.0f / l;
            f32x16 o[2];
#pragma unroll
            for (int d = 0; d < 2; ++d) o[d] = (f32x16){0.f, 0.f, 0.f, 0.f, 0.f, 0.f, 0.f, 0.f, 0.f, 0.f, 0.f, 0.f, 0.f, 0.f, 0.f, 0.f};
            const LAS bf16_t* vrp = opq_after(Vs + (4 * h + ((lane & 15) >> 2)) * VSS + 16 * ((lane >> 4) & 1) + 4 * (lane & 3), inv);
#pragma unroll
            for (int blk = 0; blk < 6; ++blk) {
#pragma unroll
                for (int s2 = 0; s2 < 2; ++s2) {
                    u32x4 pw; pw.x = cvtpk(sc[blk][8 * s2 + 0] * inv, sc[blk][8 * s2 + 1] * inv); pw.y = cvtpk(sc[blk][8 * s2 + 2] * inv, sc[blk][8 * s2 + 3] * inv);
                    pw.z = cvtpk(sc[blk][8 * s2 + 4] * inv, sc[blk][8 * s2 + 5] * inv); pw.w = cvtpk(sc[blk][8 * s2 + 6] * inv, sc[blk][8 * s2 + 7] * inv);
                    const bf16x8 pa = __builtin_bit_cast(bf16x8, pw);
#pragma unroll
                    for (int d = 0; d < 2; ++d) {
                        const LAS bf16_t* vp = vrp + (32 * blk + 16 * s2) * VSS + 32 * d;
                        const s16x4 lo = tr16(vp), hi = tr16(vp + 8 * VSS);
                        const bf16x8 vb = __builtin_shufflevector(lo, hi, 0, 1, 2, 3, 4, 5, 6, 7);
                        o[d] = MFMA32(pa, vb, o[d]);
                    }
                }
                __builtin_amdgcn_sched_barrier(0);
            }
            {
                const size_t orow0 = samp ? (size_t)(MP + b * 16) : (size_t)(b * SEQ + 64 * c + 32 * (w & 1));
                const int og0 = samp ? 2 * w : (w >> 1);
                bf16_t* ub = (dummy ? dummy + (orow0 & 2047) * 2048 : AB + orow0 * 2048) + 1024 + (4 * kh + og0) * 64;
                const unsigned lo = (unsigned)(4 * h * 2048 + r);
#pragma unroll
                for (int i = 0; i < 16; ++i) {
                    const int ro = samp ? ((i & 3) + 8 * ((i >> 2) & 1)) * 2048 + (i >> 3) * 64 : ((i & 3) + 8 * (i >> 2)) * 2048;
                    (ub + ro)[lo] = f2bf(o[0][i]); (ub + ro + 32)[lo] = f2bf(o[1][i]);
                }
            }
        }
        __syncthreads();
    }
#undef SWA_QFETCH
}
}

namespace gla {
constexpr int QST = 136, TST = 72, VST = 288;
constexpr int OFF_QS = 0, OFF_KS = OFF_QS + 64 * QST * 2, OFF_KDT = OFF_KS + 64 * QST * 2, OFF_A = OFF_KDT + 128 * TST * 2, OFF_VS = OFF_A + 64 * TST * 2;
constexpr int OFF_GA = OFF_VS + 64 * VST * 2, OFF_EB = OFF_GA + 16 * 68 * 4, OFF_CS = OFF_EB + 512, OFF_PART = OFF_CS + 2048, LDS_USED = OFF_PART + 2048;
static_assert(LDS_USED <= RING_BYTES && (OFF_VS % 16) == 0, "gla lds");
typedef short v4i16_t __attribute__((ext_vector_type(4)));
__device__ __forceinline__ s16x4 tr16(const LAS bf16_t* p) { return __builtin_bit_cast(s16x4, __builtin_amdgcn_ds_read_tr16_b64_v4i16((LAS v4i16_t*)p)); }
__device__ __forceinline__ float log_sigmoid(float z) { const float az = fabsf(z); return fminf(z, 0.f) - 0.6931471805599453f * __builtin_amdgcn_logf(1.f + __builtin_amdgcn_exp2f(-az * LOG2E)); }

template <bool FULL, bool PARTIAL  >
__device__ __forceinline__ void span(LAS unsigned char* lds, int row0, int nch, int nvalid_, int hd, const bf16_t* QK, const bf16_t* V, bf16_t* AB, const float* GA,
                                     const float* w_alpha, const float* b_alpha, const float* head_norm, const float* S0, float* Sout, float* Dout, bf16_t* dummy = nullptr) {
    const int tid = threadIdx.x, lane = tid & 63, r = lane & 31, h = lane >> 5; const int w = __builtin_amdgcn_readfirstlane(tid >> 6);
    const int kk = tid & 127, tg = tid >> 7;
    const int nvalid = PARTIAL ? nvalid_ : 64;
    LAS bf16_t* QS = (LAS bf16_t*)(lds + OFF_QS); LAS bf16_t* KS = (LAS bf16_t*)(lds + OFF_KS); LAS bf16_t* KdT = (LAS bf16_t*)(lds + OFF_KDT); LAS bf16_t* Ab = (LAS bf16_t*)(lds + OFF_A);
    LAS bf16_t* VS = (LAS bf16_t*)(lds + OFF_VS); LAS float* GAs = (LAS float*)(lds + OFF_GA); LAS float* EB = (LAS float*)(lds + OFF_EB); LAS float* CS = (LAS float*)(lds + OFF_CS);
    LAS float* PART = (LAS float*)(lds + OFF_PART);
    float wal[16];
#pragma unroll
    for (int i = 0; i < 16; ++i) wal[i] = w_alpha[i * 512 + hd * 128 + kk];
    const float bal = b_alpha[hd * 128 + kk];
    f32x16 Sacc[4];
    if (FULL && S0) {
        const float* s0p = S0 + (size_t)(4 * h) * 256 + 32 * w + r;
#pragma unroll
        for (int kb = 0; kb < 4; ++kb)
#pragma unroll
            for (int i = 0; i < 16; ++i) Sacc[kb][i] = s0p[(32 * kb + (i & 3) + 8 * (i >> 2)) * 256];
    } else {
#pragma unroll
        for (int kb = 0; kb < 4; ++kb)
#pragma unroll
            for (int i = 0; i < 16; ++i) Sacc[kb][i] = 0.f;
    }
    float dsum = 0.f;
    f32x4 raw_ga; u32x4 raw_k[2], raw_q[2];
    const int nv1 = nvalid - 1;
    const u32x4 z4 = (u32x4){0u, 0u, 0u, 0u};
#define GLA_FETCH_KG(cc) do { const int crow_ = row0 + 64 * (cc); int t_ = tid; asm volatile("" : "+v"(t_)); \
        const float* gau_ = GA + (size_t)crow_ * 16; const bf16_t* qku_ = QK + (size_t)crow_ * 1024 + hd * 128; \
        raw_ga = *(const f32x4*)(gau_ + (unsigned)(min(t_ >> 2, nv1) * 16 + (t_ & 3) * 4)); if (PARTIAL) { if ((t_ >> 2) >= nvalid) raw_ga = (f32x4){0.f, 0.f, 0.f, 0.f}; } \
        _Pragma("unroll") for (int i_ = 0; i_ < 2; ++i_) { raw_k[i_] = *(const u32x4*)(qku_ + 512 + (unsigned)(min((t_ >> 4) + 32 * i_, nv1) * 1024 + (t_ & 15) * 8)); if (PARTIAL) raw_k[i_] = ((t_ >> 4) + 32 * i_ < nvalid) ? raw_k[i_] : z4; \
            if (FULL) { raw_q[i_] = *(const u32x4*)(qku_ + (unsigned)(min((t_ >> 4) + 32 * i_, nv1) * 1024 + (t_ & 15) * 8)); if (PARTIAL) raw_q[i_] = ((t_ >> 4) + 32 * i_ < nvalid) ? raw_q[i_] : z4; } } } while (0)
#define GLA_FETCH_QV(cc) do { const int crow_ = row0 + 64 * (cc); int t_ = tid; asm volatile("" : "+v"(t_)); \
        const bf16_t* vu_ = V + (size_t)crow_ * 1024 + hd * 256; const bf16_t* qku_ = QK + (size_t)crow_ * 1024 + hd * 128; \
        _Pragma("unroll") for (int i_ = 0; i_ < 4; ++i_) { raw_v[i_] = *(const u32x4*)(vu_ + (unsigned)(min((t_ >> 5) + 16 * i_, nv1) * 1024 + (t_ & 31) * 8)); if (PARTIAL) raw_v[i_] = ((t_ >> 5) + 16 * i_ < nvalid) ? raw_v[i_] : z4; } } while (0)
    GLA_FETCH_KG(0);
    asm volatile("" :: "v"(raw_ga), "v"(raw_k[0]), "v"(raw_k[1]));
    if (FULL) asm volatile("" :: "v"(raw_q[0]), "v"(raw_q[1]));
    for (int c = 0; c < nch; ++c) {
        const int crow0 = row0 + 64 * c;
        if (tid < 256) { LAS float* gp_ = GAs + ((tid & 3) * 4) * 68 + (tid >> 2); gp_[0] = raw_ga[0]; gp_[68] = raw_ga[1]; gp_[136] = raw_ga[2]; gp_[204] = raw_ga[3]; }
        {
            LAS bf16_t* ks_st = opq(KS + (tid >> 4) * QST + (tid & 15) * 8);
#pragma unroll
            for (int i = 0; i < 2; ++i) { *(LAS u32x4*)(ks_st + 32 * i * QST) = raw_k[i]; if (FULL) *(LAS u32x4*)(ks_st - 64 * QST + 32 * i * QST) = raw_q[i]; }
        }
        u32x4 raw_v[4];
        GLA_FETCH_QV(c);
        __syncthreads();
        float bc[16]; float run = 0.f;
        const LAS float* ga_r = opq(GAs + 16 * tg);
        LAS float* cs_p = opq(CS + kk);
#pragma unroll
        for (int j = 0; j < 16; ++j) bc[j] = bal;
#pragma unroll
        for (int r2 = 0; r2 < 16; ++r2)
#pragma unroll
            for (int q4 = 0; q4 < 4; ++q4) { const f32x4 gq = *(const LAS f32x4*)(ga_r + r2 * 68 + q4 * 4);
#pragma unroll
                for (int e = 0; e < 4; ++e) bc[4 * q4 + e] += gq[e] * wal[r2]; }
#pragma unroll
        for (int j = 0; j < 16; ++j) { float la = log_sigmoid(bc[j]) * 0.0625f; if (PARTIAL) la = (16 * tg + j < nvalid) ? la : 0.f; run += la; bc[j] = run; }
        cs_p[tg * 128] = run;
        __syncthreads();
        float offs = 0.f, blast = 0.f;
#pragma unroll
        for (int g2 = 0; g2 < 4; ++g2) { const float cs = cs_p[g2 * 128]; blast += cs; if (g2 < tg) offs += cs; }
        const float eblast = fast_exp(blast);
        if (tg == 0) { EB[kk] = eblast; dsum += blast; }
        {
            LAS bf16_t* qs_e = opq(QS + (16 * tg) * QST + kk); LAS bf16_t* ks_e = qs_e + 64 * QST;
            LAS bf16_t* kdt_w = opq(KdT + kk * TST + 16 * tg);
            unsigned kdw[8];
#pragma unroll
            for (int j = 0; j < 16; j += 2) {
                const float b0 = bc[j] + offs, b1 = bc[j + 1] + offs;
                const float k0 = bf2f(ks_e[j * QST]), k1 = bf2f(ks_e[(j + 1) * QST]);
                const float e0 = fast_exp(b0), e1 = fast_exp(b1), r0 = __builtin_amdgcn_rcpf(e0), r1 = __builtin_amdgcn_rcpf(e1);
                const float kt0 = k0 * r0, kt1 = k1 * r1;
                kdw[j >> 1] = cvtpk(kt0 * eblast, kt1 * eblast);
                if (FULL) {
                    const float q0 = bf2f(qs_e[j * QST]), q1 = bf2f(qs_e[(j + 1) * QST]);
                    qs_e[j * QST] = f2bf(q0 * e0); qs_e[(j + 1) * QST] = f2bf(q1 * e1);
                    ks_e[j * QST] = f2bf(kt0); ks_e[(j + 1) * QST] = f2bf(kt1);
                }
            }
            *(LAS u32x4*)(kdt_w) = (u32x4){kdw[0], kdw[1], kdw[2], kdw[3]};
            *(LAS u32x4*)(kdt_w + 8) = (u32x4){kdw[4], kdw[5], kdw[6], kdw[7]};
        }
        {
            LAS bf16_t* vs_st = opq(VS + (tid >> 5) * VST + (tid & 31) * 8);
#pragma unroll
            for (int i = 0; i < 4; ++i) *(LAS u32x4*)(vs_st + 16 * i * VST) = raw_v[i];
        }
        if (c + 1 < nch) GLA_FETCH_KG(c + 1);
        __syncthreads();
        f32x16 oT[2]; u32x2 grv[2][4]; f32x4 hn[4];
        bf16x8 vfr[4];
        if (FULL) {
            if (w < 3) {
                const int tb = w == 0 ? 0 : 1, sb = w == 2 ? 1 : 0;
                const LAS bf16_t* qa_r = opq(QS + (32 * tb + r) * QST + 8 * h); const LAS bf16_t* kb_r = opq(KS + (32 * sb + r) * QST + 8 * h);
                f32x16 a = {0.f, 0.f, 0.f, 0.f, 0.f, 0.f, 0.f, 0.f, 0.f, 0.f, 0.f, 0.f, 0.f, 0.f, 0.f, 0.f};
#pragma unroll
                for (int s = 0; s < 8; ++s) {
                    const bf16x8 qa = *(const LAS bf16x8*)(qa_r + 16 * s);
                    const bf16x8 kb2 = *(const LAS bf16x8*)(kb_r + 16 * s);
                    a = MFMA32(qa, kb2, a);
                }
                LAS bf16_t* ab_w = opq(Ab + (32 * tb + 4 * h) * TST + 32 * sb + r);
                const int dl = 32 * sb + r - 32 * tb - 4 * h;
#pragma unroll
                for (int i = 0; i < 16; ++i) ab_w[((i & 3) + 8 * (i >> 2)) * TST] = f2bf(dl <= (i & 3) + 8 * (i >> 2) ? a[i] : 0.f);
            }
            const LAS bf16_t* qt_r4 = opq(QS + r * QST + 4 * h);
#pragma unroll
            for (int tb = 0; tb < 2; ++tb) oT[tb] = (f32x16){0.f, 0.f, 0.f, 0.f, 0.f, 0.f, 0.f, 0.f, 0.f, 0.f, 0.f, 0.f, 0.f, 0.f, 0.f, 0.f};
#pragma unroll
            for (int kb = 0; kb < 4; ++kb) {
#pragma unroll
                for (int s2 = 0; s2 < 2; ++s2) {
                    u32x4 sw; sw.x = cvtpk(Sacc[kb][8 * s2 + 0], Sacc[kb][8 * s2 + 1]); sw.y = cvtpk(Sacc[kb][8 * s2 + 2], Sacc[kb][8 * s2 + 3]);
                    sw.z = cvtpk(Sacc[kb][8 * s2 + 4], Sacc[kb][8 * s2 + 5]); sw.w = cvtpk(Sacc[kb][8 * s2 + 6], Sacc[kb][8 * s2 + 7]);
                    const bf16x8 sb = __builtin_bit_cast(bf16x8, sw);
#pragma unroll
                    for (int tb = 0; tb < 2; ++tb) {
                        const LAS bf16_t* qp = qt_r4 + (32 * tb) * QST + 32 * kb + 16 * s2;
                        const s16x4 lo = *(const LAS s16x4*)qp, hi = *(const LAS s16x4*)(qp + 8);
                        const bf16x8 qa = __builtin_shufflevector(lo, hi, 0, 1, 2, 3, 4, 5, 6, 7);
                        oT[tb] = MFMA32(sb, qa, oT[tb]);
                    }
                }
                __builtin_amdgcn_sched_barrier(0);
            }
            __syncthreads();
            {
                const LAS bf16_t* vt_r = opq(VS + (8 * h + ((lane & 15) >> 2)) * VST + 32 * w + 16 * ((lane >> 4) & 1) + 4 * (lane & 3));
#pragma unroll
                for (int s4 = 0; s4 < 4; ++s4) { const s16x4 vlo = tr16(vt_r + (16 * s4) * VST), vhi = tr16(vt_r + (16 * s4 + 4) * VST); vfr[s4] = __builtin_shufflevector(vlo, vhi, 0, 1, 2, 3, 4, 5, 6, 7); }
            }
#pragma unroll
            for (int tb = 0; tb < 2; ++tb)
#pragma unroll
                for (int q4 = 0; q4 < 4; ++q4) grv[tb][q4] = *(const u32x2*)(AB + (size_t)crow0 * 2048 + hd * 256 + 32 * w + 8 * q4 + (unsigned)(min(32 * tb + r, nv1) * 2048 + 4 * h));
#pragma unroll
            for (int q4 = 0; q4 < 4; ++q4) hn[q4] = *(const f32x4*)(head_norm + 32 * w + 4 * h + 8 * q4);
            const LAS bf16_t* ab_r = opq(Ab + r * TST + 8 * h);
#pragma unroll
            for (int tb = 0; tb < 2; ++tb)
#pragma unroll
                for (int sb = 0; sb < 2; ++sb) {
                    if (sb > tb) continue;
#pragma unroll
                    for (int s2 = 0; s2 < 2; ++s2) {
                        const bf16x8 aa = *(const LAS bf16x8*)(ab_r + (32 * tb) * TST + 32 * sb + 16 * s2);
                        oT[tb] = MFMA32(vfr[2 * sb + s2], aa, oT[tb]);
                    }
                }
        }
        const LAS bf16_t* kdt_r = opq(KdT + r * TST + 8 * h);
        if (!FULL) {
            const LAS bf16_t* vt_r2 = opq(VS + (8 * h + ((lane & 15) >> 2)) * VST + 32 * w + 16 * ((lane >> 4) & 1) + 4 * (lane & 3));
#pragma unroll
            for (int s4 = 0; s4 < 4; ++s4) { const s16x4 vlo = tr16(vt_r2 + (16 * s4) * VST), vhi = tr16(vt_r2 + (16 * s4 + 4) * VST); vfr[s4] = __builtin_shufflevector(vlo, vhi, 0, 1, 2, 3, 4, 5, 6, 7); }
        }
        const LAS float* eb_r = opq(EB + 4 * h);
#pragma unroll
        for (int kb = 0; kb < 4; ++kb) {
#pragma unroll
            for (int q4 = 0; q4 < 4; ++q4) { const f32x4 e = *(const LAS f32x4*)(eb_r + 32 * kb + 8 * q4);
#pragma unroll
                for (int e2 = 0; e2 < 4; ++e2) Sacc[kb][4 * q4 + e2] *= e[e2]; }
#pragma unroll
            for (int s = 0; s < 4; ++s) {
                const bf16x8 ka = *(const LAS bf16x8*)(kdt_r + (32 * kb) * TST + 16 * s);
                Sacc[kb] = MFMA32(ka, vfr[s], Sacc[kb]);
            }
            __builtin_amdgcn_sched_barrier(0);
        }
        LAS float* part_p = opq(PART + r);
        if (FULL) {
#pragma unroll
            for (int tb = 0; tb < 2; ++tb) { float p = 0.f;
#pragma unroll
                for (int i = 0; i < 16; ++i) p += oT[tb][i] * oT[tb][i];
                p += __shfl_xor(p, 32);
                if (h == 0) part_p[w * 64 + 32 * tb] = p; }
        }
        __syncthreads();
        if (FULL) {
#pragma unroll
            for (int tb = 0; tb < 2; ++tb) {
                float tot = 0.f;
#pragma unroll
                for (int w2 = 0; w2 < 8; ++w2) tot += part_p[w2 * 64 + 32 * tb];
                const float rs = __builtin_amdgcn_rsqf(tot * (1.0f / 256.0f) + EPS);
                if (32 * tb + r < nvalid) {
                    bf16_t* gp = (dummy ? dummy + (size_t)((crow0 + 32 * tb) & 2047) * 2048 : AB + (size_t)(crow0 + 32 * tb) * 2048) + hd * 256 + 32 * w + (unsigned)(r * 2048 + 4 * h);
#pragma unroll
                    for (int q4 = 0; q4 < 4; ++q4) {
                        const f32x4 g4 = (f32x4){bflo(grv[tb][q4].x), bfhi(grv[tb][q4].x), bflo(grv[tb][q4].y), bfhi(grv[tb][q4].y)};
                        f32x4 y;
#pragma unroll
                        for (int e = 0; e < 4; ++e) y[e] = oT[tb][4 * q4 + e] * rs * hn[q4][e] * siluf_(g4[e]);
                        *(u32x2*)(gp + 8 * q4) = (u32x2){cvtpk(y[0], y[1]), cvtpk(y[2], y[3])};
                    }
                }
            }
        }
    }
#undef GLA_FETCH_KG
#undef GLA_FETCH_QV
    if (Sout) {
#pragma unroll
        for (int kb = 0; kb < 4; ++kb)
#pragma unroll
            for (int i = 0; i < 16; ++i) Sout[(size_t)(32 * kb + crow(i, h)) * 256 + 32 * w + r] = Sacc[kb][i];
    }
    if (!FULL && tg == 0) Dout[kk] = fast_exp(dsum);
    __syncthreads();
}
}


namespace skinny {
typedef float f32x4v __attribute__((ext_vector_type(4)));
template <int NPARTS, int STEPS  , bool FINAL, class Epi>
__device__ __forceinline__ void phase(LAS unsigned char* lds, const bf16_t* A, int lda, const bf16_t* Bt, int ldb, int koff, float* ssq, int G, int bx, const Epi& E,
                                      const float* gain = nullptr, float* out = nullptr, unsigned* cnt = nullptr) {
    const int tid = threadIdx.x, lane = tid & 63, fr = lane & 15, fq = lane >> 4; const int w = __builtin_amdgcn_readfirstlane(tid >> 6);
    LAS f32x4* red = (LAS f32x4*)lds;
    LAS float* sred = (LAS float*)(lds + 8 * NPARTS * 4 * 64 * 16);
    constexpr int UB = STEPS > 4 ? 4 : STEPS;
    for (int pi = bx; pi < 256; pi += G) {
        const int rg = pi >> 4, cg = pi & 15;
        f32x4 acc[NPARTS][4];
#pragma unroll
        for (int p = 0; p < NPARTS; ++p) {
#pragma unroll
            for (int nt = 0; nt < 4; ++nt) acc[p][nt] = (f32x4){0.f, 0.f, 0.f, 0.f};
            const bf16_t* wp = Bt + (size_t)(64 * cg + fr) * ldb + p * koff + w * (STEPS * 32) + 8 * fq;
            const bf16_t* ap = A + (size_t)(MP + 16 * rg + fr) * lda + p * koff + w * (STEPS * 32) + 8 * fq;
            constexpr int NB = (STEPS + UB - 1) / UB;
            bf16x8 af[2][UB], wf[2][UB][4];
#define SK_LOAD(b_, s0_) do { _Pragma("unroll") for (int u = 0; u < UB; ++u) if ((s0_) + u < STEPS) { af[b_][u] = *(const bf16x8*)(ap + ((s0_) + u) * 32); \
                _Pragma("unroll") for (int nt = 0; nt < 4; ++nt) wf[b_][u][nt] = *(const bf16x8*)(wp + (size_t)(16 * nt) * ldb + ((s0_) + u) * 32); } } while (0)
#define SK_MMA(b_, s0_) do { _Pragma("unroll") for (int u = 0; u < UB; ++u) if ((s0_) + u < STEPS) { \
                _Pragma("unroll") for (int nt = 0; nt < 4; ++nt) acc[p][nt] = __builtin_amdgcn_mfma_f32_16x16x32_bf16(wf[b_][u][nt], af[b_][u], acc[p][nt], 0, 0, 0); } } while (0)
            SK_LOAD(0, 0);
#pragma unroll
            for (int b = 0; b < NB; ++b) {
                if (b + 1 < NB) { if ((b & 1) == 0) SK_LOAD(1, (b + 1) * UB); else SK_LOAD(0, (b + 1) * UB); }
                if ((b & 1) == 0) SK_MMA(0, b * UB); else SK_MMA(1, b * UB);
            }
#undef SK_LOAD
#undef SK_MMA
        }
#pragma unroll
        for (int p = 0; p < NPARTS; ++p)
#pragma unroll
            for (int nt = 0; nt < 4; ++nt) red[((w * NPARTS + p) * 4 + nt) * 64 + lane] = acc[p][nt];
        __syncthreads();
        f32x4 o = (f32x4){0.f, 0.f, 0.f, 0.f};
        if (w < 4) {
            f32x4 a2[NPARTS];
#pragma unroll
            for (int p = 0; p < NPARTS; ++p) { a2[p] = (f32x4){0.f, 0.f, 0.f, 0.f};
#pragma unroll
                for (int w2 = 0; w2 < 8; ++w2) a2[p] += red[((w2 * NPARTS + p) * 4 + w) * 64 + lane]; }
            const int row = MP + 16 * rg + fr, c0 = 64 * cg + 16 * w + 4 * fq;
            o = E(row, c0, a2);
            float s = (o[0] * o[0] + o[1] * o[1]) + (o[2] * o[2] + o[3] * o[3]);
            s += __shfl_xor(s, 16); s += __shfl_xor(s, 32);
            if (fq == 0) sred[w * 16 + fr] = s;
        }
        __syncthreads();
        if constexpr (FINAL) {
            float mine = 0.f; if (tid < 16) mine = (sred[tid] + sred[16 + tid]) + (sred[32 + tid] + sred[48 + tid]);
            LAS float* S = sred + 64;
            xchg_rstd(mine, S, 16, ssq + (size_t)(MP + 16 * rg) * 16, cg, 16, cnt + 64 * rg, 16u);
            if (w < 4) { const int row = MP + 16 * rg + fr, c0 = 64 * cg + 16 * w + 4 * fq; const f32x4 g4 = *(const f32x4*)(gain + c0); *(f32x4*)(out + (size_t)row * D + c0) = o * S[fr] * g4; }
        } else {
            if (ssq && tid < 16) ssq[(size_t)(MP + 16 * rg + tid) * 16 + cg] = (sred[tid] + sred[16 + tid]) + (sred[32 + tid] + sred[48 + tid]);
        }
        __syncthreads();
    }
}
__device__ __forceinline__ u32x2 pack4(const f32x4 v) { return (u32x2){cvtpk(v[0], v[1]), cvtpk(v[2], v[3])}; }
__device__ __forceinline__ f32x4 unpack4(const u32x2 w) { return (f32x4){bflo(w.x), bfhi(w.x), bflo(w.y), bfhi(w.y)}; }
template <bool BASE_BF16, bool OUT_F32, bool OUT_BF16> struct EpiResidual {
    const void* base; float* outf; bf16_t* outb; float scale;
    __device__ __forceinline__ f32x4 operator()(int row, int c0, const f32x4 (&acc)[1]) const {
        const size_t off = (size_t)row * D + c0;
        f32x4 b;
        if (BASE_BF16) b = unpack4(*(const u32x2*)((const bf16_t*)base + off)); else b = *(const f32x4*)((const float*)base + (off - (size_t)MP * D));
        const f32x4 v = b + acc[0] * scale;
        if (OUT_F32) *(f32x4*)(outf + off) = v;
        if (OUT_BF16) *(u32x2*)(outb + off) = pack4(v);
        return v;
    }
};
struct EpiMerge {
    bf16_t* G;
    __device__ __forceinline__ f32x4 operator()(int row, int c0, const f32x4 (&acc)[2]) const {
        bf16_t* pt = G + (size_t)row * 2048 + c0;
        const f32x4 rho = unpack4(*(const u32x2*)pt), sgb = unpack4(*(const u32x2*)(pt + 1024));
        const f32x4 m = sgb * (rho * acc[0] + acc[1]);
        *(u32x2*)pt = pack4(m);
        return m;
    }
};
}

__global__ void __launch_bounds__(NTHREADS, 2) fwd_kernel(Params P) {
    extern __shared__ __attribute__((aligned(16))) unsigned char lds_raw[];
    LAS unsigned char* lds = (LAS unsigned char*)lds_raw;
    volatile LAS unsigned* MISC = (volatile LAS unsigned*)(lds + MISC_OFF);
    const int tid = threadIdx.x, lane = tid & 63; const int wave = __builtin_amdgcn_readfirstlane(tid >> 6);
    const int G = gridDim.x, bx = blockIdx.x;
    unsigned char* ws = P.ws; float* out = P.out; unsigned char* outb = (unsigned char*)P.out;
    for (int u = tid; u < (LDS_BYTES - RING_BYTES) / 4; u += NTHREADS) ((LAS unsigned*)(lds + RING_BYTES))[u] = 0u;
    __syncthreads();
    const bool use_bar = (P.ph_hi - P.ph_lo) > 1;
    XcdBarrier bar; bar.bar = (unsigned*)(ws + WS_CTL); bar.x = 0; bar.st = nullptr;
    if (use_bar) bar = xcd_barrier_post((unsigned*)(ws + WS_CTL), MISC + 8);
    const int lo = P.ph_lo, hi = P.ph_hi;
#ifndef PHASE_MASK
#define PHASE_MASK 0xFFF
#endif
#define IN(k) (((PHASE_MASK >> (k)) & 1) && lo <= (k) && (k) < hi)
#define SEAM(k) do { if (IN(k) && IN((k) + 1)) xcd_barrier(bar); } while (0)
    float* ssq0 = (float*)(ws + WS_SSQ); float* ssq1 = (float*)(ws + WS_SSQ + SSQ_STRIDE); float* ssq2 = (float*)(ws + WS_SSQ + 2 * SSQ_STRIDE); float* ssq3 = (float*)(ws + WS_SSQ + 3 * SSQ_STRIDE);
    float* GA = (float*)(ws + WS_GA); float* DV = (float*)(ws + WS_DV);
    bf16_t* XA = (bf16_t*)(ws + WS_XA); bf16_t* QK = (bf16_t*)(ws + WS_QK); bf16_t* Vb = (bf16_t*)(ws + WS_V); bf16_t* Gb = (bf16_t*)(ws + WS_G); bf16_t* AB = (bf16_t*)(ws + WS_AB);
    bf16_t* SKV = (bf16_t*)(ws + WS_SKV); bf16_t* Hb = (bf16_t*)(ws + WS_H); float* X2F = (float*)(ws + WS_AB);
    bf16_t* Wup1 = (bf16_t*)(outb + OW_UP1); bf16_t* Wdn1 = (bf16_t*)(outb + OW_DN1); bf16_t* Win = (bf16_t*)(outb + OW_IN); bf16_t* Wbr = (bf16_t*)(outb + OW_BR);
    bf16_t* Wout = (bf16_t*)(outb + OW_OUT); bf16_t* Wup2 = (bf16_t*)(outb + OW_UP2); bf16_t* Wdn2 = (bf16_t*)(ws + WS_WDN2);
    float* DS = (float*)(outb + O_DS);
    const int gw = bx * NWAVES + wave, NGW = G * NWAVES;

    constexpr int G_UP = NUP / 32, G_DN = D / 32, G_IN = NIN_V / 32, G_BR = D / 32;
    constexpr int I_UP = (D / 64) * G_UP, I_DN = (FF / 64) * G_DN, I_IN = (D / 64) * G_IN, I_BR = (2048 / 64) * G_BR, I_OUT = (D / 64) * G_BR;
#define CONVERT_LIST(LIST, first_, stride_) do { LAS float* scr_ = (LAS float*)(lds + wave * 16384); \
        const int n_ = (LIST) == 0 ? I_UP : (LIST) == 1 ? I_DN + I_IN + I_BR + I_OUT : (LIST) == 2 ? I_UP : I_DN; \
        for (int it_ = (first_); it_ < n_; it_ += (stride_)) { int r_ = it_; \
            if ((LIST) == 0) { p0_transpose_item(P.in[6], D, NUP, 1, P.in[5], Wup1, scr_, r_, G_UP, lane); } \
            else if ((LIST) == 2) { p0_transpose_item(P.in[20], D, NUP, 1, P.in[19], Wup2, scr_, r_, G_UP, lane); } \
            else if ((LIST) == 3) { p0_transpose_item(P.in[21], FF, D, 0, nullptr, Wdn2, scr_, r_, G_DN, lane); } \
            else { if (r_ < I_DN) { p0_transpose_item(P.in[7], FF, D, 0, nullptr, Wdn1, scr_, r_, G_DN, lane); continue; } r_ -= I_DN; \
                   if (r_ < I_IN) { p0_transpose_item(P.in[9], D, 6672, 2, P.in[8], Win, scr_, r_, G_IN, lane); continue; } r_ -= I_IN; \
                   if (r_ < I_BR) { p0_transpose_item(P.in[17], 2048, D, 0, nullptr, Wbr, scr_, r_, G_BR, lane); continue; } r_ -= I_BR; \
                   p0_transpose_item(P.in[18], D, D, 0, nullptr, Wout, scr_, r_, G_BR, lane); } } } while (0)
#define CONVERT_ON_LIGHT(LIST, nwg_) do { const int rem_ = (nwg_) % G; const int nl_ = rem_ ? G - rem_ : G, lc_ = rem_ ? bx - rem_ : bx; \
        if (lc_ >= 0) CONVERT_LIST(LIST, lc_ * NWAVES + wave, nl_ * NWAVES); } while (0)
    const bool split_conv = (lo == 0 && hi == 12);
    if (IN(0)) {
        CONVERT_LIST(0, gw, NGW);
        if (!split_conv) { CONVERT_LIST(1, gw, NGW); CONVERT_LIST(2, gw, NGW); CONVERT_LIST(3, gw, NGW); }
        {
            f32x4 v[2][4], vn[2][4];
            auto xrow = [&](int m) -> const f32x4* { const float* xr = (m < MP) ? P.in[0] + (size_t)m * D : P.in[1] + (size_t)(m - MP) * D; return (const f32x4*)xr + lane; };
            int m0 = 2 * gw;
            if (m0 < M) {
#pragma unroll
                for (int q = 0; q < 2; ++q) { const f32x4* xv = xrow(m0 + q);
#pragma unroll
                    for (int j = 0; j < 4; ++j) v[q][j] = xv[64 * j]; }
            }
            for (; m0 < M; m0 += 2 * NGW) {
                const int mn = m0 + 2 * NGW; const bool more = mn < M;
                if (more) {
#pragma unroll
                    for (int q = 0; q < 2; ++q) { const f32x4* xv = xrow(mn + q);
#pragma unroll
                        for (int j = 0; j < 4; ++j) vn[q][j] = xv[64 * j]; }
                }
                float sq[2];
#pragma unroll
                for (int q = 0; q < 2; ++q) { float s2 = 0.f;
#pragma unroll
                    for (int j = 0; j < 4; ++j) s2 += (v[q][j][0] * v[q][j][0] + v[q][j][1] * v[q][j][1]) + (v[q][j][2] * v[q][j][2] + v[q][j][3] * v[q][j][3]);
                    sq[q] = wave_sum(s2); }
#pragma unroll
                for (int q = 0; q < 2; ++q) { const int m = m0 + q; u32x2* o8 = (u32x2*)(XA + (size_t)m * D) + lane;
#pragma unroll
                    for (int j = 0; j < 4; ++j) o8[64 * j] = (u32x2){cvtpk(v[q][j][0], v[q][j][1]), cvtpk(v[q][j][2], v[q][j][3])};
                    if (lane == 0) ssq0[(size_t)m * 16] = __builtin_amdgcn_rsqf(sq[q] * (1.0f / D) + EPS); }
                if (more) {
#pragma unroll
                    for (int q = 0; q < 2; ++q)
#pragma unroll
                        for (int j = 0; j < 4; ++j) v[q][j] = vn[q][j];
                }
            }
        }
    }
    SEAM(0);
    LAS float* rtab = (LAS float*)(lds + RING_BYTES + 2048);
#define RSTD_TABLE_FILL(S_, ssq_, DIRECT_) do { \
        for (int ui_ = 0; ui_ < 8; ++ui_) { pg8::Unit u_; if (!(S_).next(ui_, u_)) break; \
            if (tid < 256) { const int row_ = u_.pm * 256 + tid; rtab[ui_ * 256 + tid] = (DIRECT_) ? (ssq_)[(size_t)row_ * 16] : row_rstd((ssq_), row_); } } \
        __syncthreads(); } while (0)
    if (IN(1)) {
        pg8::Gemm g{XA, Wup1, D, D, D, 0}; pg8::Sched S; S.init(M, NUP, G, bx, 0);
        RSTD_TABLE_FILL(S, ssq0, true);
        pg8::EpiSwiglu E{Hb, rtab};
        pg8::gemm_phase(lds, g, S, E);
        if (split_conv) CONVERT_ON_LIGHT(1, (M / 256) * (NUP / 256));
    }
    SEAM(1);
    const bool stagger = (G == 256);
    const bool sk_early = stagger && ((bx >> 3) & 1) == 0;
    const int sk_piece = stagger ? (((bx >> 3) & 15) * 16 + 2 * (bx & 7) + (bx >> 7)) : bx;
    if (IN(2)) {
        pg8::Gemm g{Hb, Wdn1, FF, FF, FF, 0}; pg8::Sched S; S.init(MP, D, G, bx, 0);
        pg8::EpiResidual<true, false, true> E{XA, nullptr, nullptr, XA, ssq1, 0.5f};
        skinny::EpiResidual<true, false, true> Es{XA, nullptr, XA, 0.5f};
        if (sk_early) skinny::phase<1, FF / 256, false>(lds, Hb, FF, Wdn1, FF, 0, ssq1, G, sk_piece, Es);
        pg8::gemm_phase(lds, g, S, E);
        if (!sk_early) skinny::phase<1, FF / 256, false>(lds, Hb, FF, Wdn1, FF, 0, ssq1, G, sk_piece, Es);
    }
    SEAM(2);
    if (IN(3)) {
        pg8::Gemm g{XA, Win, D, D, D, 0}; pg8::Sched S; S.init(M, NIN_V, G, bx, 0);
        RSTD_TABLE_FILL(S, ssq1, false);
        pg8::EpiIn E{QK, Vb, Gb, AB, SKV, GA, rtab, P.in[13], P.in[14], out};
        pg8::gemm_phase(lds, g, S, E);
        if (split_conv) CONVERT_ON_LIGHT(2, (M / 256) * (NIN_V / 256));
    }
    SEAM(3);
    if (IN(4)) {
#ifndef P4_SKIP_GLA
#ifndef P4_SKIP_GLA_A
#if defined(PROBE_GLAA)
        for (int it = bx; it < 240; it += G) { const int bh = it / 15, sc = it % 15, b = bh >> 2, hd = bh & 3;
            gla::span<false, false>(lds, b * SEQ + sc * 256, 4, 64, hd, QK, Vb, AB, GA, P.in[10], P.in[11], P.in[12], nullptr, DS + (size_t)it * 32768, DV + (size_t)it * 128); }
#endif
        for (int it = bx; it < 240; it += G) { const int bh = it / 15, sc = it % 15, b = bh >> 2, hd = bh & 3;
            gla::span<false, false>(lds, b * SEQ + sc * 256, 4, 64, hd, QK, Vb, AB, GA, P.in[10], P.in[11], P.in[12], nullptr, DS + (size_t)it * 32768, DV + (size_t)it * 128); }
#endif
#ifndef P4_SKIP_GLA_S
        for (int s = (G - 1 - bx) ; s < 64; s += G) { const int db = s >> 2, hd = s & 3;
            gla::span<true, true>(lds, MP + db * 16, 1, 16, hd, QK, Vb, AB, GA, P.in[10], P.in[11], P.in[12], P.in[4] + (size_t)s * 32768, out + OUT_GS + (size_t)s * 32768, nullptr); }
#endif
#endif
#ifndef P4_SKIP_SWA
#if defined(PROBE_SWA)
        swa::phase(lds, bx, G, AB, (bf16_t*)(outb + 53 * MiB), SKV, P.in[2], P.in[3], P.in[15], P.in[16]);
#endif
        swa::phase(lds, bx, G, AB, nullptr, SKV, P.in[2], P.in[3], P.in[15], P.in[16]);
#endif
    }
    SEAM(4);
    if (IN(5)) {
        for (int gid = bx * NTHREADS + tid; gid < 16 * 8192; gid += G * NTHREADS) {
            const int bh = gid >> 13, e = gid & 8191, k = e >> 6;
            f32x4 ds[15]; float dd[15];
#pragma unroll
            for (int j = 0; j < 15; ++j) { ds[j] = *((const f32x4*)(DS + (size_t)(bh * 15 + j) * 32768) + e); dd[j] = DV[(size_t)(bh * 15 + j) * 128 + k]; }
            f32x4 Sv = (f32x4){0.f, 0.f, 0.f, 0.f};
#pragma unroll
            for (int j = 0; j < 15; ++j) { Sv = Sv * dd[j] + ds[j]; *((f32x4*)(DS + (size_t)(bh * 15 + j) * 32768) + e) = Sv; }
        }
    }
    SEAM(5);
    if (IN(6)) {
#if defined(PROBE_GLAC)
        for (int it = bx; it < 256; it += G) { const int bh = it >> 4, sc = it & 15, b = bh >> 2, hd = bh & 3;
            gla::span<true, false>(lds, b * SEQ + sc * 256, 4, 64, hd, QK, Vb, AB, GA, P.in[10], P.in[11], P.in[12], sc ? DS + (size_t)(bh * 15 + sc - 1) * 32768 : nullptr, nullptr, nullptr, (bf16_t*)(outb + 53 * MiB)); }
#endif
        for (int it = bx; it < 256; it += G) { const int bh = it >> 4, sc = it & 15, b = bh >> 2, hd = bh & 3;
            gla::span<true, false>(lds, b * SEQ + sc * 256, 4, 64, hd, QK, Vb, AB, GA, P.in[10], P.in[11], P.in[12], sc ? DS + (size_t)(bh * 15 + sc - 1) * 32768 : nullptr,
                            sc == 15 ? out + OUT_GP + (size_t)bh * 32768 : nullptr, nullptr); }
    }
    SEAM(6);
    if (IN(7)) {
        pg8::Gemm g{AB, Wbr, 2048, 2048, D, 1024}; pg8::Sched S; S.init(MP, D, G, bx, 1);
        pg8::EpiMerge E{Gb, Gb, 0x7fffffff};
        skinny::EpiMerge Es{Gb};
        if (sk_early) skinny::phase<2, D / 256, false>(lds, AB, 2048, Wbr, 2048, 1024, nullptr, G, sk_piece, Es);
        pg8::gemm_phase(lds, g, S, E);
        if (!sk_early) skinny::phase<2, D / 256, false>(lds, AB, 2048, Wbr, 2048, 1024, nullptr, G, sk_piece, Es);
    }
    SEAM(7);
    if (IN(8)) {
        pg8::Gemm g{Gb, Wout, 2048, D, D, 0}; pg8::Sched S; S.init(MP, D, G, bx, 0);
        pg8::EpiResidual<true, false, true> E{XA, nullptr, nullptr, QK, ssq2, 1.0f};
        skinny::EpiResidual<true, false, true> Es{XA, nullptr, QK, 1.0f};
        if (sk_early) skinny::phase<1, D / 256, false>(lds, Gb, 2048, Wout, D, 0, ssq2, G, sk_piece, Es);
        pg8::gemm_phase(lds, g, S, E);
        if (!sk_early) skinny::phase<1, D / 256, false>(lds, Gb, 2048, Wout, D, 0, ssq2, G, sk_piece, Es);
    }
    SEAM(8);
    if (IN(9)) {
        pg8::Gemm g{QK, Wup2, D, D, D, 0}; pg8::Sched S; S.init(M, NUP, G, bx, 0);
        RSTD_TABLE_FILL(S, ssq2, false);
        pg8::EpiSwiglu E{Hb, rtab};
        pg8::gemm_phase(lds, g, S, E);
        if (split_conv) CONVERT_ON_LIGHT(3, (M / 256) * (NUP / 256));
    }
    SEAM(9);
    const bool fuse_final = (G == 256) && IN(10) && IN(11);
    if (IN(10)) {
        pg8::Gemm g{Hb, Wdn2, FF, FF, FF, 0}; pg8::Sched S; S.init(MP, D, G, bx, 0);
        unsigned* xcnt = (unsigned*)(ws + WS_CTL) + 4096;
        if (fuse_final) {
            pg8::EpiFinal E{QK, out + OUT_Y, P.in[22], ssq3, xcnt, 0.5f};
            skinny::EpiResidual<true, false, false> Es{QK, nullptr, nullptr, 0.5f};
            if (sk_early) skinny::phase<1, FF / 256, true>(lds, Hb, FF, Wdn2, FF, 0, ssq3, G, sk_piece, Es, P.in[22], out + OUT_Y, xcnt + 64 * 64);
            pg8::gemm_phase(lds, g, S, E);
            if (!sk_early) skinny::phase<1, FF / 256, true>(lds, Hb, FF, Wdn2, FF, 0, ssq3, G, sk_piece, Es, P.in[22], out + OUT_Y, xcnt + 64 * 64);
        } else {
            pg8::EpiResidual<true, true, false> E{QK, nullptr, X2F, nullptr, ssq3, 0.5f};
            pg8::gemm_phase(lds, g, S, E);
            skinny::EpiResidual<true, true, false> Es{QK, X2F, nullptr, 0.5f};
            skinny::phase<1, FF / 256, false>(lds, Hb, FF, Wdn2, FF, 0, ssq3, G, bx, Es);
        }
    }
    if (!fuse_final) SEAM(10);
    if (IN(11) && !fuse_final) {
        const float* fn = P.in[22];
        for (int m = gw; m < M; m += NGW) {
            const float rs = row_rstd(ssq3, m);
            const f32x4* xv = (const f32x4*)(X2F + (size_t)m * D) + lane; f32x4* yv = (f32x4*)(out + OUT_Y + (size_t)m * D) + lane;
#pragma unroll
            for (int j = 0; j < 4; ++j) { const f32x4 g4 = *((const f32x4*)fn + lane + 64 * j); yv[64 * j] = xv[64 * j] * rs * g4; }
        }
    }
#undef IN
#undef SEAM
}

#ifndef N_LAUNCHES
#define N_LAUNCHES 1
#endif
extern "C" void kernel_launch(void* const* d_in, const int* in_sizes, int n_in, void* d_out, int out_size, void* d_ws, size_t ws_size, hipStream_t stream) {
    static int grid = 0;
    if (grid == 0) {
        if (n_in != 23 || ws_size < WS_END) { fprintf(stderr, "kernel_launch: unexpected inputs (n_in %d, ws %zu)\n", n_in, ws_size); grid = -1; return; }
        int dev = 0, cus = 0;
        if (hipGetDevice(&dev) != hipSuccess || hipDeviceGetAttribute(&cus, hipDeviceAttributeMultiprocessorCount, dev) != hipSuccess) { grid = -1; return; }
        if (hipFuncSetAttribute((const void*)fwd_kernel, hipFuncAttributeMaxDynamicSharedMemorySize, LDS_BYTES) != hipSuccess) { fprintf(stderr, "kernel_launch: hipFuncSetAttribute failed\n"); grid = -1; return; }
        (void)hipGetLastError();
        grid = cus;
    }
    if (grid < 0) return;
    (void)hipMemsetAsync((char*)d_ws + WS_CTL, 0, CTL_ZERO_BYTES, stream);
    Params p{};
    for (int i = 0; i < 23; ++i) p.in[i] = (const float*)d_in[i];
    p.out = (float*)d_out; p.ws = (unsigned char*)d_ws;
    if (N_LAUNCHES == 1) { p.ph_lo = 0; p.ph_hi = 12; hipLaunchKernelGGL(fwd_kernel, dim3(grid), dim3(NTHREADS), LDS_BYTES, stream, p); }
    else for (int k = 0; k < 12; ++k) { p.ph_lo = k; p.ph_hi = k + 1; hipLaunchKernelGGL(fwd_kernel, dim3(grid), dim3(NTHREADS), LDS_BYTES, stream, p); }
}
```

```cpp
#include <hip/hip_runtime.h>
#include <cstdio>
#include <cstdint>

#define LAS __attribute__((address_space(3)))
typedef unsigned short bf16_t;
typedef short bf16x8 __attribute__((ext_vector_type(8)));
typedef short s16x4 __attribute__((ext_vector_type(4)));
typedef float f32x4 __attribute__((ext_vector_type(4)));
typedef float f32x16 __attribute__((ext_vector_type(16)));
typedef unsigned u32x4 __attribute__((ext_vector_type(4)));
typedef unsigned u32x2 __attribute__((ext_vector_type(2)));
typedef float f32x2_t __attribute__((ext_vector_type(2)));
typedef __bf16 bf16x2_t __attribute__((ext_vector_type(2)));

constexpr int D = 1024, SEQ = 4096, NBATCH = 4, MP = NBATCH * SEQ, DBATCH = 16, DSEQ = 16, MS = DBATCH * DSEQ, M = MP + MS;
constexpr int FF = 2816, NUP = 2 * FF, NIN_V = 27 * 256;
constexpr int NCACHE = 128;
constexpr float EPS = 1e-6f;
constexpr float LOG2E = 1.4426950408889634f;

constexpr size_t MiB = 1u << 20;
constexpr size_t WS_CTL = 0, CTL_ZERO_BYTES = 64 * 1024;
constexpr size_t SSQ_BYTES = (size_t)M * 16 * 4;
constexpr size_t WS_SSQ = 65536, SSQ_STRIDE = SSQ_BYTES;
constexpr size_t WS_GA = WS_SSQ + 4 * SSQ_STRIDE;
constexpr size_t WS_DV = WS_GA + SSQ_BYTES;
constexpr size_t WS_XA = 5 * MiB + 512 * 1024;
constexpr size_t WS_QK = WS_XA + (size_t)M * 1024 * 2;
constexpr size_t WS_V = WS_QK + (size_t)M * 1024 * 2;
constexpr size_t WS_G = WS_V + (size_t)M * 1024 * 2;
constexpr size_t WS_AB = WS_G + (size_t)M * 2048 * 2;
constexpr size_t WS_SKV = WS_AB + (size_t)M * 2048 * 2;
constexpr size_t WS_WDN2 = WS_SKV + (size_t)M * 512 * 2;
constexpr size_t WS_END = WS_WDN2 + (size_t)1024 * FF * 2;
constexpr size_t WS_H = WS_V;
static_assert(WS_DV + 240 * 128 * 4 <= WS_XA && WS_XA + (size_t)M * 1024 * 2 <= WS_QK && WS_END <= 256 * MiB && (WS_GA % 16) == 0 && (WS_DV % 16) == 0 && (WS_WDN2 % 256) == 0, "ws map");
static_assert(WS_H + (size_t)M * FF * 2 <= WS_AB, "hidden overlay");
constexpr size_t OUT_Y = 0, OUT_KP = (size_t)M * D, OUT_VP = OUT_KP + 131072, OUT_GP = OUT_VP + 131072, OUT_KS = OUT_GP + 524288, OUT_VS = OUT_KS + 65536, OUT_GS = OUT_VS + 65536;
constexpr size_t OW_UP1 = 0, OW_DN1 = 11 * MiB, OW_IN = OW_DN1 + 5 * MiB + 512 * 1024, OW_BR = 30 * MiB, OW_OUT = 34 * MiB, OW_UP2 = 36 * MiB, OW_DN2 = 47 * MiB;
constexpr size_t O_DS = 0;
static_assert(OW_IN + (size_t)NIN_V * 1024 * 2 <= OW_BR && OW_DN2 + (size_t)1024 * FF * 2 <= (size_t)M * D * 4 && 240ull * 32768 * 4 <= OW_BR, "out map");

__device__ __forceinline__ unsigned cvtpk(float lo, float hi) { f32x2_t v = {lo, hi}; bf16x2_t b = __builtin_convertvector(v, bf16x2_t); return __builtin_bit_cast(unsigned, b); }
__device__ __forceinline__ float bf2f(unsigned short x) { return __uint_as_float((unsigned)x << 16); }
__device__ __forceinline__ float bflo(unsigned w) { return __uint_as_float(w << 16); }
__device__ __forceinline__ float bfhi(unsigned w) { return __uint_as_float(w & 0xffff0000u); }
__device__ __forceinline__ unsigned short f2bf(float f) { return (unsigned short)(cvtpk(f, 0.f) & 0xffffu); }
__device__ __forceinline__ float fast_exp(float x) { return __builtin_amdgcn_exp2f(x * LOG2E); }
__device__ __forceinline__ float sigmoidf_(float x) { return __builtin_amdgcn_rcpf(1.f + fast_exp(-x)); }
__device__ __forceinline__ float siluf_(float x) { return x * sigmoidf_(x); }
__device__ __forceinline__ int crow(int r, int hi) { return (r & 3) + 8 * (r >> 2) + 4 * hi; }
#if defined(__HIP_DEVICE_COMPILE__)
template <class T> __device__ __forceinline__ LAS T* opq(LAS T* p) { unsigned a = __builtin_bit_cast(unsigned, p); asm volatile("" : "+v"(a)); return __builtin_bit_cast(LAS T*, a); }
template <class T> __device__ __forceinline__ LAS T* opq_after(LAS T* p, float dep) { unsigned a = __builtin_bit_cast(unsigned, p); asm volatile("" : "+v"(a) : "v"(dep)); return __builtin_bit_cast(LAS T*, a); }
#else
template <class T> __device__ __forceinline__ LAS T* opq(LAS T* p) { return p; }
template <class T> __device__ __forceinline__ LAS T* opq_after(LAS T* p, float) { return p; }
#endif
#define LDS_WAIT() asm volatile("s_waitcnt lgkmcnt(0)" ::: "memory")
#define VM_WAIT() asm volatile("s_waitcnt vmcnt(0)" ::: "memory")
#define MFMA32(a, b, c) __builtin_amdgcn_mfma_f32_32x32x16_bf16((a), (b), (c), 0, 0, 0)

__device__ __forceinline__ float row_rstd(const float* ssq, int row) {
    const f32x4* p = (const f32x4*)(ssq + (size_t)row * 16);
    const f32x4 a = p[0], b = p[1], c = p[2], d = p[3];
    const float s = ((a[0] + a[1]) + (a[2] + a[3])) + ((b[0] + b[1]) + (b[2] + b[3])) + ((c[0] + c[1]) + (c[2] + c[3])) + ((d[0] + d[1]) + (d[2] + d[3]));
    return __builtin_amdgcn_rsqf(s * (1.0f / D) + EPS);
}


#define XC_SPIN_CAP (1u << 22)
__device__ __forceinline__ void xchg_rstd(float mine, LAS float* S, int nrows, float* slots, int myslot, int nslots, unsigned* cnt, unsigned need) {
    const int tid = threadIdx.x;
    if (tid < nrows) __hip_atomic_store((unsigned*)(slots + (size_t)tid * 16 + myslot), __float_as_uint(mine), __ATOMIC_RELAXED, __HIP_MEMORY_SCOPE_AGENT);
    asm volatile("s_waitcnt vmcnt(0)" ::: "memory");
    __syncthreads();
    if (tid < 64) {
        if (tid == 0) (void)__hip_atomic_fetch_add(cnt, 1u, __ATOMIC_RELAXED, __HIP_MEMORY_SCOPE_AGENT);
        unsigned sp = 0;
        while ((unsigned)__builtin_amdgcn_readfirstlane(__hip_atomic_load(cnt, __ATOMIC_RELAXED, __HIP_MEMORY_SCOPE_AGENT)) < need) { __builtin_amdgcn_s_sleep(2); if (++sp > XC_SPIN_CAP) break; }
        __builtin_amdgcn_fence(__ATOMIC_ACQUIRE, "agent");
        asm volatile("s_waitcnt vmcnt(0)" ::: "memory");
    }
    __syncthreads();
    if (tid < nrows) {
        float t = 0.f;
        for (int j = 0; j < nslots; ++j) t += __uint_as_float(__hip_atomic_load((unsigned*)(slots + (size_t)tid * 16 + j), __ATOMIC_RELAXED, __HIP_MEMORY_SCOPE_AGENT));
        S[tid] = __builtin_amdgcn_rsqf(t * (1.0f / D) + EPS);
    }
    __syncthreads();
}

namespace pg8 {
constexpr int BM = 256, BK = 64, HALF = 128, HTB = HALF * BK * 2, STAGE_BYTES = 8 * HTB, NXCD = 8, WGM = 4;
__host__ __device__ __forceinline__ int lds_byte(int r, int c) { const int st = (r >> 4) * 2 + (c >> 5), rr = r & 15, cc = c & 31, ob = rr * 64 + cc * 2; return st * 1024 + (ob ^ (((ob >> 9) & 1) << 5)); }
__host__ __device__ __forceinline__ void stage_rc(int b, int& R, int& C) { const int st = b / 1024, sb = b % 1024, swz = sb ^ (((sb >> 9) & 1) << 5); R = (st >> 1) * 16 + swz / 64; C = (st & 1) * 32 + (swz % 64) / 2; }
__host__ __device__ __forceinline__ int perm32(int rho) { const int n = rho >> 4, i = rho & 15; return 8 * (i >> 2) + 4 * n + (i & 3); }

struct Unit { int pm, pn, part, idx; };
struct Gemm { const bf16_t* A; const bf16_t* Bt; int lda, ldb, K; int koff; };

struct Sched {
    int nM, nN, nwg, G, c, psh;
    __device__ __forceinline__ void init(int M_, int N_, int G_, int c_, int psh_) { nM = M_ / BM; nN = N_ / BM; nwg = nM * nN; G = G_; c = c_; psh = psh_; }
    __device__ __forceinline__ bool next(int i, Unit& u) const {
        const long L = (long)(i >> psh) * G + c; if (L >= nwg) return false;
        int wgid = (int)L; { const int q = nwg / NXCD, r = nwg % NXCD, xcd = wgid % NXCD, off = wgid / NXCD; wgid = (xcd < r ? xcd * (q + 1) : r * (q + 1) + (xcd - r) * q) + off; }
        const int nig = WGM * nN, gid = wgid / nig, fm = gid * WGM, gsz = (nM - fm) < WGM ? (nM - fm) : WGM;
        u.pm = fm + ((wgid % nig) % gsz); u.pn = (wgid % nig) / gsz; u.part = i & ((1 << psh) - 1); u.idx = i; return true;
    }
};

typedef f32x4 Acc[2][2][4][2];

template <class Epi>
__device__ __forceinline__ void gemm_phase(LAS unsigned char* lds, const Gemm g, const Sched& S, const Epi& E) {
    const int tid = threadIdx.x, wid = __builtin_amdgcn_readfirstlane(tid >> 6), lane = tid & 63, wr = wid >> 2, wc = wid & 3, fr = lane & 15, fq = lane >> 4;
    const int K = g.K, nt = K / BK;
    unsigned voffA[2], voffB[2];
#pragma unroll
    for (int i = 0; i < 2; ++i) { int R, C; stage_rc(tid * 16 + i * 8192, R, C); const int Rb = (R & ~31) + perm32(R & 31);
        voffA[i] = (unsigned)(R * g.lda + C) * 2u; voffB[i] = (unsigned)(Rb * g.ldb + C) * 2u; }
    const size_t kstep = (size_t)(BK * 2);
    const size_t hstepA = (size_t)HALF * g.lda * 2, hstepB = (size_t)HALF * g.ldb * 2;
    const size_t tstepA = 2 * hstepA, tstepB = 2 * hstepB;
    const unsigned ldsw = (unsigned)wid * 1024u;
    const int aoff = lds_byte(wr * 64 + fr, fq * 8), boff = lds_byte(wc * 32 + fr, fq * 8);
#define PG8_SA(b, h) (((b) * 2 + (h)) * HTB)
#define PG8_SB(b, h) ((4 + (b) * 2 + (h)) * HTB)
#define PG8_STAGE(bufoff, gbase, voff) do { _Pragma("unroll") for (int _i = 0; _i < 2; ++_i) \
        __builtin_amdgcn_global_load_lds((const unsigned*)((const char*)(gbase) + (voff)[_i]), (LAS unsigned*)(lds + (bufoff) + ldsw + _i * 8192), 16, 0, 0); } while (0)
#define PG8_LDA(dst, b, h) do { _Pragma("unroll") for (int m = 0; m < 4; ++m) _Pragma("unroll") for (int k = 0; k < 2; ++k) dst[m][k] = *(const LAS bf16x8*)(lds + PG8_SA(b, h) + aoff + m * 2048 + k * 1024); } while (0)
#define PG8_LDB(dst, b, h) do { _Pragma("unroll") for (int n = 0; n < 2; ++n) _Pragma("unroll") for (int k = 0; k < 2; ++k) dst[n][k] = *(const LAS bf16x8*)(lds + PG8_SB(b, h) + boff + n * 2048 + k * 1024); } while (0)
#define PG8_MMA(ai, bj, At, Bt) do { __builtin_amdgcn_s_setprio(1); _Pragma("unroll") for (int m = 0; m < 4; ++m) _Pragma("unroll") for (int n = 0; n < 2; ++n) _Pragma("unroll") for (int k = 0; k < 2; ++k) \
        acc[ai][bj][m][n] = __builtin_amdgcn_mfma_f32_16x16x32_bf16(Bt[n][k], At[m][k], acc[ai][bj][m][n], 0, 0, 0); __builtin_amdgcn_s_setprio(0); } while (0)
#define PG8_WAIT_V(n) asm volatile("s_waitcnt vmcnt(" #n ")" ::: "memory")
#define PG8_WAIT_L(n) asm volatile("s_waitcnt lgkmcnt(" #n ")" ::: "memory")
#define PG8_BAR __builtin_amdgcn_s_barrier()
#define PG8_SCHED __builtin_amdgcn_sched_barrier(0)
    Unit cur, nxt; int ui = 0;
    if (!S.next(0, cur)) return;
    Acc acc;
#pragma unroll
    for (int a = 0; a < 2; ++a)
#pragma unroll
        for (int b = 0; b < 2; ++b)
#pragma unroll
            for (int m = 0; m < 4; ++m)
#pragma unroll
                for (int n = 0; n < 2; ++n) acc[a][b][m][n] = (f32x4){0.f, 0.f, 0.f, 0.f};
    bf16x8 At[4][2], B0[2][2], B1[2][2];
    const char* cA = (const char*)g.A + (size_t)cur.pm * tstepA + (size_t)cur.part * g.koff * 2; const char* cB = (const char*)g.Bt + (size_t)cur.pn * tstepB + (size_t)cur.part * g.koff * 2;
    PG8_STAGE(PG8_SB(0, 0), cB, voffB); PG8_STAGE(PG8_SB(0, 1), cB + hstepB, voffB); PG8_STAGE(PG8_SA(0, 0), cA, voffA); PG8_STAGE(PG8_SA(0, 1), cA + hstepA, voffA);
    if (wr == 1) PG8_BAR;
    PG8_WAIT_V(2); PG8_BAR;
    PG8_STAGE(PG8_SB(1, 0), cB + kstep, voffB); PG8_STAGE(PG8_SA(1, 0), cA + kstep, voffA); PG8_STAGE(PG8_SB(1, 1), cB + hstepB + kstep, voffB);
    PG8_WAIT_V(6); PG8_BAR;
    for (;;) {
        const bool has_next = S.next(ui + 1, nxt);
        const char* nA = has_next ? (const char*)g.A + (size_t)nxt.pm * tstepA + (size_t)nxt.part * g.koff * 2 : cA; const char* nB = has_next ? (const char*)g.Bt + (size_t)nxt.pn * tstepB + (size_t)nxt.part * g.koff * 2 : cB;
        for (int t = 0; t < nt; t += 2) {
            const bool last = (t == nt - 2);
            const char* a1 = cA + (size_t)(t + 1) * kstep;
            const char* a2 = last ? nA : cA + (size_t)(t + 2) * kstep; const char* b2 = last ? nB : cB + (size_t)(t + 2) * kstep;
            const char* a3 = a2 + kstep; const char* b3 = b2 + kstep;
            PG8_LDB(B0, 0, 0); PG8_LDB(B1, 0, 1); PG8_SCHED; PG8_LDA(At, 0, 0); PG8_STAGE(PG8_SA(1, 1), a1 + hstepA, voffA);
            PG8_WAIT_V(8); PG8_WAIT_L(0); PG8_BAR; PG8_MMA(0, 0, At, B0); PG8_MMA(0, 1, At, B1); PG8_BAR; PG8_SCHED;
            PG8_LDA(At, 0, 1); PG8_STAGE(PG8_SB(0, 0), b2, voffB); PG8_STAGE(PG8_SB(0, 1), b2 + hstepB, voffB); PG8_STAGE(PG8_SA(0, 0), a2, voffA);
            PG8_WAIT_V(8); PG8_WAIT_L(0); PG8_BAR; PG8_MMA(1, 0, At, B0); PG8_MMA(1, 1, At, B1); PG8_BAR; PG8_SCHED;
            PG8_LDB(B0, 1, 0); PG8_LDB(B1, 1, 1); PG8_SCHED; PG8_LDA(At, 1, 0); PG8_STAGE(PG8_SA(0, 1), a2 + hstepA, voffA);
            PG8_WAIT_V(8); PG8_WAIT_L(0); PG8_BAR; PG8_MMA(0, 0, At, B0); PG8_MMA(0, 1, At, B1); PG8_BAR; PG8_SCHED;
            PG8_LDA(At, 1, 1); PG8_STAGE(PG8_SB(1, 0), b3, voffB); PG8_STAGE(PG8_SB(1, 1), b3 + hstepB, voffB); PG8_STAGE(PG8_SA(1, 0), a3, voffA);
            PG8_WAIT_V(8); PG8_WAIT_L(0); PG8_BAR; PG8_MMA(1, 0, At, B0); PG8_MMA(1, 1, At, B1); PG8_BAR; PG8_SCHED;
        }
        if (wr == 0) PG8_BAR;
        if constexpr (!Epi::AFTER_DRAIN) E(acc, cur, wr, wc, fr, fq);
        if (!has_next) break;
        if (!(Epi::KEEP_PART0 && cur.part == 0))
#pragma unroll
        for (int a = 0; a < 2; ++a)
#pragma unroll
            for (int b = 0; b < 2; ++b)
#pragma unroll
                for (int m = 0; m < 4; ++m)
#pragma unroll
                    for (int n = 0; n < 2; ++n) acc[a][b][m][n] = (f32x4){0.f, 0.f, 0.f, 0.f};
        cur = nxt; cA = nA; cB = nB; ++ui;
        if (wr == 1) PG8_BAR;
    }
    PG8_WAIT_V(0);
    PG8_BAR;
    if constexpr (Epi::AFTER_DRAIN) E.fused(acc, cur, wr, wc, fr, fq, lds);
#undef PG8_SA
#undef PG8_SB
#undef PG8_STAGE
#undef PG8_LDA
#undef PG8_LDB
#undef PG8_MMA
#undef PG8_WAIT_V
#undef PG8_WAIT_L
#undef PG8_BAR
#undef PG8_SCHED
}

__device__ __forceinline__ u32x4 pack8(const f32x4 a, const f32x4 b) { u32x4 w; w.x = cvtpk(a[0], a[1]); w.y = cvtpk(a[2], a[3]); w.z = cvtpk(b[0], b[1]); w.w = cvtpk(b[2], b[3]); return w; }
__device__ __forceinline__ void unpack8(const u32x4 w, f32x4& a, f32x4& b) { a = (f32x4){bflo(w.x), bfhi(w.x), bflo(w.y), bfhi(w.y)}; b = (f32x4){bflo(w.z), bfhi(w.z), bflo(w.w), bfhi(w.w)}; }

struct EpiSwiglu {
    static constexpr bool AFTER_DRAIN = false, KEEP_PART0 = false;
    bf16_t* H; const LAS float* rtab;
    __device__ __forceinline__ void operator()(const Acc& acc, const Unit& u, int wr, int wc, int fr, int fq) const {
        const int col0 = u.pn * 128 + wc * 32 + 8 * fq;
        const LAS float* rt = rtab + u.idx * 256 + wr * 64 + fr;
#pragma unroll
        for (int ai = 0; ai < 2; ++ai)
#pragma unroll
            for (int m = 0; m < 4; ++m) {
                const int row = u.pm * BM + ai * HALF + wr * 64 + m * 16 + fr; const float r = rt[ai * HALF + m * 16];
                f32x4 h0, h1;
#pragma unroll
                for (int e = 0; e < 4; ++e) { h0[e] = siluf_(acc[ai][0][m][0][e] * r) * (acc[ai][1][m][0][e] * r); h1[e] = siluf_(acc[ai][0][m][1][e] * r) * (acc[ai][1][m][1][e] * r); }
                *(u32x4*)(H + (size_t)row * FF + col0) = pack8(h0, h1);
            }
    }
};
template <bool BASE_BF16, bool OUT_F32, bool OUT_BF16> struct EpiResidual {
    static constexpr bool AFTER_DRAIN = false, KEEP_PART0 = false;
    static_assert(BASE_BF16, "the residual stream is bf16");
    const void* base; const void* base_s; float* outf; bf16_t* outb; float* ssq; float scale;
    __device__ __forceinline__ void operator()(const Acc& acc, const Unit& u, int wr, int wc, int fr, int fq) const {
        const size_t off0 = (size_t)(u.pm * BM + wr * 64 + fr) * D + u.pn * BM + wc * 32 + 8 * fq;
        u32x4 bw[2][4][2];
#pragma unroll
        for (int ai = 0; ai < 2; ++ai)
#pragma unroll
            for (int m = 0; m < 4; ++m)
#pragma unroll
                for (int bj = 0; bj < 2; ++bj) bw[ai][m][bj] = *(const u32x4*)((const bf16_t*)base + off0 + (size_t)(ai * HALF + m * 16) * D + bj * HALF);
#pragma unroll
        for (int ai = 0; ai < 2; ++ai)
#pragma unroll
            for (int m = 0; m < 4; ++m) {
                const int row = u.pm * BM + ai * HALF + wr * 64 + m * 16 + fr; float s = 0.f;
#pragma unroll
                for (int bj = 0; bj < 2; ++bj) {
                    const size_t off = off0 + (size_t)(ai * HALF + m * 16) * D + bj * HALF;
                    f32x4 b0, b1; unpack8(bw[ai][m][bj], b0, b1);
                    const f32x4 v0 = b0 + acc[ai][bj][m][0] * scale, v1 = b1 + acc[ai][bj][m][1] * scale;
                    s += (v0[0] * v0[0] + v0[1] * v0[1]) + (v0[2] * v0[2] + v0[3] * v0[3]) + (v1[0] * v1[0] + v1[1] * v1[1]) + (v1[2] * v1[2] + v1[3] * v1[3]);
                    if (OUT_F32) { *(f32x4*)(outf + off) = v0; *(f32x4*)(outf + off + 4) = v1; }
                    if (OUT_BF16) *(u32x4*)(outb + off) = pack8(v0, v1);
                }
                s += __shfl_xor(s, 16); s += __shfl_xor(s, 32);
                if (fq == 0) ssq[(size_t)row * 16 + u.pn * 4 + wc] = s;
            }
    }
};
struct EpiIn {
    static constexpr bool AFTER_DRAIN = false, KEEP_PART0 = false;
    bf16_t *QK, *V, *G, *AB, *SKV; float* GA; const LAS float* rtab; const float *qn, *kn; float* out;
#define EPI_IN_ROWS(...) _Pragma("unroll") for (int ai = 0; ai < 2; ++ai) _Pragma("unroll") for (int m = 0; m < 4; ++m) { \
            const int row = u.pm * BM + ai * HALF + wr * 64 + m * 16 + fr; const float r = rt[ai * HALF + m * 16]; f32x4 v[2][2]; \
            _Pragma("unroll") for (int bj = 0; bj < 2; ++bj) _Pragma("unroll") for (int n = 0; n < 2; ++n) v[bj][n] = acc[ai][bj][m][n] * r; \
            __VA_ARGS__ }
    __device__ __forceinline__ void operator()(const Acc& acc, const Unit& u, int wr, int wc, int fr, int fq) const {
        const int pn = u.pn, cpos = wc * 32 + 8 * fq;
        const LAS float* rt = rtab + u.idx * 256 + wr * 64 + fr;
        if (pn >= 18 && pn < 26) {
            EPI_IN_ROWS({
                bf16_t* dst = G + (size_t)row * 2048 + (pn - 18) * 128 + cpos;
                f32x4 r0, r1, s0, s1;
                _Pragma("unroll") for (int e = 0; e < 4; ++e) {
                    const float ea0 = fast_exp(-v[0][0][e]), ea1 = fast_exp(-v[0][1][e]), eb0 = fast_exp(-v[1][0][e]), eb1 = fast_exp(-v[1][1][e]);
                    s0[e] = __builtin_amdgcn_rcpf(1.f + eb0); s1[e] = __builtin_amdgcn_rcpf(1.f + eb1);
                    r0[e] = (1.f + eb0) * __builtin_amdgcn_rcpf(1.f + ea0); r1[e] = (1.f + eb1) * __builtin_amdgcn_rcpf(1.f + ea1);
                }
                *(u32x4*)dst = pack8(r0, r1); *(u32x4*)(dst + 1024) = pack8(s0, s1);
            })
        } else if (pn < 12 || pn == 17) {
            bf16_t* dst0; size_t ld; float sc = 1.f;
            if (pn < 4) { dst0 = QK + pn * 256; ld = 1024; if (pn < 2) sc = 0.08838834764831845f; }
            else if (pn < 8) { dst0 = V + (pn - 4) * 256; ld = 1024; }
            else if (pn < 12) { dst0 = AB + (pn - 8) * 256; ld = 2048; }
            else { dst0 = SKV + 256; ld = 512; }
            EPI_IN_ROWS({
                bf16_t* dst = dst0 + (size_t)row * ld;
                _Pragma("unroll") for (int bj = 0; bj < 2; ++bj) *(u32x4*)(dst + bj * HALF + cpos) = pack8(v[bj][0] * sc, v[bj][1] * sc);
                if (pn == 17) {
                    float* o = nullptr;
                    if (u.pm == 64) o = out + OUT_VS + (size_t)(row - MP) * 256;
                    else if ((u.pm & 15) == 15 && ai == 1) o = out + OUT_VP + (size_t)((row >> 12) * 128 + ((row & 4095) - 3968)) * 256;
                    if (o) {
                        _Pragma("unroll") for (int bj = 0; bj < 2; ++bj) { *(f32x4*)(o + bj * HALF + cpos) = v[bj][0]; *(f32x4*)(o + bj * HALF + cpos + 4) = v[bj][1]; }
                    }
                }
            })
        } else if (pn < 17) {
            f32x4 gq[2][2];
            { const float* gn = pn < 16 ? qn : kn;
              _Pragma("unroll") for (int bj = 0; bj < 2; ++bj) { gq[bj][0] = *(const f32x4*)(gn + bj * 32 + 8 * fq); gq[bj][1] = *(const f32x4*)(gn + bj * 32 + 8 * fq + 4); } }
            const bool isq = pn < 16;
            EPI_IN_ROWS({
                float s = 0.f;
                _Pragma("unroll") for (int bj = 0; bj < 2; ++bj)
                    _Pragma("unroll") for (int n = 0; n < 2; ++n) s += (v[bj][n][0] * v[bj][n][0] + v[bj][n][1] * v[bj][n][1]) + (v[bj][n][2] * v[bj][n][2] + v[bj][n][3] * v[bj][n][3]);
                s += __shfl_xor(s, 16); s += __shfl_xor(s, 32);
                const float hr = __builtin_amdgcn_rsqf(s * (1.0f / 64.0f) + EPS);
                const float sc = isq ? (0.125f * LOG2E) * hr : hr;
                bf16_t* dst = isq ? AB + (size_t)row * 2048 + 1024 + ((pn - 12) * 4 + wc) * 64 : SKV + (size_t)row * 512 + wc * 64;
                float* o = nullptr;
                if (!isq) { if (u.pm == 64) o = out + OUT_KS + (size_t)(row - MP) * 256 + wc * 64;
                            else if ((u.pm & 15) == 15 && ai == 1) o = out + OUT_KP + (size_t)((row >> 12) * 128 + ((row & 4095) - 3968)) * 256 + wc * 64; }
                _Pragma("unroll") for (int bj = 0; bj < 2; ++bj) {
                    const int ch = bj * 32 + 8 * fq;
                    const f32x4 w0 = v[bj][0] * sc * gq[bj][0], w1 = v[bj][1] * sc * gq[bj][1];
                    *(u32x4*)(dst + ch) = pack8(w0, w1);
                    if (o) { *(f32x4*)(o + ch) = w0; *(f32x4*)(o + ch + 4) = w1; }
                }
            })
        } else {
            EPI_IN_ROWS({
                if (wc == 0 && fq < 2) { *(f32x4*)(GA + (size_t)row * 16 + 8 * fq) = v[0][0]; *(f32x4*)(GA + (size_t)row * 16 + 8 * fq + 4) = v[0][1]; }
            })
        }
    }
#undef EPI_IN_ROWS
};
struct EpiMerge {
    static constexpr bool AFTER_DRAIN = false, KEEP_PART0 = true;
    bf16_t* G; bf16_t* Go; int omask;
    __device__ __forceinline__ void operator()(Acc& acc, const Unit& u, int wr, int wc, int fr, int fq) const {
        const size_t off0 = (size_t)(u.pm * BM + wr * 64 + fr) * 2048 + u.pn * BM + wc * 32 + 8 * fq + (u.part ? 1024 : 0);
        u32x4 gw[2][4][2];
#pragma unroll
        for (int ai = 0; ai < 2; ++ai)
#pragma unroll
            for (int m = 0; m < 4; ++m)
#pragma unroll
                for (int bj = 0; bj < 2; ++bj) gw[ai][m][bj] = *(const u32x4*)(G + off0 + (size_t)(ai * HALF + m * 16) * 2048 + bj * HALF);
#pragma unroll
        for (int ai = 0; ai < 2; ++ai)
#pragma unroll
            for (int m = 0; m < 4; ++m) {
                const int row = u.pm * BM + ai * HALF + wr * 64 + m * 16 + fr;
#pragma unroll
                for (int bj = 0; bj < 2; ++bj) {
                    f32x4 a0, a1; unpack8(gw[ai][m][bj], a0, a1);
                    if (u.part == 0) { acc[ai][bj][m][0] *= a0; acc[ai][bj][m][1] *= a1; }
                    else {
                        bf16_t* po = Go + (size_t)(row & omask) * 2048 + u.pn * BM + bj * HALF + wc * 32 + 8 * fq;
                        *(u32x4*)po = pack8(a0 * acc[ai][bj][m][0], a1 * acc[ai][bj][m][1]);
                    }
                }
            }
    }
};
struct EpiFinal {
    static constexpr bool AFTER_DRAIN = true, KEEP_PART0 = false;
    const bf16_t* base; float* out; const float* gain; float* slots; unsigned* cnt; float scale;
    __device__ __forceinline__ void fused(Acc& acc, const Unit& u, int wr, int wc, int fr, int fq, LAS unsigned char* lds) const {
        LAS float* Pw = (LAS float*)lds; LAS float* S = (LAS float*)(lds + 4096);
#pragma unroll
        for (int ai = 0; ai < 2; ++ai)
#pragma unroll
            for (int m = 0; m < 4; ++m) {
                const int rt = ai * HALF + wr * 64 + m * 16 + fr; const int row = u.pm * BM + rt; float s = 0.f;
#pragma unroll
                for (int bj = 0; bj < 2; ++bj) {
                    const size_t off = (size_t)row * D + u.pn * BM + bj * HALF + wc * 32 + 8 * fq;
                    f32x4 b0, b1; unpack8(*(const u32x4*)(base + off), b0, b1);
                    const f32x4 v0 = b0 + acc[ai][bj][m][0] * scale, v1 = b1 + acc[ai][bj][m][1] * scale;
                    acc[ai][bj][m][0] = v0; acc[ai][bj][m][1] = v1;
                    s += (v0[0] * v0[0] + v0[1] * v0[1]) + (v0[2] * v0[2] + v0[3] * v0[3]) + (v1[0] * v1[0] + v1[1] * v1[1]) + (v1[2] * v1[2] + v1[3] * v1[3]);
                }
                s += __shfl_xor(s, 16); s += __shfl_xor(s, 32);
                if (fq == 0) Pw[rt * 4 + wc] = s;
            }
        __syncthreads();
        float mine = 0.f;
        if (threadIdx.x < 256) { const f32x4 p = *(const LAS f32x4*)(Pw + threadIdx.x * 4); mine = (p[0] + p[1]) + (p[2] + p[3]); }
        xchg_rstd(mine, S, 256, slots + (size_t)u.pm * BM * 16, u.pn, 4, cnt + 64 * u.pm, 4u);
        f32x4 gg[2][2];
#pragma unroll
        for (int bj = 0; bj < 2; ++bj) { const int col = u.pn * BM + bj * HALF + wc * 32 + 8 * fq; gg[bj][0] = *(const f32x4*)(gain + col); gg[bj][1] = *(const f32x4*)(gain + col + 4); }
#pragma unroll
        for (int ai = 0; ai < 2; ++ai)
#pragma unroll
            for (int m = 0; m < 4; ++m) {
                const int rt = ai * HALF + wr * 64 + m * 16 + fr; const int row = u.pm * BM + rt; const float rs = S[rt];
#pragma unroll
                for (int bj = 0; bj < 2; ++bj) {
                    const int col = u.pn * BM + bj * HALF + wc * 32 + 8 * fq; const size_t off = (size_t)row * D + col;
                    *(f32x4*)(out + off) = acc[ai][bj][m][0] * rs * gg[bj][0]; *(f32x4*)(out + off + 4) = acc[ai][bj][m][1] * rs * gg[bj][1];
                }
            }
    }
};
}

#define XB_TMO      128
#define XB_XCNT(j)  (256  + 64 * (j))
#define XB_XSUB(j)  (1280 + 64 * (j))
#define XB_XGEN(j)  (2304 + 64 * (j))
#define XB_TOP      3328
#define XB_TOPGEN   3392
#define XCD_BAR_WORDS 3456
#define XB_SPIN_CAP (1u << 20)
__device__ __forceinline__ unsigned xb_ld(unsigned* p)              { return __hip_atomic_load(p, __ATOMIC_RELAXED, __HIP_MEMORY_SCOPE_AGENT); }
__device__ __forceinline__ unsigned xb_add(unsigned* p, unsigned v) { return __hip_atomic_fetch_add(p, v, __ATOMIC_RELAXED, __HIP_MEMORY_SCOPE_AGENT); }
__device__ __forceinline__ unsigned xb_xcc_id() { return (unsigned)__builtin_amdgcn_s_getreg((3 << 11) | 20) & 0xFu; }
#define XB_SPIN(cond, bar) do { unsigned _sp = 0; while (cond) { __builtin_amdgcn_s_sleep(1); \
    if ((++_sp & 255u) == 0u) { if (xb_ld(&(bar)[XB_TMO])) break; if (_sp > XB_SPIN_CAP) { atomicAdd(&(bar)[XB_TMO], 1u); break; } } } } while (0)
struct XcdBarrier { unsigned* bar; unsigned x; volatile LAS unsigned* st; };
__device__ __forceinline__ XcdBarrier xcd_barrier_post(unsigned* bar, volatile LAS unsigned* st) {
    XcdBarrier b; b.bar = bar; b.x = xb_xcc_id(); b.st = st;
    if (threadIdx.x == 0) (void)xb_add(&bar[XB_XCNT(b.x)], 1u);
    return b;
}
__device__ __forceinline__ void xcd_barrier_complete(unsigned* bar, unsigned x, unsigned& nloc, unsigned& nx) {
    const unsigned G = gridDim.x * gridDim.y * gridDim.z;
    unsigned sum, cnt, mine, sp = 0u;
    for (;;) {
        sum = 0u; cnt = 0u; mine = 0u;
#pragma unroll
        for (unsigned j = 0; j < 16; ++j) { const unsigned c = xb_ld(&bar[XB_XCNT(j)]); sum += c; cnt += (c > 0u) ? 1u : 0u; mine = (j == x) ? c : mine; }
        if (sum == G) break;
        __builtin_amdgcn_s_sleep(1);
        if ((++sp & 255u) == 0u) { if (xb_ld(&bar[XB_TMO])) break; if (sp > XB_SPIN_CAP) { atomicAdd(&bar[XB_TMO], 1u); break; } }
    }
    nloc = mine > 0u ? mine : 1u; nx = cnt > 0u ? cnt : 1u;
}
__device__ __forceinline__ void xcd_barrier(const XcdBarrier& b) {
    asm volatile("s_waitcnt vmcnt(0)" ::: "memory");
    __syncthreads();
    if (threadIdx.x == 0) {
        unsigned* bar = b.bar;
        __builtin_amdgcn_s_waitcnt(0);
        unsigned nloc = b.st[0], nx = b.st[1];
        if (nloc == 0u) { xcd_barrier_complete(bar, b.x, nloc, nx); b.st[0] = nloc; b.st[1] = nx; }
        const unsigned old = xb_add(&bar[XB_XSUB(b.x)], 1u);
        const unsigned gen = old / nloc;
        if (old + 1u == (gen + 1u) * nloc) {
            __builtin_amdgcn_fence(__ATOMIC_RELEASE, "agent");
            asm volatile("s_waitcnt vmcnt(0)" ::: "memory");
            const unsigned og = xb_add(&bar[XB_TOP], 1u);
            const unsigned tg = og / nx;
            if (og + 1u == (tg + 1u) * nx) xb_add(&bar[XB_TOPGEN], 1u);
            else XB_SPIN(xb_ld(&bar[XB_TOPGEN]) == tg, bar);
            __builtin_amdgcn_fence(__ATOMIC_ACQUIRE, "agent");
            xb_add(&bar[XB_XGEN(b.x)], 1u);
            asm volatile("s_waitcnt vmcnt(0)" ::: "memory");
        } else {
            XB_SPIN(xb_ld(&bar[XB_XGEN(b.x)]) == gen, bar);
            __builtin_amdgcn_fence(__ATOMIC_ACQUIRE, "agent");
            asm volatile("s_waitcnt vmcnt(0)" ::: "memory");
        }
    }
    __syncthreads();
}

constexpr int NWAVES = 8, NTHREADS = 512;
constexpr int RING_BYTES = 131072;
constexpr int MISC_OFF = RING_BYTES + 320;
constexpr int LDS_BYTES = 147456;

struct Params {
    const float* in[23]; float* out; unsigned char* ws; int ph_lo, ph_hi;
};

__device__ __forceinline__ float wave_sum(float v) {
#pragma unroll
    for (int o = 1; o < 64; o <<= 1) v += __shfl_xor(v, o);
    return v;
}

__device__ __forceinline__ int vgroup_src(int kind, int g, int& cnt) {
    cnt = 32;
    if (kind == 0) return g * 32;
    if (kind == 1) { const int pn = g >> 3, tg = g & 7; return (tg >> 2) * FF + pn * 128 + (tg & 3) * 32; }
    const int tile = g >> 3, tg = g & 7;
    if (tile < 12) return g * 32;
    if (tile < 17) { const int bj = tg >> 2, wc = tg & 3; const int base = tile < 16 ? 3088 + (tile - 12) * 256 : 4112; return base + 64 * wc + 32 * bj; }
    if (tile == 17) return 4368 + tg * 32;
    if (tile < 26) return 4624 + (tg >> 2) * 1024 + (tile - 18) * 128 + (tg & 3) * 32;
    if (tg == 0) { cnt = 16; return 3072; }
    cnt = 0; return 0;
}
struct ConvSet { f32x4 v[8]; f32x4 g0, g1; };
struct ConvJob { const float* W; const float* gain; bf16_t* WT; int K, Norig, kind, kb, g; };
constexpr int G_UP = NUP / 32, G_DN = D / 32, G_IN = NIN_V / 32, G_BR = D / 32;
constexpr int I_UP = (D / 64) * G_UP, I_DN = (FF / 64) * G_DN, I_IN = (D / 64) * G_IN, I_BR = (2048 / 64) * G_BR, I_OUT = (D / 64) * G_BR;
template <int LIST> __host__ __device__ constexpr int conv_count() { return LIST == 0 ? I_UP : LIST == 1 ? I_DN + I_IN + I_BR + I_OUT : LIST == 2 ? I_UP : I_DN; }
template <int LIST> __device__ __forceinline__ ConvJob conv_job(int r, const Params& P) {
    unsigned char* outb = (unsigned char*)P.out; ConvJob j;
#define CJ_SET(W_, K_, N_, kind_, gain_, WT_, NG_) do { j.W = (W_); j.K = (K_); j.Norig = (N_); j.kind = (kind_); j.gain = (gain_); j.WT = (bf16_t*)(WT_); j.kb = r / (NG_); j.g = r % (NG_); } while (0)
    if (LIST == 0) CJ_SET(P.in[6], D, NUP, 1, P.in[5], outb + OW_UP1, G_UP);
    else if (LIST == 2) CJ_SET(P.in[20], D, NUP, 1, P.in[19], outb + OW_UP2, G_UP);
    else if (LIST == 3) CJ_SET(P.in[21], FF, D, 0, nullptr, P.ws + WS_WDN2, G_DN);
    else if (r < I_DN) CJ_SET(P.in[7], FF, D, 0, nullptr, outb + OW_DN1, G_DN);
    else if ((r -= I_DN) < I_IN) CJ_SET(P.in[9], D, 6672, 2, P.in[8], outb + OW_IN, G_IN);
    else if ((r -= I_IN) < I_BR) CJ_SET(P.in[17], 2048, D, 0, nullptr, outb + OW_BR, G_BR);
    else { r -= I_BR; CJ_SET(P.in[18], D, D, 0, nullptr, outb + OW_OUT, G_BR); }
#undef CJ_SET
    return j;
}
__device__ __forceinline__ void conv_fetch(const ConvJob& j, int lane, ConvSet& s) {
    const int k0 = 64 * j.kb; int cnt; const int src = vgroup_src(j.kind, j.g, cnt);
    const int ks = lane >> 3, n4 = (lane & 7) * 4, c = lane & 7; const bool okc = n4 < cnt;
    const float* gp = j.gain ? j.gain + k0 + 8 * c : j.W;
    s.g0 = *(const f32x4*)gp; s.g1 = *(const f32x4*)(gp + 4);
    const float* wp = j.W + (size_t)(k0 + ks) * j.Norig + src + (okc ? n4 : 0);
#pragma unroll
    for (int i = 0; i < 8; ++i) s.v[i] = *(const f32x4*)(wp + (size_t)(8 * i) * j.Norig);
}
__device__ __forceinline__ void conv_emit(const ConvJob& j, int lane, const ConvSet& s, LAS float* scr) {
    const int k0 = 64 * j.kb; int cnt; (void)vgroup_src(j.kind, j.g, cnt);
    const int ks = lane >> 3, n4 = (lane & 7) * 4, c = lane & 7; const bool okc = n4 < cnt;
    const f32x4 one = (f32x4){1.f, 1.f, 1.f, 1.f}; const f32x4 g0 = j.gain ? s.g0 : one, g1 = j.gain ? s.g1 : one;
#pragma unroll
    for (int i = 0; i < 8; ++i) { LAS float* sp = scr + (8 * i + ks) * 33 + n4;
#pragma unroll
        for (int e = 0; e < 4; ++e) sp[e] = okc ? s.v[i][e] : 0.f; }
    LDS_WAIT(); asm volatile("" ::: "memory");
#pragma unroll
    for (int q = 0; q < 4; ++q) { const int nn = (lane >> 3) + 8 * q; const LAS float* sr = scr + (8 * c) * 33 + nn;
        u32x4 o; o.x = cvtpk(sr[0 * 33] * g0[0], sr[1 * 33] * g0[1]); o.y = cvtpk(sr[2 * 33] * g0[2], sr[3 * 33] * g0[3]); o.z = cvtpk(sr[4 * 33] * g1[0], sr[5 * 33] * g1[1]); o.w = cvtpk(sr[6 * 33] * g1[2], sr[7 * 33] * g1[3]);
        *(u32x4*)(j.WT + (size_t)(j.g * 32 + nn) * j.K + k0 + 8 * c) = o; }
    LDS_WAIT(); asm volatile("" ::: "memory");
}
#define CONV_LANDED(s_) do { asm volatile("" :: "v"((s_).v[0]), "v"((s_).v[1]), "v"((s_).v[2]), "v"((s_).v[3]), "v"((s_).v[4]), "v"((s_).v[5]), "v"((s_).v[6]), "v"((s_).v[7]), "v"((s_).g0), "v"((s_).g1)); } while (0)
template <int LIST> __device__ __forceinline__ void convert_list(int first, int stride, const Params& P, LAS float* scr, int lane) {
    constexpr int n = conv_count<LIST>();
    if (first >= n) return;
    ConvSet A, B, C;
#define CONV_JOB(it_) conv_job<LIST>((it_) < n ? (it_) : n - 1, P)
    conv_fetch(CONV_JOB(first), lane, A); conv_fetch(CONV_JOB(first + stride), lane, B);
    CONV_LANDED(A); CONV_LANDED(B);
    for (int it = first; it < n; it += 3 * stride) {
        conv_fetch(CONV_JOB(it + 2 * stride), lane, C); conv_emit(CONV_JOB(it), lane, A, scr);
        conv_fetch(CONV_JOB(it + 3 * stride), lane, A); if (it + stride < n) conv_emit(CONV_JOB(it + stride), lane, B, scr);
        conv_fetch(CONV_JOB(it + 4 * stride), lane, B); if (it + 2 * stride < n) conv_emit(CONV_JOB(it + 2 * stride), lane, C, scr);
    }
#undef CONV_JOB
}

namespace swa {
constexpr int KST = 72, VSS = 96;
constexpr int OFF_K = 0, OFF_V = 192 * KST * 2, OFF_TBL = OFF_V + 192 * VSS * 2, LDS_USED = OFF_TBL + 4 * 256 * 4;
typedef short v4i16_t __attribute__((ext_vector_type(4)));
__device__ __forceinline__ s16x4 tr16(const LAS bf16_t* p) { return __builtin_bit_cast(s16x4, __builtin_amdgcn_ds_read_tr16_b64_v4i16((LAS v4i16_t*)p)); }
__device__ __forceinline__ int t5_bucket(int rel) {
    const int n = rel < 0 ? -rel : rel; const int ret = rel > 0 ? 16 : 0;
    if (n < 8) return ret + n;
    int large = 8 + (int)(2.0f * __log2f((float)n * 0.125f) + 1e-4f); if (large > 15) large = 15;
    return ret + large;
}
struct Item { int b, kh, c, kvmin, kvmax; bool samp; };
__device__ __forceinline__ Item decode(int item) {
    Item t; t.samp = item >= 1024;
    if (!t.samp) { t.b = item >> 8; t.kh = (item >> 6) & 3; t.c = item & 63; } else { const int s = item - 1024; t.b = s >> 2; t.kh = s & 3; t.c = 0; }
    t.kvmin = t.samp ? 0 : (t.c >= 2 ? 0 : 128 - 64 * t.c); t.kvmax = t.samp ? 144 : 192; return t;
}
__device__ __forceinline__ void fetch(const Item& t, const bf16_t* SKV, const float* cache_k, const float* cache_v, u32x4 (&kw)[3], u32x4 (&vw)[3]) {
    const int tid = threadIdx.x, ch = tid & 7;
#pragma unroll
    for (int i = 0; i < 3; ++i) {
        const int kv = (tid >> 3) + 64 * i;
        kw[i] = (u32x4){0u, 0u, 0u, 0u}; vw[i] = kw[i];
        if (t.samp && i < 2) {
            const float* pk = cache_k + ((size_t)(t.b * 128 + kv) * 4 + t.kh) * 64 + ch * 8; const float* pv = cache_v + ((size_t)(t.b * 128 + kv) * 4 + t.kh) * 64 + ch * 8;
            const f32x4 k0 = *(const f32x4*)pk, k1 = *(const f32x4*)(pk + 4), v0 = *(const f32x4*)pv, v1 = *(const f32x4*)(pv + 4);
            kw[i] = pg8::pack8(k0, k1); vw[i] = pg8::pack8(v0, v1);
        } else {
            const int kvc = kv < t.kvmin ? t.kvmin : (kv >= t.kvmax ? t.kvmax - 1 : kv);
            const size_t row = t.samp ? (size_t)(MP + t.b * 16 + (kvc - 128)) : (size_t)(t.b * SEQ + 64 * (t.c - 2) + kvc);
            const bf16_t* p = SKV + row * 512 + t.kh * 64 + ch * 8;
            kw[i] = *(const u32x4*)p; vw[i] = *(const u32x4*)(p + 256);
        }
    }
}
__device__ __forceinline__ void phase(LAS unsigned char* lds, int bx, int G, bf16_t* AB, bf16_t* dummy, const bf16_t* SKV, const float* cache_k, const float* cache_v, const float* sinks, const float* rel_bias) {
    const int tid = threadIdx.x, lane = tid & 63, r = lane & 31, h = lane >> 5; const int w = __builtin_amdgcn_readfirstlane(tid >> 6);
    LAS bf16_t* Ks = (LAS bf16_t*)(lds + OFF_K); LAS bf16_t* Vs = (LAS bf16_t*)(lds + OFF_V); LAS float* tbl = (LAS float*)(lds + OFF_TBL);
    constexpr int NITEMS = 1024 + 64;
    if (bx >= NITEMS) return;
    int cur_kh = -1;
    u32x4 kw[3], vw[3]; bf16x8 qn[4];
#define SWA_QFETCH(tt) do { size_t qrow_; int g_; if (!(tt).samp) { g_ = w >> 1; qrow_ = (size_t)((tt).b * SEQ + 64 * (tt).c + 32 * (w & 1) + r); } \
        else { const int ir_ = (32 * w + r) & 63; g_ = ir_ >> 4; qrow_ = (size_t)(MP + (tt).b * 16 + (ir_ & 15)); } \
        const bf16_t* Qp_ = AB + qrow_ * 2048 + 1024 + (4 * (tt).kh + g_) * 64; \
        _Pragma("unroll") for (int s_ = 0; s_ < 4; ++s_) qn[s_] = *(const bf16x8*)(Qp_ + 16 * s_ + 8 * h); } while (0)
    { const Item t0 = decode(bx); fetch(t0, SKV, cache_k, cache_v, kw, vw); SWA_QFETCH(t0); }
    asm volatile("" :: "v"(kw[0]), "v"(kw[1]), "v"(kw[2]), "v"(vw[0]), "v"(vw[1]), "v"(vw[2]));
    asm volatile("" :: "v"(qn[0]), "v"(qn[1]), "v"(qn[2]), "v"(qn[3]));
    for (int item = bx; item < NITEMS; item += G) {
        const Item t = decode(item);
        const bool samp = t.samp; const int b = t.b, kh = t.kh, c = t.c, kvmin = t.kvmin, kvmax = t.kvmax;
        {
            LAS bf16_t* kwp = opq(Ks + (tid >> 3) * KST + (tid & 7) * 8); LAS bf16_t* vwp = opq(Vs + (tid >> 3) * VSS + (tid & 7) * 8);
#pragma unroll
            for (int i = 0; i < 3; ++i) { const int kv = (tid >> 3) + 64 * i; const bool ok = kv >= kvmin && kv < kvmax; const u32x4 z4 = (u32x4){0u, 0u, 0u, 0u};
                *(LAS u32x4*)(kwp + 64 * i * KST) = ok ? kw[i] : z4; *(LAS u32x4*)(vwp + 64 * i * VSS) = ok ? vw[i] : z4; }
            if (kh != cur_kh) {
                LAS float* twp = opq(tbl + tid);
#pragma unroll
                for (int i = 0; i < 2; ++i) { const int idx = tid + 512 * i, g = idx >> 8, ii = idx & 255; twp[512 * i] = ii == 255 ? LOG2E * sinks[4 * kh + g] : LOG2E * rel_bias[t5_bucket(ii - 191) * 16 + 4 * kh + g]; }
                cur_kh = kh;
            }
        }
        __syncthreads();
        const bool active = !samp || w < 2;
        int g = 0, tq = 0;
        if (!samp) { g = w >> 1; tq = 32 * (w & 1) + r; }
        else { const int ir = (32 * w + r) & 63; g = ir >> 4; tq = ir & 15; }
        bf16x8 qf[4];
#pragma unroll
        for (int s = 0; s < 4; ++s) qf[s] = qn[s];
        if (item + G < NITEMS) { const Item tn = decode(item + G); fetch(tn, SKV, cache_k, cache_v, kw, vw); SWA_QFETCH(tn); }
        if (active) {
            f32x16 sc[6];
            {
                const LAS bf16_t* krp = opq(Ks + r * KST + 8 * h);
#pragma unroll
                for (int blk = 0; blk < 6; ++blk) {
                    f32x16 a = {0.f, 0.f, 0.f, 0.f, 0.f, 0.f, 0.f, 0.f, 0.f, 0.f, 0.f, 0.f, 0.f, 0.f, 0.f, 0.f};
#pragma unroll
                    for (int s = 0; s < 4; ++s) { const bf16x8 kf = *(const LAS bf16x8*)(krp + (32 * blk) * KST + 16 * s); a = MFMA32(kf, qf[s], a); }
                    sc[blk] = a;
                }
            }
            const float sink = tbl[g * 256 + 255];
            const LAS float* tb = opq(tbl + g * 256 + 63 - tq + 4 * h);
            const unsigned vm = (kvmax >= 192 ? 0xffffffu : ((1u << (kvmax >> 3)) - 1u)) & ~((1u << (kvmin >> 3)) - 1u);
            float mx = sink;
#pragma unroll
            for (int blk = 0; blk < 6; ++blk) {
#pragma unroll
                for (int i = 0; i < 16; ++i) { const float v = sc[blk][i] + tb[32 * blk + (i & 3) + 8 * (i >> 2)]; sc[blk][i] = v; mx = fmaxf(mx, v); }
                __builtin_amdgcn_sched_barrier(0);
            }
            mx = fmaxf(mx, __shfl_xor(mx, 32));
            float l = 0.f;
#pragma unroll
            for (int blk = 0; blk < 6; ++blk)
#pragma unroll
                for (int q4 = 0; q4 < 4; ++q4) {
                    const float vf = (float)((vm >> (4 * blk + q4)) & 1u);
                    float ps = 0.f;
#pragma unroll
                    for (int e = 0; e < 4; ++e) { const float p = __builtin_amdgcn_exp2f(sc[blk][4 * q4 + e] - mx) * vf; sc[blk][4 * q4 + e] = p; ps += p; }
                    l += ps;
                }
            l += __shfl_xor(l, 32);
            l += __builtin_amdgcn_exp2f(sink - mx);
            const float inv = 1.0f / l;
            f32x16 o[2];
#pragma unroll
            for (int d = 0; d < 2; ++d) o[d] = (f32x16){0.f, 0.f, 0.f, 0.f, 0.f, 0.f, 0.f, 0.f, 0.f, 0.f, 0.f, 0.f, 0.f, 0.f, 0.f, 0.f};
            const LAS bf16_t* vrp = opq_after(Vs + (4 * h + ((lane & 15) >> 2)) * VSS + 16 * ((lane >> 4) & 1) + 4 * (lane & 3), inv);
#pragma unroll
            for (int blk = 0; blk < 6; ++blk) {
#pragma unroll
                for (int s2 = 0; s2 < 2; ++s2) {
                    u32x4 pw; pw.x = cvtpk(sc[blk][8 * s2 + 0] * inv, sc[blk][8 * s2 + 1] * inv); pw.y = cvtpk(sc[blk][8 * s2 + 2] * inv, sc[blk][8 * s2 + 3] * inv);
                    pw.z = cvtpk(sc[blk][8 * s2 + 4] * inv, sc[blk][8 * s2 + 5] * inv); pw.w = cvtpk(sc[blk][8 * s2 + 6] * inv, sc[blk][8 * s2 + 7] * inv);
                    const bf16x8 pa = __builtin_bit_cast(bf16x8, pw);
#pragma unroll
                    for (int d = 0; d < 2; ++d) {
                        const LAS bf16_t* vp = vrp + (32 * blk + 16 * s2) * VSS + 32 * d;
                        const s16x4 lo = tr16(vp), hi = tr16(vp + 8 * VSS);
                        const bf16x8 vb = __builtin_shufflevector(lo, hi, 0, 1, 2, 3, 4, 5, 6, 7);
                        o[d] = MFMA32(pa, vb, o[d]);
                    }
                }
                __builtin_amdgcn_sched_barrier(0);
            }
            {
                const size_t orow0 = samp ? (size_t)(MP + b * 16) : (size_t)(b * SEQ + 64 * c + 32 * (w & 1));
                const int og0 = samp ? 2 * w : (w >> 1);
                bf16_t* ub = (dummy ? dummy + (orow0 & 2047) * 2048 : AB + orow0 * 2048) + 1024 + (4 * kh + og0) * 64;
                const unsigned lo = (unsigned)(4 * h * 2048 + r);
#pragma unroll
                for (int i = 0; i < 16; ++i) {
                    const int ro = samp ? ((i & 3) + 8 * ((i >> 2) & 1)) * 2048 + (i >> 3) * 64 : ((i & 3) + 8 * (i >> 2)) * 2048;
                    (ub + ro)[lo] = f2bf(o[0][i]); (ub + ro + 32)[lo] = f2bf(o[1][i]);
                }
            }
        }
        __syncthreads();
    }
#undef SWA_QFETCH
}
}

namespace gla {
constexpr int QST = 136, TST = 72, VST = 288;
constexpr int OFF_QS = 0, OFF_KS = OFF_QS + 64 * QST * 2, OFF_KDT = OFF_KS + 64 * QST * 2, OFF_A = OFF_KDT + 128 * TST * 2, OFF_VS = OFF_A + 64 * TST * 2;
constexpr int OFF_GA = OFF_VS + 64 * VST * 2, OFF_EB = OFF_GA + 16 * 68 * 4, OFF_CS = OFF_EB + 512, OFF_PART = OFF_CS + 2048, LDS_USED = OFF_PART + 2048;
static_assert(LDS_USED <= RING_BYTES && (OFF_VS % 16) == 0, "gla lds");
typedef short v4i16_t __attribute__((ext_vector_type(4)));
__device__ __forceinline__ s16x4 tr16(const LAS bf16_t* p) { return __builtin_bit_cast(s16x4, __builtin_amdgcn_ds_read_tr16_b64_v4i16((LAS v4i16_t*)p)); }
__device__ __forceinline__ float log_sigmoid(float z) { const float az = fabsf(z); return fminf(z, 0.f) - 0.6931471805599453f * __builtin_amdgcn_logf(1.f + __builtin_amdgcn_exp2f(-az * LOG2E)); }

template <bool FULL, bool PARTIAL  >
__device__ __forceinline__ void span(LAS unsigned char* lds, int row0, int nch, int nvalid_, int hd, const bf16_t* QK, const bf16_t* V, bf16_t* AB, const float* GA,
                                     const float* w_alpha, const float* b_alpha, const float* head_norm, const float* S0, float* Sout, float* Dout, bf16_t* dummy = nullptr) {
    const int tid = threadIdx.x, lane = tid & 63, r = lane & 31, h = lane >> 5; const int w = __builtin_amdgcn_readfirstlane(tid >> 6);
    const int kk = tid & 127, tg = tid >> 7;
    const int nvalid = PARTIAL ? nvalid_ : 64;
    LAS bf16_t* QS = (LAS bf16_t*)(lds + OFF_QS); LAS bf16_t* KS = (LAS bf16_t*)(lds + OFF_KS); LAS bf16_t* KdT = (LAS bf16_t*)(lds + OFF_KDT); LAS bf16_t* Ab = (LAS bf16_t*)(lds + OFF_A);
    LAS bf16_t* VS = (LAS bf16_t*)(lds + OFF_VS); LAS float* GAs = (LAS float*)(lds + OFF_GA); LAS float* EB = (LAS float*)(lds + OFF_EB); LAS float* CS = (LAS float*)(lds + OFF_CS);
    LAS float* PART = (LAS float*)(lds + OFF_PART);
    float wal[16];
#pragma unroll
    for (int i = 0; i < 16; ++i) wal[i] = w_alpha[i * 512 + hd * 128 + kk];
    const float bal = b_alpha[hd * 128 + kk];
    f32x16 Sacc[4];
    if (FULL && S0) {
        const float* s0p = S0 + (size_t)(4 * h) * 256 + 32 * w + r;
#pragma unroll
        for (int kb = 0; kb < 4; ++kb)
#pragma unroll
            for (int i = 0; i < 16; ++i) Sacc[kb][i] = s0p[(32 * kb + (i & 3) + 8 * (i >> 2)) * 256];
    } else {
#pragma unroll
        for (int kb = 0; kb < 4; ++kb)
#pragma unroll
            for (int i = 0; i < 16; ++i) Sacc[kb][i] = 0.f;
    }
    float dsum = 0.f;
    f32x4 raw_ga; u32x4 raw_k[2], raw_q[2];
    const int nv1 = nvalid - 1;
    const u32x4 z4 = (u32x4){0u, 0u, 0u, 0u};
#define GLA_FETCH_KG(cc) do { const int crow_ = row0 + 64 * (cc); int t_ = tid; asm volatile("" : "+v"(t_)); \
        const float* gau_ = GA + (size_t)crow_ * 16; const bf16_t* qku_ = QK + (size_t)crow_ * 1024 + hd * 128; \
        raw_ga = *(const f32x4*)(gau_ + (unsigned)(min(t_ >> 2, nv1) * 16 + (t_ & 3) * 4)); if (PARTIAL) { if ((t_ >> 2) >= nvalid) raw_ga = (f32x4){0.f, 0.f, 0.f, 0.f}; } \
        _Pragma("unroll") for (int i_ = 0; i_ < 2; ++i_) { raw_k[i_] = *(const u32x4*)(qku_ + 512 + (unsigned)(min((t_ >> 4) + 32 * i_, nv1) * 1024 + (t_ & 15) * 8)); if (PARTIAL) raw_k[i_] = ((t_ >> 4) + 32 * i_ < nvalid) ? raw_k[i_] : z4; \
            if (FULL) { raw_q[i_] = *(const u32x4*)(qku_ + (unsigned)(min((t_ >> 4) + 32 * i_, nv1) * 1024 + (t_ & 15) * 8)); if (PARTIAL) raw_q[i_] = ((t_ >> 4) + 32 * i_ < nvalid) ? raw_q[i_] : z4; } } } while (0)
#define GLA_FETCH_QV(cc) do { const int crow_ = row0 + 64 * (cc); int t_ = tid; asm volatile("" : "+v"(t_)); \
        const bf16_t* vu_ = V + (size_t)crow_ * 1024 + hd * 256; const bf16_t* qku_ = QK + (size_t)crow_ * 1024 + hd * 128; \
        _Pragma("unroll") for (int i_ = 0; i_ < 4; ++i_) { raw_v[i_] = *(const u32x4*)(vu_ + (unsigned)(min((t_ >> 5) + 16 * i_, nv1) * 1024 + (t_ & 31) * 8)); if (PARTIAL) raw_v[i_] = ((t_ >> 5) + 16 * i_ < nvalid) ? raw_v[i_] : z4; } } while (0)
    GLA_FETCH_KG(0);
    asm volatile("" :: "v"(raw_ga), "v"(raw_k[0]), "v"(raw_k[1]));
    if (FULL) asm volatile("" :: "v"(raw_q[0]), "v"(raw_q[1]));
    for (int c = 0; c < nch; ++c) {
        const int crow0 = row0 + 64 * c;
        if (tid < 256) { LAS float* gp_ = GAs + ((tid & 3) * 4) * 68 + (tid >> 2); gp_[0] = raw_ga[0]; gp_[68] = raw_ga[1]; gp_[136] = raw_ga[2]; gp_[204] = raw_ga[3]; }
        {
            LAS bf16_t* ks_st = opq(KS + (tid >> 4) * QST + (tid & 15) * 8);
#pragma unroll
            for (int i = 0; i < 2; ++i) { *(LAS u32x4*)(ks_st + 32 * i * QST) = raw_k[i]; if (FULL) *(LAS u32x4*)(ks_st - 64 * QST + 32 * i * QST) = raw_q[i]; }
        }
        u32x4 raw_v[4];
        GLA_FETCH_QV(c);
        __syncthreads();
        float bc[16]; float run = 0.f;
        const LAS float* ga_r = opq(GAs + 16 * tg);
        LAS float* cs_p = opq(CS + kk);
#pragma unroll
        for (int j = 0; j < 16; ++j) bc[j] = bal;
#pragma unroll
        for (int r2 = 0; r2 < 16; ++r2)
#pragma unroll
            for (int q4 = 0; q4 < 4; ++q4) { const f32x4 gq = *(const LAS f32x4*)(ga_r + r2 * 68 + q4 * 4);
#pragma unroll
                for (int e = 0; e < 4; ++e) bc[4 * q4 + e] += gq[e] * wal[r2]; }
#pragma unroll
        for (int j = 0; j < 16; ++j) { float la = log_sigmoid(bc[j]) * 0.0625f; if (PARTIAL) la = (16 * tg + j < nvalid) ? la : 0.f; run += la; bc[j] = run; }
        cs_p[tg * 128] = run;
        __syncthreads();
        float offs = 0.f, blast = 0.f;
#pragma unroll
        for (int g2 = 0; g2 < 4; ++g2) { const float cs = cs_p[g2 * 128]; blast += cs; if (g2 < tg) offs += cs; }
        const float eblast = fast_exp(blast);
        if (tg == 0) { EB[kk] = eblast; dsum += blast; }
        {
            LAS bf16_t* qs_e = opq(QS + (16 * tg) * QST + kk); LAS bf16_t* ks_e = qs_e + 64 * QST;
            LAS bf16_t* kdt_w = opq(KdT + kk * TST + 16 * tg);
            unsigned kdw[8];
#pragma unroll
            for (int j = 0; j < 16; j += 2) {
                const float b0 = bc[j] + offs, b1 = bc[j + 1] + offs;
                const float k0 = bf2f(ks_e[j * QST]), k1 = bf2f(ks_e[(j + 1) * QST]);
                const float e0 = fast_exp(b0), e1 = fast_exp(b1), r0 = __builtin_amdgcn_rcpf(e0), r1 = __builtin_amdgcn_rcpf(e1);
                const float kt0 = k0 * r0, kt1 = k1 * r1;
                kdw[j >> 1] = cvtpk(kt0 * eblast, kt1 * eblast);
                if (FULL) {
                    const float q0 = bf2f(qs_e[j * QST]), q1 = bf2f(qs_e[(j + 1) * QST]);
                    qs_e[j * QST] = f2bf(q0 * e0); qs_e[(j + 1) * QST] = f2bf(q1 * e1);
                    ks_e[j * QST] = f2bf(kt0); ks_e[(j + 1) * QST] = f2bf(kt1);
                }
            }
            *(LAS u32x4*)(kdt_w) = (u32x4){kdw[0], kdw[1], kdw[2], kdw[3]};
            *(LAS u32x4*)(kdt_w + 8) = (u32x4){kdw[4], kdw[5], kdw[6], kdw[7]};
        }
        {
            LAS bf16_t* vs_st = opq(VS + (tid >> 5) * VST + (tid & 31) * 8);
#pragma unroll
            for (int i = 0; i < 4; ++i) *(LAS u32x4*)(vs_st + 16 * i * VST) = raw_v[i];
        }
        if (c + 1 < nch) GLA_FETCH_KG(c + 1);
        __syncthreads();
        f32x16 oT[2]; u32x2 grv[2][4]; f32x4 hn[4];
        bf16x8 vfr[4];
        if (FULL) {
            if (w < 3) {
                const int tb = w == 0 ? 0 : 1, sb = w == 2 ? 1 : 0;
                const LAS bf16_t* qa_r = opq(QS + (32 * tb + r) * QST + 8 * h); const LAS bf16_t* kb_r = opq(KS + (32 * sb + r) * QST + 8 * h);
                f32x16 a = {0.f, 0.f, 0.f, 0.f, 0.f, 0.f, 0.f, 0.f, 0.f, 0.f, 0.f, 0.f, 0.f, 0.f, 0.f, 0.f};
#pragma unroll
                for (int s = 0; s < 8; ++s) {
                    const bf16x8 qa = *(const LAS bf16x8*)(qa_r + 16 * s);
                    const bf16x8 kb2 = *(const LAS bf16x8*)(kb_r + 16 * s);
                    a = MFMA32(qa, kb2, a);
                }
                LAS bf16_t* ab_w = opq(Ab + (32 * tb + 4 * h) * TST + 32 * sb + r);
                const int dl = 32 * sb + r - 32 * tb - 4 * h;
#pragma unroll
                for (int i = 0; i < 16; ++i) ab_w[((i & 3) + 8 * (i >> 2)) * TST] = f2bf(dl <= (i & 3) + 8 * (i >> 2) ? a[i] : 0.f);
            }
            const LAS bf16_t* qt_r4 = opq(QS + r * QST + 4 * h);
#pragma unroll
            for (int tb = 0; tb < 2; ++tb) oT[tb] = (f32x16){0.f, 0.f, 0.f, 0.f, 0.f, 0.f, 0.f, 0.f, 0.f, 0.f, 0.f, 0.f, 0.f, 0.f, 0.f, 0.f};
#pragma unroll
            for (int kb = 0; kb < 4; ++kb) {
#pragma unroll
                for (int s2 = 0; s2 < 2; ++s2) {
                    u32x4 sw; sw.x = cvtpk(Sacc[kb][8 * s2 + 0], Sacc[kb][8 * s2 + 1]); sw.y = cvtpk(Sacc[kb][8 * s2 + 2], Sacc[kb][8 * s2 + 3]);
                    sw.z = cvtpk(Sacc[kb][8 * s2 + 4], Sacc[kb][8 * s2 + 5]); sw.w = cvtpk(Sacc[kb][8 * s2 + 6], Sacc[kb][8 * s2 + 7]);
                    const bf16x8 sb = __builtin_bit_cast(bf16x8, sw);
#pragma unroll
                    for (int tb = 0; tb < 2; ++tb) {
                        const LAS bf16_t* qp = qt_r4 + (32 * tb) * QST + 32 * kb + 16 * s2;
                        const s16x4 lo = *(const LAS s16x4*)qp, hi = *(const LAS s16x4*)(qp + 8);
                        const bf16x8 qa = __builtin_shufflevector(lo, hi, 0, 1, 2, 3, 4, 5, 6, 7);
                        oT[tb] = MFMA32(sb, qa, oT[tb]);
                    }
                }
                __builtin_amdgcn_sched_barrier(0);
            }
            __syncthreads();
            {
                const LAS bf16_t* vt_r = opq(VS + (8 * h + ((lane & 15) >> 2)) * VST + 32 * w + 16 * ((lane >> 4) & 1) + 4 * (lane & 3));
#pragma unroll
                for (int s4 = 0; s4 < 4; ++s4) { const s16x4 vlo = tr16(vt_r + (16 * s4) * VST), vhi = tr16(vt_r + (16 * s4 + 4) * VST); vfr[s4] = __builtin_shufflevector(vlo, vhi, 0, 1, 2, 3, 4, 5, 6, 7); }
            }
#pragma unroll
            for (int tb = 0; tb < 2; ++tb)
#pragma unroll
                for (int q4 = 0; q4 < 4; ++q4) grv[tb][q4] = *(const u32x2*)(AB + (size_t)crow0 * 2048 + hd * 256 + 32 * w + 8 * q4 + (unsigned)(min(32 * tb + r, nv1) * 2048 + 4 * h));
#pragma unroll
            for (int q4 = 0; q4 < 4; ++q4) hn[q4] = *(const f32x4*)(head_norm + 32 * w + 4 * h + 8 * q4);
            const LAS bf16_t* ab_r = opq(Ab + r * TST + 8 * h);
#pragma unroll
            for (int tb = 0; tb < 2; ++tb)
#pragma unroll
                for (int sb = 0; sb < 2; ++sb) {
                    if (sb > tb) continue;
#pragma unroll
                    for (int s2 = 0; s2 < 2; ++s2) {
                        const bf16x8 aa = *(const LAS bf16x8*)(ab_r + (32 * tb) * TST + 32 * sb + 16 * s2);
                        oT[tb] = MFMA32(vfr[2 * sb + s2], aa, oT[tb]);
                    }
                }
        }
        const LAS bf16_t* kdt_r = opq(KdT + r * TST + 8 * h);
        if (!FULL) {
            const LAS bf16_t* vt_r2 = opq(VS + (8 * h + ((lane & 15) >> 2)) * VST + 32 * w + 16 * ((lane >> 4) & 1) + 4 * (lane & 3));
#pragma unroll
            for (int s4 = 0; s4 < 4; ++s4) { const s16x4 vlo = tr16(vt_r2 + (16 * s4) * VST), vhi = tr16(vt_r2 + (16 * s4 + 4) * VST); vfr[s4] = __builtin_shufflevector(vlo, vhi, 0, 1, 2, 3, 4, 5, 6, 7); }
        }
        const LAS float* eb_r = opq(EB + 4 * h);
#pragma unroll
        for (int kb = 0; kb < 4; ++kb) {
#pragma unroll
            for (int q4 = 0; q4 < 4; ++q4) { const f32x4 e = *(const LAS f32x4*)(eb_r + 32 * kb + 8 * q4);
#pragma unroll
                for (int e2 = 0; e2 < 4; ++e2) Sacc[kb][4 * q4 + e2] *= e[e2]; }
#pragma unroll
            for (int s = 0; s < 4; ++s) {
                const bf16x8 ka = *(const LAS bf16x8*)(kdt_r + (32 * kb) * TST + 16 * s);
                Sacc[kb] = MFMA32(ka, vfr[s], Sacc[kb]);
            }
            __builtin_amdgcn_sched_barrier(0);
        }
        LAS float* part_p = opq(PART + r);
        if (FULL) {
#pragma unroll
            for (int tb = 0; tb < 2; ++tb) { float p = 0.f;
#pragma unroll
                for (int i = 0; i < 16; ++i) p += oT[tb][i] * oT[tb][i];
                p += __shfl_xor(p, 32);
                if (h == 0) part_p[w * 64 + 32 * tb] = p; }
        }
        __syncthreads();
        if (FULL) {
#pragma unroll
            for (int tb = 0; tb < 2; ++tb) {
                float tot = 0.f;
#pragma unroll
                for (int w2 = 0; w2 < 8; ++w2) tot += part_p[w2 * 64 + 32 * tb];
                const float rs = __builtin_amdgcn_rsqf(tot * (1.0f / 256.0f) + EPS);
                if (32 * tb + r < nvalid) {
                    bf16_t* gp = (dummy ? dummy + (size_t)((crow0 + 32 * tb) & 2047) * 2048 : AB + (size_t)(crow0 + 32 * tb) * 2048) + hd * 256 + 32 * w + (unsigned)(r * 2048 + 4 * h);
#pragma unroll
                    for (int q4 = 0; q4 < 4; ++q4) {
                        const f32x4 g4 = (f32x4){bflo(grv[tb][q4].x), bfhi(grv[tb][q4].x), bflo(grv[tb][q4].y), bfhi(grv[tb][q4].y)};
                        f32x4 y;
#pragma unroll
                        for (int e = 0; e < 4; ++e) y[e] = oT[tb][4 * q4 + e] * rs * hn[q4][e] * siluf_(g4[e]);
                        *(u32x2*)(gp + 8 * q4) = (u32x2){cvtpk(y[0], y[1]), cvtpk(y[2], y[3])};
                    }
                }
            }
        }
    }
#undef GLA_FETCH_KG
#undef GLA_FETCH_QV
    if (Sout) {
#pragma unroll
        for (int kb = 0; kb < 4; ++kb)
#pragma unroll
            for (int i = 0; i < 16; ++i) Sout[(size_t)(32 * kb + crow(i, h)) * 256 + 32 * w + r] = Sacc[kb][i];
    }
    if (!FULL && tg == 0) Dout[kk] = fast_exp(dsum);
    __syncthreads();
}
}


namespace skinny {
typedef float f32x4v __attribute__((ext_vector_type(4)));
template <int NPARTS, int STEPS  , bool FINAL, class Epi>
__device__ __forceinline__ void phase(LAS unsigned char* lds, const bf16_t* A, int lda, const bf16_t* Bt, int ldb, int koff, float* ssq, int G, int bx, const Epi& E,
                                      const float* gain = nullptr, float* out = nullptr, unsigned* cnt = nullptr) {
    const int tid = threadIdx.x, lane = tid & 63, fr = lane & 15, fq = lane >> 4; const int w = __builtin_amdgcn_readfirstlane(tid >> 6);
    LAS f32x4* red = (LAS f32x4*)lds;
    LAS float* sred = (LAS float*)(lds + 8 * NPARTS * 4 * 64 * 16);
    constexpr int UB = STEPS > 4 ? 4 : STEPS;
    for (int pi = bx; pi < 256; pi += G) {
        const int rg = pi >> 4, cg = pi & 15;
        f32x4 acc[NPARTS][4];
#pragma unroll
        for (int p = 0; p < NPARTS; ++p) {
#pragma unroll
            for (int nt = 0; nt < 4; ++nt) acc[p][nt] = (f32x4){0.f, 0.f, 0.f, 0.f};
            const bf16_t* wp = Bt + (size_t)(64 * cg + fr) * ldb + p * koff + w * (STEPS * 32) + 8 * fq;
            const bf16_t* ap = A + (size_t)(MP + 16 * rg + fr) * lda + p * koff + w * (STEPS * 32) + 8 * fq;
            constexpr int NB = (STEPS + UB - 1) / UB;
            bf16x8 af[2][UB], wf[2][UB][4];
#define SK_LOAD(b_, s0_) do { _Pragma("unroll") for (int u = 0; u < UB; ++u) if ((s0_) + u < STEPS) { af[b_][u] = *(const bf16x8*)(ap + ((s0_) + u) * 32); \
                _Pragma("unroll") for (int nt = 0; nt < 4; ++nt) wf[b_][u][nt] = *(const bf16x8*)(wp + (size_t)(16 * nt) * ldb + ((s0_) + u) * 32); } } while (0)
#define SK_MMA(b_, s0_) do { _Pragma("unroll") for (int u = 0; u < UB; ++u) if ((s0_) + u < STEPS) { \
                _Pragma("unroll") for (int nt = 0; nt < 4; ++nt) acc[p][nt] = __builtin_amdgcn_mfma_f32_16x16x32_bf16(wf[b_][u][nt], af[b_][u], acc[p][nt], 0, 0, 0); } } while (0)
            SK_LOAD(0, 0);
#pragma unroll
            for (int b = 0; b < NB; ++b) {
                if (b + 1 < NB) { if ((b & 1) == 0) SK_LOAD(1, (b + 1) * UB); else SK_LOAD(0, (b + 1) * UB); }
                if ((b & 1) == 0) SK_MMA(0, b * UB); else SK_MMA(1, b * UB);
            }
#undef SK_LOAD
#undef SK_MMA
        }
#pragma unroll
        for (int p = 0; p < NPARTS; ++p)
#pragma unroll
            for (int nt = 0; nt < 4; ++nt) red[((w * NPARTS + p) * 4 + nt) * 64 + lane] = acc[p][nt];
        __syncthreads();
        f32x4 o = (f32x4){0.f, 0.f, 0.f, 0.f};
        if (w < 4) {
            f32x4 a2[NPARTS];
#pragma unroll
            for (int p = 0; p < NPARTS; ++p) { a2[p] = (f32x4){0.f, 0.f, 0.f, 0.f};
#pragma unroll
                for (int w2 = 0; w2 < 8; ++w2) a2[p] += red[((w2 * NPARTS + p) * 4 + w) * 64 + lane]; }
            const int row = MP + 16 * rg + fr, c0 = 64 * cg + 16 * w + 4 * fq;
            o = E(row, c0, a2);
            float s = (o[0] * o[0] + o[1] * o[1]) + (o[2] * o[2] + o[3] * o[3]);
            s += __shfl_xor(s, 16); s += __shfl_xor(s, 32);
            if (fq == 0) sred[w * 16 + fr] = s;
        }
        __syncthreads();
        if constexpr (FINAL) {
            float mine = 0.f; if (tid < 16) mine = (sred[tid] + sred[16 + tid]) + (sred[32 + tid] + sred[48 + tid]);
            LAS float* S = sred + 64;
            xchg_rstd(mine, S, 16, ssq + (size_t)(MP + 16 * rg) * 16, cg, 16, cnt + 64 * rg, 16u);
            if (w < 4) { const int row = MP + 16 * rg + fr, c0 = 64 * cg + 16 * w + 4 * fq; const f32x4 g4 = *(const f32x4*)(gain + c0); *(f32x4*)(out + (size_t)row * D + c0) = o * S[fr] * g4; }
        } else {
            if (ssq && tid < 16) ssq[(size_t)(MP + 16 * rg + tid) * 16 + cg] = (sred[tid] + sred[16 + tid]) + (sred[32 + tid] + sred[48 + tid]);
        }
        __syncthreads();
    }
}
__device__ __forceinline__ u32x2 pack4(const f32x4 v) { return (u32x2){cvtpk(v[0], v[1]), cvtpk(v[2], v[3])}; }
__device__ __forceinline__ f32x4 unpack4(const u32x2 w) { return (f32x4){bflo(w.x), bfhi(w.x), bflo(w.y), bfhi(w.y)}; }
template <bool BASE_BF16, bool OUT_F32, bool OUT_BF16> struct EpiResidual {
    const void* base; float* outf; bf16_t* outb; float scale;
    __device__ __forceinline__ f32x4 operator()(int row, int c0, const f32x4 (&acc)[1]) const {
        const size_t off = (size_t)row * D + c0;
        f32x4 b;
        if (BASE_BF16) b = unpack4(*(const u32x2*)((const bf16_t*)base + off)); else b = *(const f32x4*)((const float*)base + (off - (size_t)MP * D));
        const f32x4 v = b + acc[0] * scale;
        if (OUT_F32) *(f32x4*)(outf + off) = v;
        if (OUT_BF16) *(u32x2*)(outb + off) = pack4(v);
        return v;
    }
};
struct EpiMerge {
    bf16_t* G;
    __device__ __forceinline__ f32x4 operator()(int row, int c0, const f32x4 (&acc)[2]) const {
        bf16_t* pt = G + (size_t)row * 2048 + c0;
        const f32x4 rho = unpack4(*(const u32x2*)pt), sgb = unpack4(*(const u32x2*)(pt + 1024));
        const f32x4 m = sgb * (rho * acc[0] + acc[1]);
        *(u32x2*)pt = pack4(m);
        return m;
    }
};
}

__global__ void __launch_bounds__(NTHREADS, 2) fwd_kernel(Params P) {
    extern __shared__ __attribute__((aligned(16))) unsigned char lds_raw[];
    LAS unsigned char* lds = (LAS unsigned char*)lds_raw;
    volatile LAS unsigned* MISC = (volatile LAS unsigned*)(lds + MISC_OFF);
    const int tid = threadIdx.x, lane = tid & 63; const int wave = __builtin_amdgcn_readfirstlane(tid >> 6);
    const int G = gridDim.x, bx = blockIdx.x;
    unsigned char* ws = P.ws; float* out = P.out; unsigned char* outb = (unsigned char*)P.out;
    for (int u = tid; u < (LDS_BYTES - RING_BYTES) / 4; u += NTHREADS) ((LAS unsigned*)(lds + RING_BYTES))[u] = 0u;
    __syncthreads();
    const bool use_bar = (P.ph_hi - P.ph_lo) > 1;
    XcdBarrier bar; bar.bar = (unsigned*)(ws + WS_CTL); bar.x = 0; bar.st = nullptr;
    if (use_bar) bar = xcd_barrier_post((unsigned*)(ws + WS_CTL), MISC + 8);
    const int lo = P.ph_lo, hi = P.ph_hi;
#ifndef PHASE_MASK
#define PHASE_MASK 0xFFF
#endif
#define IN(k) (((PHASE_MASK >> (k)) & 1) && lo <= (k) && (k) < hi)
#define SEAM(k) do { if (IN(k) && IN((k) + 1)) xcd_barrier(bar); } while (0)
    float* ssq0 = (float*)(ws + WS_SSQ); float* ssq1 = (float*)(ws + WS_SSQ + SSQ_STRIDE); float* ssq2 = (float*)(ws + WS_SSQ + 2 * SSQ_STRIDE); float* ssq3 = (float*)(ws + WS_SSQ + 3 * SSQ_STRIDE);
    float* GA = (float*)(ws + WS_GA); float* DV = (float*)(ws + WS_DV);
    bf16_t* XA = (bf16_t*)(ws + WS_XA); bf16_t* QK = (bf16_t*)(ws + WS_QK); bf16_t* Vb = (bf16_t*)(ws + WS_V); bf16_t* Gb = (bf16_t*)(ws + WS_G); bf16_t* AB = (bf16_t*)(ws + WS_AB);
    bf16_t* SKV = (bf16_t*)(ws + WS_SKV); bf16_t* Hb = (bf16_t*)(ws + WS_H); float* X2F = (float*)(ws + WS_AB);
    bf16_t* Wup1 = (bf16_t*)(outb + OW_UP1); bf16_t* Wdn1 = (bf16_t*)(outb + OW_DN1); bf16_t* Win = (bf16_t*)(outb + OW_IN); bf16_t* Wbr = (bf16_t*)(outb + OW_BR);
    bf16_t* Wout = (bf16_t*)(outb + OW_OUT); bf16_t* Wup2 = (bf16_t*)(outb + OW_UP2); bf16_t* Wdn2 = (bf16_t*)(ws + WS_WDN2);
    float* DS = (float*)(outb + O_DS);
    const int gw = bx * NWAVES + wave, NGW = G * NWAVES;

#define CONVERT_LIST(LIST, first_, stride_) convert_list<LIST>((first_), (stride_), P, (LAS float*)(lds + wave * 16384), lane)
#define CONVERT_ON_LIGHT(LIST, nwg_) do { const int rem_ = (nwg_) % G; const int nl_ = rem_ ? G - rem_ : G, lc_ = rem_ ? bx - rem_ : bx; \
        if (lc_ >= 0) CONVERT_LIST(LIST, lc_ * NWAVES + wave, nl_ * NWAVES); } while (0)
    const bool split_conv = (lo == 0 && hi == 12);
    if (IN(0)) {
        CONVERT_LIST(0, gw, NGW);
        if (!split_conv) { CONVERT_LIST(1, gw, NGW); CONVERT_LIST(2, gw, NGW); CONVERT_LIST(3, gw, NGW); }
        {
            f32x4 v[2][4], vn[2][4];
            auto xrow = [&](int m) -> const f32x4* { const float* xr = (m < MP) ? P.in[0] + (size_t)m * D : P.in[1] + (size_t)(m - MP) * D; return (const f32x4*)xr + lane; };
            int m0 = 2 * gw;
            if (m0 < M) {
#pragma unroll
                for (int q = 0; q < 2; ++q) { const f32x4* xv = xrow(m0 + q);
#pragma unroll
                    for (int j = 0; j < 4; ++j) v[q][j] = xv[64 * j]; }
            }
            for (; m0 < M; m0 += 2 * NGW) {
                const int mn = m0 + 2 * NGW; const bool more = mn < M;
                if (more) {
#pragma unroll
                    for (int q = 0; q < 2; ++q) { const f32x4* xv = xrow(mn + q);
#pragma unroll
                        for (int j = 0; j < 4; ++j) vn[q][j] = xv[64 * j]; }
                }
                float sq[2];
#pragma unroll
                for (int q = 0; q < 2; ++q) { float s2 = 0.f;
#pragma unroll
                    for (int j = 0; j < 4; ++j) s2 += (v[q][j][0] * v[q][j][0] + v[q][j][1] * v[q][j][1]) + (v[q][j][2] * v[q][j][2] + v[q][j][3] * v[q][j][3]);
                    sq[q] = wave_sum(s2); }
#pragma unroll
                for (int q = 0; q < 2; ++q) { const int m = m0 + q; u32x2* o8 = (u32x2*)(XA + (size_t)m * D) + lane;
#pragma unroll
                    for (int j = 0; j < 4; ++j) o8[64 * j] = (u32x2){cvtpk(v[q][j][0], v[q][j][1]), cvtpk(v[q][j][2], v[q][j][3])};
                    if (lane == 0) ssq0[(size_t)m * 16] = __builtin_amdgcn_rsqf(sq[q] * (1.0f / D) + EPS); }
                if (more) {
#pragma unroll
                    for (int q = 0; q < 2; ++q)
#pragma unroll
                        for (int j = 0; j < 4; ++j) v[q][j] = vn[q][j];
                }
            }
        }
    }
    SEAM(0);
    LAS float* rtab = (LAS float*)(lds + RING_BYTES + 2048);
#define RSTD_TABLE_FILL(S_, ssq_, DIRECT_) do { \
        const int rr_ = tid & 255, uh_ = tid >> 8; f32x4 tv_[4][4]; bool ok_[4];     \
        _Pragma("unroll") for (int j_ = 0; j_ < 4; ++j_) { pg8::Unit u_; ok_[j_] = (S_).next(2 * j_ + uh_, u_); const float* p_ = (ssq_) + (size_t)((ok_[j_] ? u_.pm : 0) * 256 + rr_) * 16; \
            _Pragma("unroll") for (int q_ = 0; q_ < ((DIRECT_) ? 1 : 4); ++q_) tv_[j_][q_] = *(const f32x4*)(p_ + 4 * q_); } \
        _Pragma("unroll") for (int j_ = 0; j_ < 4; ++j_) { float r_; \
            if (DIRECT_) r_ = tv_[j_][0][0]; \
            else { const f32x4 a_ = tv_[j_][0], b_ = tv_[j_][1], c_ = tv_[j_][2], d_ = tv_[j_][3]; \
                   const float s_ = ((a_[0] + a_[1]) + (a_[2] + a_[3])) + ((b_[0] + b_[1]) + (b_[2] + b_[3])) + ((c_[0] + c_[1]) + (c_[2] + c_[3])) + ((d_[0] + d_[1]) + (d_[2] + d_[3])); \
                   r_ = __builtin_amdgcn_rsqf(s_ * (1.0f / D) + EPS); } \
            if (ok_[j_]) rtab[(2 * j_ + uh_) * 256 + rr_] = r_; } \
        __syncthreads(); } while (0)
    if (IN(1)) {
        pg8::Gemm g{XA, Wup1, D, D, D, 0}; pg8::Sched S; S.init(M, NUP, G, bx, 0);
        RSTD_TABLE_FILL(S, ssq0, true);
        pg8::EpiSwiglu E{Hb, rtab};
        pg8::gemm_phase(lds, g, S, E);
        if (split_conv) CONVERT_ON_LIGHT(1, (M / 256) * (NUP / 256));
    }
    SEAM(1);
    const bool stagger = (G == 256);
    const bool sk_early = stagger && ((bx >> 3) & 1) == 0;
    const int sk_piece = stagger ? (((bx >> 3) & 15) * 16 + 2 * (bx & 7) + (bx >> 7)) : bx;
    if (IN(2)) {
        pg8::Gemm g{Hb, Wdn1, FF, FF, FF, 0}; pg8::Sched S; S.init(MP, D, G, bx, 0);
        pg8::EpiResidual<true, false, true> E{XA, nullptr, nullptr, XA, ssq1, 0.5f};
        skinny::EpiResidual<true, false, true> Es{XA, nullptr, XA, 0.5f};
        if (sk_early) skinny::phase<1, FF / 256, false>(lds, Hb, FF, Wdn1, FF, 0, ssq1, G, sk_piece, Es);
        pg8::gemm_phase(lds, g, S, E);
        if (!sk_early) skinny::phase<1, FF / 256, false>(lds, Hb, FF, Wdn1, FF, 0, ssq1, G, sk_piece, Es);
    }
    SEAM(2);
    if (IN(3)) {
        pg8::Gemm g{XA, Win, D, D, D, 0}; pg8::Sched S; S.init(M, NIN_V, G, bx, 0);
        RSTD_TABLE_FILL(S, ssq1, false);
        pg8::EpiIn E{QK, Vb, Gb, AB, SKV, GA, rtab, P.in[13], P.in[14], out};
        pg8::gemm_phase(lds, g, S, E);
        if (split_conv) CONVERT_ON_LIGHT(2, (M / 256) * (NIN_V / 256));
    }
    SEAM(3);
    if (IN(4)) {
#ifndef P4_SKIP_GLA
#ifndef P4_SKIP_GLA_A
#if defined(PROBE_GLAA)
        for (int it = bx; it < 240; it += G) { const int bh = it / 15, sc = it % 15, b = bh >> 2, hd = bh & 3;
            gla::span<false, false>(lds, b * SEQ + sc * 256, 4, 64, hd, QK, Vb, AB, GA, P.in[10], P.in[11], P.in[12], nullptr, DS + (size_t)it * 32768, DV + (size_t)it * 128); }
#endif
        for (int it = bx; it < 240; it += G) { const int bh = it / 15, sc = it % 15, b = bh >> 2, hd = bh & 3;
            gla::span<false, false>(lds, b * SEQ + sc * 256, 4, 64, hd, QK, Vb, AB, GA, P.in[10], P.in[11], P.in[12], nullptr, DS + (size_t)it * 32768, DV + (size_t)it * 128); }
#endif
#ifndef P4_SKIP_GLA_S
        for (int s = (G - 1 - bx) ; s < 64; s += G) { const int db = s >> 2, hd = s & 3;
            gla::span<true, true>(lds, MP + db * 16, 1, 16, hd, QK, Vb, AB, GA, P.in[10], P.in[11], P.in[12], P.in[4] + (size_t)s * 32768, out + OUT_GS + (size_t)s * 32768, nullptr); }
#endif
#endif
#ifndef P4_SKIP_SWA
#if defined(PROBE_SWA)
        swa::phase(lds, bx, G, AB, (bf16_t*)(outb + 53 * MiB), SKV, P.in[2], P.in[3], P.in[15], P.in[16]);
#endif
        swa::phase(lds, bx, G, AB, nullptr, SKV, P.in[2], P.in[3], P.in[15], P.in[16]);
#endif
    }
    SEAM(4);
    if (IN(5)) {
        for (int gid = bx * NTHREADS + tid; gid < 16 * 8192; gid += G * NTHREADS) {
            const int bh = gid >> 13, e = gid & 8191, k = e >> 6;
            f32x4 ds[15]; float dd[15];
#pragma unroll
            for (int j = 0; j < 15; ++j) { ds[j] = *((const f32x4*)(DS + (size_t)(bh * 15 + j) * 32768) + e); dd[j] = DV[(size_t)(bh * 15 + j) * 128 + k]; }
            f32x4 Sv = (f32x4){0.f, 0.f, 0.f, 0.f};
#pragma unroll
            for (int j = 0; j < 15; ++j) { Sv = Sv * dd[j] + ds[j]; *((f32x4*)(DS + (size_t)(bh * 15 + j) * 32768) + e) = Sv; }
        }
    }
    SEAM(5);
    if (IN(6)) {
#if defined(PROBE_GLAC)
        for (int it = bx; it < 256; it += G) { const int bh = it >> 4, sc = it & 15, b = bh >> 2, hd = bh & 3;
            gla::span<true, false>(lds, b * SEQ + sc * 256, 4, 64, hd, QK, Vb, AB, GA, P.in[10], P.in[11], P.in[12], sc ? DS + (size_t)(bh * 15 + sc - 1) * 32768 : nullptr, nullptr, nullptr, (bf16_t*)(outb + 53 * MiB)); }
#endif
        for (int it = bx; it < 256; it += G) { const int bh = it >> 4, sc = it & 15, b = bh >> 2, hd = bh & 3;
            gla::span<true, false>(lds, b * SEQ + sc * 256, 4, 64, hd, QK, Vb, AB, GA, P.in[10], P.in[11], P.in[12], sc ? DS + (size_t)(bh * 15 + sc - 1) * 32768 : nullptr,
                            sc == 15 ? out + OUT_GP + (size_t)bh * 32768 : nullptr, nullptr); }
    }
    SEAM(6);
    if (IN(7)) {
        pg8::Gemm g{AB, Wbr, 2048, 2048, D, 1024}; pg8::Sched S; S.init(MP, D, G, bx, 1);
        pg8::EpiMerge E{Gb, Gb, 0x7fffffff};
        skinny::EpiMerge Es{Gb};
        if (sk_early) skinny::phase<2, D / 256, false>(lds, AB, 2048, Wbr, 2048, 1024, nullptr, G, sk_piece, Es);
        pg8::gemm_phase(lds, g, S, E);
        if (!sk_early) skinny::phase<2, D / 256, false>(lds, AB, 2048, Wbr, 2048, 1024, nullptr, G, sk_piece, Es);
    }
    SEAM(7);
    if (IN(8)) {
        pg8::Gemm g{Gb, Wout, 2048, D, D, 0}; pg8::Sched S; S.init(MP, D, G, bx, 0);
        pg8::EpiResidual<true, false, true> E{XA, nullptr, nullptr, QK, ssq2, 1.0f};
        skinny::EpiResidual<true, false, true> Es{XA, nullptr, QK, 1.0f};
        if (sk_early) skinny::phase<1, D / 256, false>(lds, Gb, 2048, Wout, D, 0, ssq2, G, sk_piece, Es);
        pg8::gemm_phase(lds, g, S, E);
        if (!sk_early) skinny::phase<1, D / 256, false>(lds, Gb, 2048, Wout, D, 0, ssq2, G, sk_piece, Es);
    }
    SEAM(8);
    if (IN(9)) {
        pg8::Gemm g{QK, Wup2, D, D, D, 0}; pg8::Sched S; S.init(M, NUP, G, bx, 0);
        RSTD_TABLE_FILL(S, ssq2, false);
        pg8::EpiSwiglu E{Hb, rtab};
        pg8::gemm_phase(lds, g, S, E);
        if (split_conv) CONVERT_ON_LIGHT(3, (M / 256) * (NUP / 256));
    }
    SEAM(9);
    const bool fuse_final = (G == 256) && IN(10) && IN(11);
    if (IN(10)) {
        pg8::Gemm g{Hb, Wdn2, FF, FF, FF, 0}; pg8::Sched S; S.init(MP, D, G, bx, 0);
        unsigned* xcnt = (unsigned*)(ws + WS_CTL) + 4096;
        if (fuse_final) {
            pg8::EpiFinal E{QK, out + OUT_Y, P.in[22], ssq3, xcnt, 0.5f};
            skinny::EpiResidual<true, false, false> Es{QK, nullptr, nullptr, 0.5f};
            if (sk_early) skinny::phase<1, FF / 256, true>(lds, Hb, FF, Wdn2, FF, 0, ssq3, G, sk_piece, Es, P.in[22], out + OUT_Y, xcnt + 64 * 64);
            pg8::gemm_phase(lds, g, S, E);
            if (!sk_early) skinny::phase<1, FF / 256, true>(lds, Hb, FF, Wdn2, FF, 0, ssq3, G, sk_piece, Es, P.in[22], out + OUT_Y, xcnt + 64 * 64);
        } else {
            pg8::EpiResidual<true, true, false> E{QK, nullptr, X2F, nullptr, ssq3, 0.5f};
            pg8::gemm_phase(lds, g, S, E);
            skinny::EpiResidual<true, true, false> Es{QK, X2F, nullptr, 0.5f};
            skinny::phase<1, FF / 256, false>(lds, Hb, FF, Wdn2, FF, 0, ssq3, G, bx, Es);
        }
    }
    if (!fuse_final) SEAM(10);
    if (IN(11) && !fuse_final) {
        const float* fn = P.in[22];
        for (int m = gw; m < M; m += NGW) {
            const float rs = row_rstd(ssq3, m);
            const f32x4* xv = (const f32x4*)(X2F + (size_t)m * D) + lane; f32x4* yv = (f32x4*)(out + OUT_Y + (size_t)m * D) + lane;
#pragma unroll
            for (int j = 0; j < 4; ++j) { const f32x4 g4 = *((const f32x4*)fn + lane + 64 * j); yv[64 * j] = xv[64 * j] * rs * g4; }
        }
    }
#undef IN
#undef SEAM
}

#ifndef N_LAUNCHES
#define N_LAUNCHES 1
#endif
extern "C" void kernel_launch(void* const* d_in, const int* in_sizes, int n_in, void* d_out, int out_size, void* d_ws, size_t ws_size, hipStream_t stream) {
    static int grid = 0;
    if (grid == 0) {
        if (n_in != 23 || ws_size < WS_END) { fprintf(stderr, "kernel_launch: unexpected inputs (n_in %d, ws %zu)\n", n_in, ws_size); grid = -1; return; }
        int dev = 0, cus = 0;
        if (hipGetDevice(&dev) != hipSuccess || hipDeviceGetAttribute(&cus, hipDeviceAttributeMultiprocessorCount, dev) != hipSuccess) { grid = -1; return; }
        if (hipFuncSetAttribute((const void*)fwd_kernel, hipFuncAttributeMaxDynamicSharedMemorySize, LDS_BYTES) != hipSuccess) { fprintf(stderr, "kernel_launch: hipFuncSetAttribute failed\n"); grid = -1; return; }
        (void)hipGetLastError();
        grid = cus;
    }
    if (grid < 0) return;
    (void)hipMemsetAsync((char*)d_ws + WS_CTL, 0, CTL_ZERO_BYTES, stream);
    Params p{};
    for (int i = 0; i < 23; ++i) p.in[i] = (const float*)d_in[i];
    p.out = (float*)d_out; p.ws = (unsigned char*)d_ws;
    if (N_LAUNCHES == 1) { p.ph_lo = 0; p.ph_hi = 12; hipLaunchKernelGGL(fwd_kernel, dim3(grid), dim3(NTHREADS), LDS_BYTES, stream, p); }
    else for (int k = 0; k < 12; ++k) { p.ph_lo = k; p.ph_hi = k + 1; hipLaunchKernelGGL(fwd_kernel, dim3(grid), dim3(NTHREADS), LDS_BYTES, stream, p); }
}
```

```cpp
#include <hip/hip_runtime.h>
#include <cstdio>
#include <cstdint>

#define LAS __attribute__((address_space(3)))
typedef unsigned short bf16_t;
typedef short bf16x8 __attribute__((ext_vector_type(8)));
typedef short s16x4 __attribute__((ext_vector_type(4)));
typedef float f32x4 __attribute__((ext_vector_type(4)));
typedef float f32x16 __attribute__((ext_vector_type(16)));
typedef unsigned u32x4 __attribute__((ext_vector_type(4)));
typedef unsigned u32x2 __attribute__((ext_vector_type(2)));
typedef float f32x2_t __attribute__((ext_vector_type(2)));
typedef __bf16 bf16x2_t __attribute__((ext_vector_type(2)));

constexpr int D = 1024, SEQ = 4096, NBATCH = 4, MP = NBATCH * SEQ, DBATCH = 16, DSEQ = 16, MS = DBATCH * DSEQ, M = MP + MS;
constexpr int FF = 2816, NUP = 2 * FF, NIN_V = 27 * 256;
constexpr int NCACHE = 128;
constexpr float EPS = 1e-6f;
constexpr float LOG2E = 1.4426950408889634f;

constexpr size_t MiB = 1u << 20;
constexpr size_t WS_CTL = 0, CTL_ZERO_BYTES = 64 * 1024;
constexpr size_t SSQ_BYTES = (size_t)M * 16 * 4;
constexpr size_t WS_SSQ = 65536, SSQ_STRIDE = SSQ_BYTES;
constexpr size_t WS_GA = WS_SSQ + 4 * SSQ_STRIDE;
constexpr size_t WS_DV = WS_GA + SSQ_BYTES;
constexpr size_t WS_XA = 5 * MiB + 512 * 1024;
constexpr size_t WS_QK = WS_XA + (size_t)M * 1024 * 2;
constexpr size_t WS_V = WS_QK + (size_t)M * 1024 * 2;
constexpr size_t WS_G = WS_V + (size_t)M * 1024 * 2;
constexpr size_t WS_AB = WS_G + (size_t)M * 2048 * 2;
constexpr size_t WS_SKV = WS_AB + (size_t)M * 2048 * 2;
constexpr size_t WS_WDN2 = WS_SKV + (size_t)M * 512 * 2;
constexpr size_t WS_END = WS_WDN2 + (size_t)1024 * FF * 2;
constexpr size_t WS_H = WS_V;
static_assert(WS_DV + 240 * 128 * 4 <= WS_XA && WS_XA + (size_t)M * 1024 * 2 <= WS_QK && WS_END <= 256 * MiB && (WS_GA % 16) == 0 && (WS_DV % 16) == 0 && (WS_WDN2 % 256) == 0, "ws map");
static_assert(WS_H + (size_t)M * FF * 2 <= WS_AB, "hidden overlay");
constexpr size_t OUT_Y = 0, OUT_KP = (size_t)M * D, OUT_VP = OUT_KP + 131072, OUT_GP = OUT_VP + 131072, OUT_KS = OUT_GP + 524288, OUT_VS = OUT_KS + 65536, OUT_GS = OUT_VS + 65536;
constexpr size_t OW_UP1 = 0, OW_DN1 = 11 * MiB, OW_IN = OW_DN1 + 5 * MiB + 512 * 1024, OW_BR = 30 * MiB, OW_OUT = 34 * MiB, OW_UP2 = 36 * MiB, OW_DN2 = 47 * MiB;
constexpr size_t O_DS = 0;
static_assert(OW_IN + (size_t)NIN_V * 1024 * 2 <= OW_BR && OW_DN2 + (size_t)1024 * FF * 2 <= (size_t)M * D * 4 && 240ull * 32768 * 4 <= OW_BR, "out map");

__device__ __forceinline__ unsigned cvtpk(float lo, float hi) { f32x2_t v = {lo, hi}; bf16x2_t b = __builtin_convertvector(v, bf16x2_t); return __builtin_bit_cast(unsigned, b); }
__device__ __forceinline__ float bf2f(unsigned short x) { return __uint_as_float((unsigned)x << 16); }
__device__ __forceinline__ float bflo(unsigned w) { return __uint_as_float(w << 16); }
__device__ __forceinline__ float bfhi(unsigned w) { return __uint_as_float(w & 0xffff0000u); }
__device__ __forceinline__ unsigned short f2bf(float f) { return (unsigned short)(cvtpk(f, 0.f) & 0xffffu); }
__device__ __forceinline__ float fast_exp(float x) { return __builtin_amdgcn_exp2f(x * LOG2E); }
__device__ __forceinline__ float sigmoidf_(float x) { return __builtin_amdgcn_rcpf(1.f + fast_exp(-x)); }
__device__ __forceinline__ float siluf_(float x) { return x * sigmoidf_(x); }
__device__ __forceinline__ int crow(int r, int hi) { return (r & 3) + 8 * (r >> 2) + 4 * hi; }
#if defined(__HIP_DEVICE_COMPILE__)
template <class T> __device__ __forceinline__ LAS T* opq(LAS T* p) { unsigned a = __builtin_bit_cast(unsigned, p); asm volatile("" : "+v"(a)); return __builtin_bit_cast(LAS T*, a); }
template <class T> __device__ __forceinline__ LAS T* opq_after(LAS T* p, float dep) { unsigned a = __builtin_bit_cast(unsigned, p); asm volatile("" : "+v"(a) : "v"(dep)); return __builtin_bit_cast(LAS T*, a); }
#else
template <class T> __device__ __forceinline__ LAS T* opq(LAS T* p) { return p; }
template <class T> __device__ __forceinline__ LAS T* opq_after(LAS T* p, float) { return p; }
#endif
#define LDS_WAIT() asm volatile("s_waitcnt lgkmcnt(0)" ::: "memory")
#define VM_WAIT() asm volatile("s_waitcnt vmcnt(0)" ::: "memory")
#define MFMA32(a, b, c) __builtin_amdgcn_mfma_f32_32x32x16_bf16((a), (b), (c), 0, 0, 0)

__device__ __forceinline__ float row_rstd(const float* ssq, int row) {
    const f32x4* p = (const f32x4*)(ssq + (size_t)row * 16);
    const f32x4 a = p[0], b = p[1], c = p[2], d = p[3];
    const float s = ((a[0] + a[1]) + (a[2] + a[3])) + ((b[0] + b[1]) + (b[2] + b[3])) + ((c[0] + c[1]) + (c[2] + c[3])) + ((d[0] + d[1]) + (d[2] + d[3]));
    return __builtin_amdgcn_rsqf(s * (1.0f / D) + EPS);
}


#define XC_SPIN_CAP (1u << 22)
__device__ __forceinline__ void xchg_rstd(float mine, LAS float* S, int nrows, float* slots, int myslot, int nslots, unsigned* cnt, unsigned need) {
    const int tid = threadIdx.x;
    if (tid < nrows) __hip_atomic_store((unsigned*)(slots + (size_t)tid * 16 + myslot), __float_as_uint(mine), __ATOMIC_RELAXED, __HIP_MEMORY_SCOPE_AGENT);
    asm volatile("s_waitcnt vmcnt(0)" ::: "memory");
    __syncthreads();
    if (tid < 64) {
        if (tid == 0) (void)__hip_atomic_fetch_add(cnt, 1u, __ATOMIC_RELAXED, __HIP_MEMORY_SCOPE_AGENT);
        unsigned sp = 0;
        while ((unsigned)__builtin_amdgcn_readfirstlane(__hip_atomic_load(cnt, __ATOMIC_RELAXED, __HIP_MEMORY_SCOPE_AGENT)) < need) { __builtin_amdgcn_s_sleep(2); if (++sp > XC_SPIN_CAP) break; }
        __builtin_amdgcn_fence(__ATOMIC_ACQUIRE, "agent");
        asm volatile("s_waitcnt vmcnt(0)" ::: "memory");
    }
    __syncthreads();
    if (tid < nrows) {
        float t = 0.f;
        for (int j = 0; j < nslots; ++j) t += __uint_as_float(__hip_atomic_load((unsigned*)(slots + (size_t)tid * 16 + j), __ATOMIC_RELAXED, __HIP_MEMORY_SCOPE_AGENT));
        S[tid] = __builtin_amdgcn_rsqf(t * (1.0f / D) + EPS);
    }
    __syncthreads();
}

namespace pg8 {
constexpr int BM = 256, BK = 64, HALF = 128, HTB = HALF * BK * 2, STAGE_BYTES = 8 * HTB, NXCD = 8, WGM = 4;
__host__ __device__ __forceinline__ int lds_byte(int r, int c) { const int st = (r >> 4) * 2 + (c >> 5), rr = r & 15, cc = c & 31, ob = rr * 64 + cc * 2; return st * 1024 + (ob ^ (((ob >> 9) & 1) << 5)); }
__host__ __device__ __forceinline__ void stage_rc(int b, int& R, int& C) { const int st = b / 1024, sb = b % 1024, swz = sb ^ (((sb >> 9) & 1) << 5); R = (st >> 1) * 16 + swz / 64; C = (st & 1) * 32 + (swz % 64) / 2; }
__host__ __device__ __forceinline__ int perm32(int rho) { const int n = rho >> 4, i = rho & 15; return 8 * (i >> 2) + 4 * n + (i & 3); }

struct Unit { int pm, pn, part, idx; };
struct Gemm { const bf16_t* A; const bf16_t* Bt; int lda, ldb, K; int koff; };

struct Sched {
    int nM, nN, nwg, G, c, psh;
    __device__ __forceinline__ void init(int M_, int N_, int G_, int c_, int psh_) { nM = M_ / BM; nN = N_ / BM; nwg = nM * nN; G = G_; c = c_; psh = psh_; }
    __device__ __forceinline__ bool next(int i, Unit& u) const {
        const long L = (long)(i >> psh) * G + c; if (L >= nwg) return false;
        int wgid = (int)L; { const int q = nwg / NXCD, r = nwg % NXCD, xcd = wgid % NXCD, off = wgid / NXCD; wgid = (xcd < r ? xcd * (q + 1) : r * (q + 1) + (xcd - r) * q) + off; }
        const int nig = WGM * nN, gid = wgid / nig, fm = gid * WGM, gsz = (nM - fm) < WGM ? (nM - fm) : WGM;
        u.pm = fm + ((wgid % nig) % gsz); u.pn = (wgid % nig) / gsz; u.part = i & ((1 << psh) - 1); u.idx = i; return true;
    }
};

typedef f32x4 Acc[2][2][4][2];

template <class Epi>
__device__ __forceinline__ void gemm_phase(LAS unsigned char* lds, const Gemm g, const Sched& S, const Epi& E) {
    const int tid = threadIdx.x, wid = __builtin_amdgcn_readfirstlane(tid >> 6), lane = tid & 63, wr = wid >> 2, wc = wid & 3, fr = lane & 15, fq = lane >> 4;
    const int K = g.K, nt = K / BK;
    unsigned voffA[2], voffB[2];
#pragma unroll
    for (int i = 0; i < 2; ++i) { int R, C; stage_rc(tid * 16 + i * 8192, R, C); const int Rb = (R & ~31) + perm32(R & 31);
        voffA[i] = (unsigned)(R * g.lda + C) * 2u; voffB[i] = (unsigned)(Rb * g.ldb + C) * 2u; }
    const size_t kstep = (size_t)(BK * 2);
    const size_t hstepA = (size_t)HALF * g.lda * 2, hstepB = (size_t)HALF * g.ldb * 2;
    const size_t tstepA = 2 * hstepA, tstepB = 2 * hstepB;
    const unsigned ldsw = (unsigned)wid * 1024u;
    const int aoff = lds_byte(wr * 64 + fr, fq * 8), boff = lds_byte(wc * 32 + fr, fq * 8);
#define PG8_SA(b, h) (((b) * 2 + (h)) * HTB)
#define PG8_SB(b, h) ((4 + (b) * 2 + (h)) * HTB)
#define PG8_STAGE(bufoff, gbase, voff) do { _Pragma("unroll") for (int _i = 0; _i < 2; ++_i) \
        __builtin_amdgcn_global_load_lds((const unsigned*)((const char*)(gbase) + (voff)[_i]), (LAS unsigned*)(lds + (bufoff) + ldsw + _i * 8192), 16, 0, 0); } while (0)
#define PG8_LDA(dst, b, h) do { _Pragma("unroll") for (int m = 0; m < 4; ++m) _Pragma("unroll") for (int k = 0; k < 2; ++k) dst[m][k] = *(const LAS bf16x8*)(lds + PG8_SA(b, h) + aoff + m * 2048 + k * 1024); } while (0)
#define PG8_LDB(dst, b, h) do { _Pragma("unroll") for (int n = 0; n < 2; ++n) _Pragma("unroll") for (int k = 0; k < 2; ++k) dst[n][k] = *(const LAS bf16x8*)(lds + PG8_SB(b, h) + boff + n * 2048 + k * 1024); } while (0)
#define PG8_MMA(ai, bj, At, Bt) do { __builtin_amdgcn_s_setprio(1); _Pragma("unroll") for (int m = 0; m < 4; ++m) _Pragma("unroll") for (int n = 0; n < 2; ++n) _Pragma("unroll") for (int k = 0; k < 2; ++k) \
        acc[ai][bj][m][n] = __builtin_amdgcn_mfma_f32_16x16x32_bf16(Bt[n][k], At[m][k], acc[ai][bj][m][n], 0, 0, 0); __builtin_amdgcn_s_setprio(0); } while (0)
#define PG8_WAIT_V(n) asm volatile("s_waitcnt vmcnt(" #n ")" ::: "memory")
#define PG8_WAIT_L(n) asm volatile("s_waitcnt lgkmcnt(" #n ")" ::: "memory")
#define PG8_BAR __builtin_amdgcn_s_barrier()
#define PG8_SCHED __builtin_amdgcn_sched_barrier(0)
    Unit cur, nxt; int ui = 0;
    if (!S.next(0, cur)) return;
    Acc acc;
#pragma unroll
    for (int a = 0; a < 2; ++a)
#pragma unroll
        for (int b = 0; b < 2; ++b)
#pragma unroll
            for (int m = 0; m < 4; ++m)
#pragma unroll
                for (int n = 0; n < 2; ++n) acc[a][b][m][n] = (f32x4){0.f, 0.f, 0.f, 0.f};
    bf16x8 At[4][2], B0[2][2], B1[2][2];
    const char* cA = (const char*)g.A + (size_t)cur.pm * tstepA + (size_t)cur.part * g.koff * 2; const char* cB = (const char*)g.Bt + (size_t)cur.pn * tstepB + (size_t)cur.part * g.koff * 2;
    PG8_STAGE(PG8_SB(0, 0), cB, voffB); PG8_STAGE(PG8_SB(0, 1), cB + hstepB, voffB); PG8_STAGE(PG8_SA(0, 0), cA, voffA); PG8_STAGE(PG8_SA(0, 1), cA + hstepA, voffA);
    if (wr == 1) PG8_BAR;
    PG8_WAIT_V(2); PG8_BAR;
    PG8_STAGE(PG8_SB(1, 0), cB + kstep, voffB); PG8_STAGE(PG8_SA(1, 0), cA + kstep, voffA); PG8_STAGE(PG8_SB(1, 1), cB + hstepB + kstep, voffB);
    PG8_WAIT_V(6); PG8_BAR;
    for (;;) {
        const bool has_next = S.next(ui + 1, nxt);
        const char* nA = has_next ? (const char*)g.A + (size_t)nxt.pm * tstepA + (size_t)nxt.part * g.koff * 2 : cA; const char* nB = has_next ? (const char*)g.Bt + (size_t)nxt.pn * tstepB + (size_t)nxt.part * g.koff * 2 : cB;
        for (int t = 0; t < nt; t += 2) {
            const bool last = (t == nt - 2);
            const char* a1 = cA + (size_t)(t + 1) * kstep;
            const char* a2 = last ? nA : cA + (size_t)(t + 2) * kstep; const char* b2 = last ? nB : cB + (size_t)(t + 2) * kstep;
            const char* a3 = a2 + kstep; const char* b3 = b2 + kstep;
            PG8_LDB(B0, 0, 0); PG8_LDB(B1, 0, 1); PG8_SCHED; PG8_LDA(At, 0, 0); PG8_STAGE(PG8_SA(1, 1), a1 + hstepA, voffA);
            PG8_WAIT_V(8); PG8_WAIT_L(0); PG8_BAR; PG8_MMA(0, 0, At, B0); PG8_MMA(0, 1, At, B1); PG8_BAR; PG8_SCHED;
            PG8_LDA(At, 0, 1); PG8_STAGE(PG8_SB(0, 0), b2, voffB); PG8_STAGE(PG8_SB(0, 1), b2 + hstepB, voffB); PG8_STAGE(PG8_SA(0, 0), a2, voffA);
            PG8_WAIT_V(8); PG8_WAIT_L(0); PG8_BAR; PG8_MMA(1, 0, At, B0); PG8_MMA(1, 1, At, B1); PG8_BAR; PG8_SCHED;
            PG8_LDB(B0, 1, 0); PG8_LDB(B1, 1, 1); PG8_SCHED; PG8_LDA(At, 1, 0); PG8_STAGE(PG8_SA(0, 1), a2 + hstepA, voffA);
            PG8_WAIT_V(8); PG8_WAIT_L(0); PG8_BAR; PG8_MMA(0, 0, At, B0); PG8_MMA(0, 1, At, B1); PG8_BAR; PG8_SCHED;
            PG8_LDA(At, 1, 1); PG8_STAGE(PG8_SB(1, 0), b3, voffB); PG8_STAGE(PG8_SB(1, 1), b3 + hstepB, voffB); PG8_STAGE(PG8_SA(1, 0), a3, voffA);
            PG8_WAIT_V(8); PG8_WAIT_L(0); PG8_BAR; PG8_MMA(1, 0, At, B0); PG8_MMA(1, 1, At, B1); PG8_BAR; PG8_SCHED;
        }
        if (wr == 0) PG8_BAR;
        if constexpr (!Epi::AFTER_DRAIN) E(acc, cur, wr, wc, fr, fq);
        if (!has_next) break;
        if (!(Epi::KEEP_PART0 && cur.part == 0))
#pragma unroll
        for (int a = 0; a < 2; ++a)
#pragma unroll
            for (int b = 0; b < 2; ++b)
#pragma unroll
                for (int m = 0; m < 4; ++m)
#pragma unroll
                    for (int n = 0; n < 2; ++n) acc[a][b][m][n] = (f32x4){0.f, 0.f, 0.f, 0.f};
        cur = nxt; cA = nA; cB = nB; ++ui;
        if (wr == 1) PG8_BAR;
    }
    PG8_WAIT_V(0);
    PG8_BAR;
    if constexpr (Epi::AFTER_DRAIN) E.fused(acc, cur, wr, wc, fr, fq, lds);
#undef PG8_SA
#undef PG8_SB
#undef PG8_STAGE
#undef PG8_LDA
#undef PG8_LDB
#undef PG8_MMA
#undef PG8_WAIT_V
#undef PG8_WAIT_L
#undef PG8_BAR
#undef PG8_SCHED
}

__device__ __forceinline__ u32x4 pack8(const f32x4 a, const f32x4 b) { u32x4 w; w.x = cvtpk(a[0], a[1]); w.y = cvtpk(a[2], a[3]); w.z = cvtpk(b[0], b[1]); w.w = cvtpk(b[2], b[3]); return w; }
__device__ __forceinline__ void unpack8(const u32x4 w, f32x4& a, f32x4& b) { a = (f32x4){bflo(w.x), bfhi(w.x), bflo(w.y), bfhi(w.y)}; b = (f32x4){bflo(w.z), bfhi(w.z), bflo(w.w), bfhi(w.w)}; }

struct EpiSwiglu {
    static constexpr bool AFTER_DRAIN = false, KEEP_PART0 = false;
    bf16_t* H; const LAS float* rtab;
    __device__ __forceinline__ void operator()(const Acc& acc, const Unit& u, int wr, int wc, int fr, int fq) const {
        const int col0 = u.pn * 128 + wc * 32 + 8 * fq;
        const LAS float* rt = rtab + u.idx * 256 + wr * 64 + fr;
#pragma unroll
        for (int ai = 0; ai < 2; ++ai)
#pragma unroll
            for (int m = 0; m < 4; ++m) {
                const int row = u.pm * BM + ai * HALF + wr * 64 + m * 16 + fr; const float r = rt[ai * HALF + m * 16];
                f32x4 h0, h1;
#pragma unroll
                for (int e = 0; e < 4; ++e) { h0[e] = siluf_(acc[ai][0][m][0][e] * r) * (acc[ai][1][m][0][e] * r); h1[e] = siluf_(acc[ai][0][m][1][e] * r) * (acc[ai][1][m][1][e] * r); }
                *(u32x4*)(H + (size_t)row * FF + col0) = pack8(h0, h1);
            }
    }
};
template <bool BASE_BF16, bool OUT_F32, bool OUT_BF16> struct EpiResidual {
    static constexpr bool AFTER_DRAIN = false, KEEP_PART0 = false;
    static_assert(BASE_BF16, "the residual stream is bf16");
    const void* base; const void* base_s; float* outf; bf16_t* outb; float* ssq; float scale;
    __device__ __forceinline__ void operator()(const Acc& acc, const Unit& u, int wr, int wc, int fr, int fq) const {
        const size_t off0 = (size_t)(u.pm * BM + wr * 64 + fr) * D + u.pn * BM + wc * 32 + 8 * fq;
        u32x4 bw[2][4][2];
#pragma unroll
        for (int ai = 0; ai < 2; ++ai)
#pragma unroll
            for (int m = 0; m < 4; ++m)
#pragma unroll
                for (int bj = 0; bj < 2; ++bj) bw[ai][m][bj] = *(const u32x4*)((const bf16_t*)base + off0 + (size_t)(ai * HALF + m * 16) * D + bj * HALF);
#pragma unroll
        for (int ai = 0; ai < 2; ++ai)
#pragma unroll
            for (int m = 0; m < 4; ++m) {
                const int row = u.pm * BM + ai * HALF + wr * 64 + m * 16 + fr; float s = 0.f;
#pragma unroll
                for (int bj = 0; bj < 2; ++bj) {
                    const size_t off = off0 + (size_t)(ai * HALF + m * 16) * D + bj * HALF;
                    f32x4 b0, b1; unpack8(bw[ai][m][bj], b0, b1);
                    const f32x4 v0 = b0 + acc[ai][bj][m][0] * scale, v1 = b1 + acc[ai][bj][m][1] * scale;
                    s += (v0[0] * v0[0] + v0[1] * v0[1]) + (v0[2] * v0[2] + v0[3] * v0[3]) + (v1[0] * v1[0] + v1[1] * v1[1]) + (v1[2] * v1[2] + v1[3] * v1[3]);
                    if (OUT_F32) { *(f32x4*)(outf + off) = v0; *(f32x4*)(outf + off + 4) = v1; }
                    if (OUT_BF16) *(u32x4*)(outb + off) = pack8(v0, v1);
                }
                s += __shfl_xor(s, 16); s += __shfl_xor(s, 32);
                if (fq == 0) ssq[(size_t)row * 16 + u.pn * 4 + wc] = s;
            }
    }
};
struct EpiIn {
    static constexpr bool AFTER_DRAIN = false, KEEP_PART0 = false;
    bf16_t *QK, *V, *G, *AB, *SKV; float* GA; const LAS float* rtab; const float *qn, *kn; float* out;
#define EPI_IN_ROWS(...) _Pragma("unroll") for (int ai = 0; ai < 2; ++ai) _Pragma("unroll") for (int m = 0; m < 4; ++m) { \
            const int row = u.pm * BM + ai * HALF + wr * 64 + m * 16 + fr; const float r = rt[ai * HALF + m * 16]; f32x4 v[2][2]; \
            _Pragma("unroll") for (int bj = 0; bj < 2; ++bj) _Pragma("unroll") for (int n = 0; n < 2; ++n) v[bj][n] = acc[ai][bj][m][n] * r; \
            __VA_ARGS__ }
    __device__ __forceinline__ void operator()(const Acc& acc, const Unit& u, int wr, int wc, int fr, int fq) const {
        const int pn = u.pn, cpos = wc * 32 + 8 * fq;
        const LAS float* rt = rtab + u.idx * 256 + wr * 64 + fr;
        if (pn >= 18 && pn < 26) {
            EPI_IN_ROWS({
                bf16_t* dst = G + (size_t)row * 2048 + (pn - 18) * 128 + cpos;
                f32x4 r0, r1, s0, s1;
                _Pragma("unroll") for (int e = 0; e < 4; ++e) {
                    const float ea0 = fast_exp(-v[0][0][e]), ea1 = fast_exp(-v[0][1][e]), eb0 = fast_exp(-v[1][0][e]), eb1 = fast_exp(-v[1][1][e]);
                    s0[e] = __builtin_amdgcn_rcpf(1.f + eb0); s1[e] = __builtin_amdgcn_rcpf(1.f + eb1);
                    r0[e] = (1.f + eb0) * __builtin_amdgcn_rcpf(1.f + ea0); r1[e] = (1.f + eb1) * __builtin_amdgcn_rcpf(1.f + ea1);
                }
                *(u32x4*)dst = pack8(r0, r1); *(u32x4*)(dst + 1024) = pack8(s0, s1);
            })
        } else if (pn < 12 || pn == 17) {
            bf16_t* dst0; size_t ld; float sc = 1.f;
            if (pn < 4) { dst0 = QK + pn * 256; ld = 1024; if (pn < 2) sc = 0.08838834764831845f; }
            else if (pn < 8) { dst0 = V + (pn - 4) * 256; ld = 1024; }
            else if (pn < 12) { dst0 = AB + (pn - 8) * 256; ld = 2048; }
            else { dst0 = SKV + 256; ld = 512; }
            EPI_IN_ROWS({
                bf16_t* dst = dst0 + (size_t)row * ld;
                _Pragma("unroll") for (int bj = 0; bj < 2; ++bj) *(u32x4*)(dst + bj * HALF + cpos) = pack8(v[bj][0] * sc, v[bj][1] * sc);
                if (pn == 17) {
                    float* o = nullptr;
                    if (u.pm == 64) o = out + OUT_VS + (size_t)(row - MP) * 256;
                    else if ((u.pm & 15) == 15 && ai == 1) o = out + OUT_VP + (size_t)((row >> 12) * 128 + ((row & 4095) - 3968)) * 256;
                    if (o) {
                        _Pragma("unroll") for (int bj = 0; bj < 2; ++bj) { *(f32x4*)(o + bj * HALF + cpos) = v[bj][0]; *(f32x4*)(o + bj * HALF + cpos + 4) = v[bj][1]; }
                    }
                }
            })
        } else if (pn < 17) {
            f32x4 gq[2][2];
            { const float* gn = pn < 16 ? qn : kn;
              _Pragma("unroll") for (int bj = 0; bj < 2; ++bj) { gq[bj][0] = *(const f32x4*)(gn + bj * 32 + 8 * fq); gq[bj][1] = *(const f32x4*)(gn + bj * 32 + 8 * fq + 4); } }
            const bool isq = pn < 16;
            EPI_IN_ROWS({
                float s = 0.f;
                _Pragma("unroll") for (int bj = 0; bj < 2; ++bj)
                    _Pragma("unroll") for (int n = 0; n < 2; ++n) s += (v[bj][n][0] * v[bj][n][0] + v[bj][n][1] * v[bj][n][1]) + (v[bj][n][2] * v[bj][n][2] + v[bj][n][3] * v[bj][n][3]);
                s += __shfl_xor(s, 16); s += __shfl_xor(s, 32);
                const float hr = __builtin_amdgcn_rsqf(s * (1.0f / 64.0f) + EPS);
                const float sc = isq ? (0.125f * LOG2E) * hr : hr;
                bf16_t* dst = isq ? AB + (size_t)row * 2048 + 1024 + ((pn - 12) * 4 + wc) * 64 : SKV + (size_t)row * 512 + wc * 64;
                float* o = nullptr;
                if (!isq) { if (u.pm == 64) o = out + OUT_KS + (size_t)(row - MP) * 256 + wc * 64;
                            else if ((u.pm & 15) == 15 && ai == 1) o = out + OUT_KP + (size_t)((row >> 12) * 128 + ((row & 4095) - 3968)) * 256 + wc * 64; }
                _Pragma("unroll") for (int bj = 0; bj < 2; ++bj) {
                    const int ch = bj * 32 + 8 * fq;
                    const f32x4 w0 = v[bj][0] * sc * gq[bj][0], w1 = v[bj][1] * sc * gq[bj][1];
                    *(u32x4*)(dst + ch) = pack8(w0, w1);
                    if (o) { *(f32x4*)(o + ch) = w0; *(f32x4*)(o + ch + 4) = w1; }
                }
            })
        } else {
            EPI_IN_ROWS({
                if (wc == 0 && fq < 2) { *(f32x4*)(GA + (size_t)row * 16 + 8 * fq) = v[0][0]; *(f32x4*)(GA + (size_t)row * 16 + 8 * fq + 4) = v[0][1]; }
            })
        }
    }
#undef EPI_IN_ROWS
};
struct EpiMerge {
    static constexpr bool AFTER_DRAIN = false, KEEP_PART0 = true;
    bf16_t* G; bf16_t* Go; int omask;
    __device__ __forceinline__ void operator()(Acc& acc, const Unit& u, int wr, int wc, int fr, int fq) const {
        const size_t off0 = (size_t)(u.pm * BM + wr * 64 + fr) * 2048 + u.pn * BM + wc * 32 + 8 * fq + (u.part ? 1024 : 0);
        u32x4 gw[2][4][2];
#pragma unroll
        for (int ai = 0; ai < 2; ++ai)
#pragma unroll
            for (int m = 0; m < 4; ++m)
#pragma unroll
                for (int bj = 0; bj < 2; ++bj) gw[ai][m][bj] = *(const u32x4*)(G + off0 + (size_t)(ai * HALF + m * 16) * 2048 + bj * HALF);
#pragma unroll
        for (int ai = 0; ai < 2; ++ai)
#pragma unroll
            for (int m = 0; m < 4; ++m) {
                const int row = u.pm * BM + ai * HALF + wr * 64 + m * 16 + fr;
#pragma unroll
                for (int bj = 0; bj < 2; ++bj) {
                    f32x4 a0, a1; unpack8(gw[ai][m][bj], a0, a1);
                    if (u.part == 0) { acc[ai][bj][m][0] *= a0; acc[ai][bj][m][1] *= a1; }
                    else {
                        bf16_t* po = Go + (size_t)(row & omask) * 2048 + u.pn * BM + bj * HALF + wc * 32 + 8 * fq;
                        *(u32x4*)po = pack8(a0 * acc[ai][bj][m][0], a1 * acc[ai][bj][m][1]);
                    }
                }
            }
    }
};
struct EpiFinal {
    static constexpr bool AFTER_DRAIN = true, KEEP_PART0 = false;
    const bf16_t* base; float* out; const float* gain; float* slots; unsigned* cnt; float scale;
    __device__ __forceinline__ void fused(Acc& acc, const Unit& u, int wr, int wc, int fr, int fq, LAS unsigned char* lds) const {
        LAS float* Pw = (LAS float*)lds; LAS float* S = (LAS float*)(lds + 4096);
#pragma unroll
        for (int ai = 0; ai < 2; ++ai)
#pragma unroll
            for (int m = 0; m < 4; ++m) {
                const int rt = ai * HALF + wr * 64 + m * 16 + fr; const int row = u.pm * BM + rt; float s = 0.f;
#pragma unroll
                for (int bj = 0; bj < 2; ++bj) {
                    const size_t off = (size_t)row * D + u.pn * BM + bj * HALF + wc * 32 + 8 * fq;
                    f32x4 b0, b1; unpack8(*(const u32x4*)(base + off), b0, b1);
                    const f32x4 v0 = b0 + acc[ai][bj][m][0] * scale, v1 = b1 + acc[ai][bj][m][1] * scale;
                    acc[ai][bj][m][0] = v0; acc[ai][bj][m][1] = v1;
                    s += (v0[0] * v0[0] + v0[1] * v0[1]) + (v0[2] * v0[2] + v0[3] * v0[3]) + (v1[0] * v1[0] + v1[1] * v1[1]) + (v1[2] * v1[2] + v1[3] * v1[3]);
                }
                s += __shfl_xor(s, 16); s += __shfl_xor(s, 32);
                if (fq == 0) Pw[rt * 4 + wc] = s;
            }
        __syncthreads();
        float mine = 0.f;
        if (threadIdx.x < 256) { const f32x4 p = *(const LAS f32x4*)(Pw + threadIdx.x * 4); mine = (p[0] + p[1]) + (p[2] + p[3]); }
        xchg_rstd(mine, S, 256, slots + (size_t)u.pm * BM * 16, u.pn, 4, cnt + 64 * u.pm, 4u);
        f32x4 gg[2][2];
#pragma unroll
        for (int bj = 0; bj < 2; ++bj) { const int col = u.pn * BM + bj * HALF + wc * 32 + 8 * fq; gg[bj][0] = *(const f32x4*)(gain + col); gg[bj][1] = *(const f32x4*)(gain + col + 4); }
#pragma unroll
        for (int ai = 0; ai < 2; ++ai)
#pragma unroll
            for (int m = 0; m < 4; ++m) {
                const int rt = ai * HALF + wr * 64 + m * 16 + fr; const int row = u.pm * BM + rt; const float rs = S[rt];
#pragma unroll
                for (int bj = 0; bj < 2; ++bj) {
                    const int col = u.pn * BM + bj * HALF + wc * 32 + 8 * fq; const size_t off = (size_t)row * D + col;
                    *(f32x4*)(out + off) = acc[ai][bj][m][0] * rs * gg[bj][0]; *(f32x4*)(out + off + 4) = acc[ai][bj][m][1] * rs * gg[bj][1];
                }
            }
    }
};
}

#define XB_TMO      128
#define XB_XCNT(j)  (256  + 64 * (j))
#define XB_XSUB(j)  (1280 + 64 * (j))
#define XB_XGEN(j)  (2304 + 64 * (j))
#define XB_TOP      3328
#define XB_TOPGEN   3392
#define XCD_BAR_WORDS 3456
#define XB_SPIN_CAP (1u << 20)
__device__ __forceinline__ unsigned xb_ld(unsigned* p)              { return __hip_atomic_load(p, __ATOMIC_RELAXED, __HIP_MEMORY_SCOPE_AGENT); }
__device__ __forceinline__ unsigned xb_add(unsigned* p, unsigned v) { return __hip_atomic_fetch_add(p, v, __ATOMIC_RELAXED, __HIP_MEMORY_SCOPE_AGENT); }
__device__ __forceinline__ unsigned xb_xcc_id() { return (unsigned)__builtin_amdgcn_s_getreg((3 << 11) | 20) & 0xFu; }
#define XB_SPIN(cond, bar) do { unsigned _sp = 0; while (cond) { __builtin_amdgcn_s_sleep(1); \
    if ((++_sp & 255u) == 0u) { if (xb_ld(&(bar)[XB_TMO])) break; if (_sp > XB_SPIN_CAP) { atomicAdd(&(bar)[XB_TMO], 1u); break; } } } } while (0)
struct XcdBarrier { unsigned* bar; unsigned x; volatile LAS unsigned* st; };
__device__ __forceinline__ XcdBarrier xcd_barrier_post(unsigned* bar, volatile LAS unsigned* st) {
    XcdBarrier b; b.bar = bar; b.x = xb_xcc_id(); b.st = st;
    if (threadIdx.x == 0) (void)xb_add(&bar[XB_XCNT(b.x)], 1u);
    return b;
}
__device__ __forceinline__ void xcd_barrier_complete(unsigned* bar, unsigned x, unsigned& nloc, unsigned& nx) {
    const unsigned G = gridDim.x * gridDim.y * gridDim.z;
    unsigned sum, cnt, mine, sp = 0u;
    for (;;) {
        sum = 0u; cnt = 0u; mine = 0u;
#pragma unroll
        for (unsigned j = 0; j < 16; ++j) { const unsigned c = xb_ld(&bar[XB_XCNT(j)]); sum += c; cnt += (c > 0u) ? 1u : 0u; mine = (j == x) ? c : mine; }
        if (sum == G) break;
        __builtin_amdgcn_s_sleep(1);
        if ((++sp & 255u) == 0u) { if (xb_ld(&bar[XB_TMO])) break; if (sp > XB_SPIN_CAP) { atomicAdd(&bar[XB_TMO], 1u); break; } }
    }
    nloc = mine > 0u ? mine : 1u; nx = cnt > 0u ? cnt : 1u;
}
__device__ __forceinline__ void xcd_barrier(const XcdBarrier& b) {
    asm volatile("s_waitcnt vmcnt(0)" ::: "memory");
    __syncthreads();
    if (threadIdx.x == 0) {
        unsigned* bar = b.bar;
        __builtin_amdgcn_s_waitcnt(0);
        unsigned nloc = b.st[0], nx = b.st[1];
        if (nloc == 0u) { xcd_barrier_complete(bar, b.x, nloc, nx); b.st[0] = nloc; b.st[1] = nx; }
        const unsigned old = xb_add(&bar[XB_XSUB(b.x)], 1u);
        const unsigned gen = old / nloc;
        if (old + 1u == (gen + 1u) * nloc) {
            __builtin_amdgcn_fence(__ATOMIC_RELEASE, "agent");
            asm volatile("s_waitcnt vmcnt(0)" ::: "memory");
            const unsigned og = xb_add(&bar[XB_TOP], 1u);
            const unsigned tg = og / nx;
            if (og + 1u == (tg + 1u) * nx) xb_add(&bar[XB_TOPGEN], 1u);
            else XB_SPIN(xb_ld(&bar[XB_TOPGEN]) == tg, bar);
            __builtin_amdgcn_fence(__ATOMIC_ACQUIRE, "agent");
            xb_add(&bar[XB_XGEN(b.x)], 1u);
            asm volatile("s_waitcnt vmcnt(0)" ::: "memory");
        } else {
            XB_SPIN(xb_ld(&bar[XB_XGEN(b.x)]) == gen, bar);
            __builtin_amdgcn_fence(__ATOMIC_ACQUIRE, "agent");
            asm volatile("s_waitcnt vmcnt(0)" ::: "memory");
        }
    }
    __syncthreads();
}

constexpr int NWAVES = 8, NTHREADS = 512;
constexpr int RING_BYTES = 131072;
constexpr int MISC_OFF = RING_BYTES + 320;
constexpr int LDS_BYTES = 147456;

struct Params {
    const float* in[23]; float* out; unsigned char* ws; int ph_lo, ph_hi;
};

__device__ __forceinline__ float wave_sum(float v) {
#pragma unroll
    for (int o = 1; o < 64; o <<= 1) v += __shfl_xor(v, o);
    return v;
}

__device__ __forceinline__ int vgroup_src(int kind, int g, int& cnt) {
    cnt = 32;
    if (kind == 0) return g * 32;
    if (kind == 1) { const int pn = g >> 3, tg = g & 7; return (tg >> 2) * FF + pn * 128 + (tg & 3) * 32; }
    const int tile = g >> 3, tg = g & 7;
    if (tile < 12) return g * 32;
    if (tile < 17) { const int bj = tg >> 2, wc = tg & 3; const int base = tile < 16 ? 3088 + (tile - 12) * 256 : 4112; return base + 64 * wc + 32 * bj; }
    if (tile == 17) return 4368 + tg * 32;
    if (tile < 26) return 4624 + (tg >> 2) * 1024 + (tile - 18) * 128 + (tg & 3) * 32;
    if (tg == 0) { cnt = 16; return 3072; }
    cnt = 0; return 0;
}
struct ConvSet { f32x4 v[8]; f32x4 g0, g1; };
struct ConvJob { const float* W; const float* gain; bf16_t* WT; int K, Norig, kind, kb, g; };
constexpr int G_UP = NUP / 32, G_DN = D / 32, G_IN = NIN_V / 32, G_BR = D / 32;
constexpr int I_UP = (D / 64) * G_UP, I_DN = (FF / 64) * G_DN, I_IN = (D / 64) * G_IN, I_BR = (2048 / 64) * G_BR, I_OUT = (D / 64) * G_BR;
template <int LIST> __host__ __device__ constexpr int conv_count() { return LIST == 0 ? I_UP : LIST == 1 ? I_DN + I_IN + I_BR + I_OUT : LIST == 2 ? I_UP : I_DN; }
template <int LIST> __device__ __forceinline__ ConvJob conv_job(int r, const Params& P) {
    unsigned char* outb = (unsigned char*)P.out; ConvJob j;
#define CJ_SET(W_, K_, N_, kind_, gain_, WT_, NG_) do { j.W = (W_); j.K = (K_); j.Norig = (N_); j.kind = (kind_); j.gain = (gain_); j.WT = (bf16_t*)(WT_); j.kb = r / (NG_); j.g = r % (NG_); } while (0)
    if (LIST == 0) CJ_SET(P.in[6], D, NUP, 1, P.in[5], outb + OW_UP1, G_UP);
    else if (LIST == 2) CJ_SET(P.in[20], D, NUP, 1, P.in[19], outb + OW_UP2, G_UP);
    else if (LIST == 3) CJ_SET(P.in[21], FF, D, 0, nullptr, P.ws + WS_WDN2, G_DN);
    else if (r < I_DN) CJ_SET(P.in[7], FF, D, 0, nullptr, outb + OW_DN1, G_DN);
    else if ((r -= I_DN) < I_IN) CJ_SET(P.in[9], D, 6672, 2, P.in[8], outb + OW_IN, G_IN);
    else if ((r -= I_IN) < I_BR) CJ_SET(P.in[17], 2048, D, 0, nullptr, outb + OW_BR, G_BR);
    else { r -= I_BR; CJ_SET(P.in[18], D, D, 0, nullptr, outb + OW_OUT, G_BR); }
#undef CJ_SET
    return j;
}
__device__ __forceinline__ void conv_fetch(const ConvJob& j, int lane, ConvSet& s) {
    const int k0 = 64 * j.kb; int cnt; const int src = vgroup_src(j.kind, j.g, cnt);
    const int ks = lane >> 3, n4 = (lane & 7) * 4, c = lane & 7; const bool okc = n4 < cnt;
    const float* gp = j.gain ? j.gain + k0 + 8 * c : j.W;
    s.g0 = *(const f32x4*)gp; s.g1 = *(const f32x4*)(gp + 4);
    const float* wp = j.W + (size_t)(k0 + ks) * j.Norig + src + (okc ? n4 : 0);
#pragma unroll
    for (int i = 0; i < 8; ++i) s.v[i] = *(const f32x4*)(wp + (size_t)(8 * i) * j.Norig);
}
__device__ __forceinline__ void conv_emit(const ConvJob& j, int lane, const ConvSet& s, LAS float* scr) {
    const int k0 = 64 * j.kb; int cnt; (void)vgroup_src(j.kind, j.g, cnt);
    const int ks = lane >> 3, n4 = (lane & 7) * 4, c = lane & 7; const bool okc = n4 < cnt;
    const f32x4 one = (f32x4){1.f, 1.f, 1.f, 1.f}; const f32x4 g0 = j.gain ? s.g0 : one, g1 = j.gain ? s.g1 : one;
#pragma unroll
    for (int i = 0; i < 8; ++i) { LAS float* sp = scr + (8 * i + ks) * 33 + n4;
#pragma unroll
        for (int e = 0; e < 4; ++e) sp[e] = okc ? s.v[i][e] : 0.f; }
    LDS_WAIT(); asm volatile("" ::: "memory");
#pragma unroll
    for (int q = 0; q < 4; ++q) { const int nn = (lane >> 3) + 8 * q; const LAS float* sr = scr + (8 * c) * 33 + nn;
        u32x4 o; o.x = cvtpk(sr[0 * 33] * g0[0], sr[1 * 33] * g0[1]); o.y = cvtpk(sr[2 * 33] * g0[2], sr[3 * 33] * g0[3]); o.z = cvtpk(sr[4 * 33] * g1[0], sr[5 * 33] * g1[1]); o.w = cvtpk(sr[6 * 33] * g1[2], sr[7 * 33] * g1[3]);
        *(u32x4*)(j.WT + (size_t)(j.g * 32 + nn) * j.K + k0 + 8 * c) = o; }
    LDS_WAIT(); asm volatile("" ::: "memory");
}
#define CONV_LANDED(s_) do { asm volatile("" :: "v"((s_).v[0]), "v"((s_).v[1]), "v"((s_).v[2]), "v"((s_).v[3]), "v"((s_).v[4]), "v"((s_).v[5]), "v"((s_).v[6]), "v"((s_).v[7]), "v"((s_).g0), "v"((s_).g1)); } while (0)
template <int LIST> __device__ __forceinline__ void convert_list(int first, int stride, const Params& P, LAS float* scr, int lane) {
    constexpr int n = conv_count<LIST>();
    if (first >= n) return;
    ConvSet A, B, C;
#define CONV_JOB(it_) conv_job<LIST>((it_) < n ? (it_) : n - 1, P)
    conv_fetch(CONV_JOB(first), lane, A); conv_fetch(CONV_JOB(first + stride), lane, B);
    CONV_LANDED(A); CONV_LANDED(B);
    for (int it = first; it < n; it += 3 * stride) {
        conv_fetch(CONV_JOB(it + 2 * stride), lane, C); conv_emit(CONV_JOB(it), lane, A, scr);
        conv_fetch(CONV_JOB(it + 3 * stride), lane, A); if (it + stride < n) conv_emit(CONV_JOB(it + stride), lane, B, scr);
        conv_fetch(CONV_JOB(it + 4 * stride), lane, B); if (it + 2 * stride < n) conv_emit(CONV_JOB(it + 2 * stride), lane, C, scr);
    }
#undef CONV_JOB
}

namespace swa {
constexpr int KST = 72, VSS = 96;
constexpr int OFF_K = 0, OFF_V = 192 * KST * 2, OFF_TBL = OFF_V + 192 * VSS * 2, LDS_USED = OFF_TBL + 4 * 256 * 4;
typedef short v4i16_t __attribute__((ext_vector_type(4)));
__device__ __forceinline__ s16x4 tr16(const LAS bf16_t* p) { return __builtin_bit_cast(s16x4, __builtin_amdgcn_ds_read_tr16_b64_v4i16((LAS v4i16_t*)p)); }
__device__ __forceinline__ int t5_bucket(int rel) {
    const int n = rel < 0 ? -rel : rel; const int ret = rel > 0 ? 16 : 0;
    if (n < 8) return ret + n;
    int large = 8 + (int)(2.0f * __log2f((float)n * 0.125f) + 1e-4f); if (large > 15) large = 15;
    return ret + large;
}
struct Item { int b, kh, c, kvmin, kvmax; bool samp; };
__device__ __forceinline__ Item decode(int item) {
    Item t; t.samp = item >= 1024;
    if (!t.samp) { t.b = item >> 8; t.kh = (item >> 6) & 3; t.c = item & 63; } else { const int s = item - 1024; t.b = s >> 2; t.kh = s & 3; t.c = 0; }
    t.kvmin = t.samp ? 0 : (t.c >= 2 ? 0 : 128 - 64 * t.c); t.kvmax = t.samp ? 144 : 192; return t;
}
__device__ __forceinline__ void fetch(const Item& t, const bf16_t* SKV, const float* cache_k, const float* cache_v, u32x4 (&kw)[3], u32x4 (&vw)[3]) {
    const int tid = threadIdx.x, ch = tid & 7;
#pragma unroll
    for (int i = 0; i < 3; ++i) {
        const int kv = (tid >> 3) + 64 * i;
        kw[i] = (u32x4){0u, 0u, 0u, 0u}; vw[i] = kw[i];
        if (t.samp && i < 2) {
            const float* pk = cache_k + ((size_t)(t.b * 128 + kv) * 4 + t.kh) * 64 + ch * 8; const float* pv = cache_v + ((size_t)(t.b * 128 + kv) * 4 + t.kh) * 64 + ch * 8;
            const f32x4 k0 = *(const f32x4*)pk, k1 = *(const f32x4*)(pk + 4), v0 = *(const f32x4*)pv, v1 = *(const f32x4*)(pv + 4);
            kw[i] = pg8::pack8(k0, k1); vw[i] = pg8::pack8(v0, v1);
        } else {
            const int kvc = kv < t.kvmin ? t.kvmin : (kv >= t.kvmax ? t.kvmax - 1 : kv);
            const size_t row = t.samp ? (size_t)(MP + t.b * 16 + (kvc - 128)) : (size_t)(t.b * SEQ + 64 * (t.c - 2) + kvc);
            const bf16_t* p = SKV + row * 512 + t.kh * 64 + ch * 8;
            kw[i] = *(const u32x4*)p; vw[i] = *(const u32x4*)(p + 256);
        }
    }
}
__device__ __forceinline__ void phase(LAS unsigned char* lds, int bx, int G, bf16_t* AB, bf16_t* dummy, const bf16_t* SKV, const float* cache_k, const float* cache_v, const float* sinks, const float* rel_bias) {
    const int tid = threadIdx.x, lane = tid & 63, r = lane & 31, h = lane >> 5; const int w = __builtin_amdgcn_readfirstlane(tid >> 6);
    LAS bf16_t* Ks = (LAS bf16_t*)(lds + OFF_K); LAS bf16_t* Vs = (LAS bf16_t*)(lds + OFF_V); LAS float* tbl = (LAS float*)(lds + OFF_TBL);
    constexpr int NITEMS = 1024 + 64;
    const bool bal = (G == 256);
    int cnt;
    if (!bal) cnt = bx < NITEMS ? (NITEMS - bx + G - 1) / G : 0;
    else if (bx < 208) cnt = ((bx & 63) < 16 || (bx >= 160 && bx < 192)) ? 5 : 4;
    else cnt = bx < 240 ? 3 : 4;
    if (cnt == 0) return;
    auto item_of = [&](int k) -> int {
        if (!bal) return bx + k * G;
        if (bx >= 240) return k * 256 + 208 + (bx - 240);
        if (bx >= 208) return k * 256 + 224 + (bx - 208);
        if (k < 4) return k * 256 + bx;
        return (bx & 63) < 16 ? 1024 + 4 * (bx & 63) + (bx >> 6) : 3 * 256 + 224 + (bx - 160);
    };
    int cur_kh = -1;
    u32x4 kw[3], vw[3]; bf16x8 qn[4];
#define SWA_QFETCH(tt) do { size_t qrow_; int g_; if (!(tt).samp) { g_ = w >> 1; qrow_ = (size_t)((tt).b * SEQ + 64 * (tt).c + 32 * (w & 1) + r); } \
        else { const int ir_ = (32 * w + r) & 63; g_ = ir_ >> 4; qrow_ = (size_t)(MP + (tt).b * 16 + (ir_ & 15)); } \
        const bf16_t* Qp_ = AB + qrow_ * 2048 + 1024 + (4 * (tt).kh + g_) * 64; \
        _Pragma("unroll") for (int s_ = 0; s_ < 4; ++s_) qn[s_] = *(const bf16x8*)(Qp_ + 16 * s_ + 8 * h); } while (0)
    { const Item t0 = decode(item_of(0)); fetch(t0, SKV, cache_k, cache_v, kw, vw); SWA_QFETCH(t0); }
    asm volatile("" :: "v"(kw[0]), "v"(kw[1]), "v"(kw[2]), "v"(vw[0]), "v"(vw[1]), "v"(vw[2]));
    asm volatile("" :: "v"(qn[0]), "v"(qn[1]), "v"(qn[2]), "v"(qn[3]));
    for (int k = 0; k < cnt; ++k) {
        const Item t = decode(item_of(k));
        const bool samp = t.samp; const int b = t.b, kh = t.kh, c = t.c, kvmin = t.kvmin, kvmax = t.kvmax;
        {
            LAS bf16_t* kwp = opq(Ks + (tid >> 3) * KST + (tid & 7) * 8); LAS bf16_t* vwp = opq(Vs + (tid >> 3) * VSS + (tid & 7) * 8);
#pragma unroll
            for (int i = 0; i < 3; ++i) { const int kv = (tid >> 3) + 64 * i; const bool ok = kv >= kvmin && kv < kvmax; const u32x4 z4 = (u32x4){0u, 0u, 0u, 0u};
                *(LAS u32x4*)(kwp + 64 * i * KST) = ok ? kw[i] : z4; *(LAS u32x4*)(vwp + 64 * i * VSS) = ok ? vw[i] : z4; }
            if (kh != cur_kh) {
                LAS float* twp = opq(tbl + tid);
#pragma unroll
                for (int i = 0; i < 2; ++i) { const int idx = tid + 512 * i, g = idx >> 8, ii = idx & 255; twp[512 * i] = ii == 255 ? LOG2E * sinks[4 * kh + g] : LOG2E * rel_bias[t5_bucket(ii - 191) * 16 + 4 * kh + g]; }
                cur_kh = kh;
            }
        }
        __syncthreads();
        const bool active = !samp || w < 2;
        int g = 0, tq = 0;
        if (!samp) { g = w >> 1; tq = 32 * (w & 1) + r; }
        else { const int ir = (32 * w + r) & 63; g = ir >> 4; tq = ir & 15; }
        bf16x8 qf[4];
#pragma unroll
        for (int s = 0; s < 4; ++s) qf[s] = qn[s];
        if (k + 1 < cnt) { const Item tn = decode(item_of(k + 1)); fetch(tn, SKV, cache_k, cache_v, kw, vw); SWA_QFETCH(tn); }
        if (active) {
            f32x16 sc[6];
            {
                const LAS bf16_t* krp = opq(Ks + r * KST + 8 * h);
#pragma unroll
                for (int blk = 0; blk < 6; ++blk) {
                    f32x16 a = {0.f, 0.f, 0.f, 0.f, 0.f, 0.f, 0.f, 0.f, 0.f, 0.f, 0.f, 0.f, 0.f, 0.f, 0.f, 0.f};
#pragma unroll
                    for (int s = 0; s < 4; ++s) { const bf16x8 kf = *(const LAS bf16x8*)(krp + (32 * blk) * KST + 16 * s); a = MFMA32(kf, qf[s], a); }
                    sc[blk] = a;
                }
            }
            const float sink = tbl[g * 256 + 255];
            const LAS float* tb = opq(tbl + g * 256 + 63 - tq + 4 * h);
            const unsigned vm = (kvmax >= 192 ? 0xffffffu : ((1u << (kvmax >> 3)) - 1u)) & ~((1u << (kvmin >> 3)) - 1u);
            float mx = sink;
#pragma unroll
            for (int blk = 0; blk < 6; ++blk) {
#pragma unroll
                for (int i = 0; i < 16; ++i) { const float v = sc[blk][i] + tb[32 * blk + (i & 3) + 8 * (i >> 2)]; sc[blk][i] = v; mx = fmaxf(mx, v); }
                __builtin_amdgcn_sched_barrier(0);
            }
            mx = fmaxf(mx, __shfl_xor(mx, 32));
            float l = 0.f;
#pragma unroll
            for (int blk = 0; blk < 6; ++blk)
#pragma unroll
                for (int q4 = 0; q4 < 4; ++q4) {
                    const float vf = (float)((vm >> (4 * blk + q4)) & 1u);
                    float ps = 0.f;
#pragma unroll
                    for (int e = 0; e < 4; ++e) { const float p = __builtin_amdgcn_exp2f(sc[blk][4 * q4 + e] - mx) * vf; sc[blk][4 * q4 + e] = p; ps += p; }
                    l += ps;
                }
            l += __shfl_xor(l, 32);
            l += __builtin_amdgcn_exp2f(sink - mx);
            const float inv = 1.0f / l;
            f32x16 o[2];
#pragma unroll
            for (int d = 0; d < 2; ++d) o[d] = (f32x16){0.f, 0.f, 0.f, 0.f, 0.f, 0.f, 0.f, 0.f, 0.f, 0.f, 0.f, 0.f, 0.f, 0.f, 0.f, 0.f};
            const LAS bf16_t* vrp = opq_after(Vs + (4 * h + ((lane & 15) >> 2)) * VSS + 16 * ((lane >> 4) & 1) + 4 * (lane & 3), inv);
#pragma unroll
            for (int blk = 0; blk < 6; ++blk) {
#pragma unroll
                for (int s2 = 0; s2 < 2; ++s2) {
                    u32x4 pw; pw.x = cvtpk(sc[blk][8 * s2 + 0] * inv, sc[blk][8 * s2 + 1] * inv); pw.y = cvtpk(sc[blk][8 * s2 + 2] * inv, sc[blk][8 * s2 + 3] * inv);
                    pw.z = cvtpk(sc[blk][8 * s2 + 4] * inv, sc[blk][8 * s2 + 5] * inv); pw.w = cvtpk(sc[blk][8 * s2 + 6] * inv, sc[blk][8 * s2 + 7] * inv);
                    const bf16x8 pa = __builtin_bit_cast(bf16x8, pw);
#pragma unroll
                    for (int d = 0; d < 2; ++d) {
                        const LAS bf16_t* vp = vrp + (32 * blk + 16 * s2) * VSS + 32 * d;
                        const s16x4 lo = tr16(vp), hi = tr16(vp + 8 * VSS);
                        const bf16x8 vb = __builtin_shufflevector(lo, hi, 0, 1, 2, 3, 4, 5, 6, 7);
                        o[d] = MFMA32(pa, vb, o[d]);
                    }
                }
                __builtin_amdgcn_sched_barrier(0);
            }
            {
                const size_t orow0 = samp ? (size_t)(MP + b * 16) : (size_t)(b * SEQ + 64 * c + 32 * (w & 1));
                const int og0 = samp ? 2 * w : (w >> 1);
                bf16_t* ub = (dummy ? dummy + (orow0 & 2047) * 2048 : AB + orow0 * 2048) + 1024 + (4 * kh + og0) * 64;
                const unsigned lo = (unsigned)(4 * h * 2048 + r);
#pragma unroll
                for (int i = 0; i < 16; ++i) {
                    const int ro = samp ? ((i & 3) + 8 * ((i >> 2) & 1)) * 2048 + (i >> 3) * 64 : ((i & 3) + 8 * (i >> 2)) * 2048;
                    (ub + ro)[lo] = f2bf(o[0][i]); (ub + ro + 32)[lo] = f2bf(o[1][i]);
                }
            }
        }
        __syncthreads();
    }
#undef SWA_QFETCH
}
}

namespace gla {
constexpr int QST = 136, TST = 72, VST = 288;
constexpr int OFF_QS = 0, OFF_KS = OFF_QS + 64 * QST * 2, OFF_KDT = OFF_KS + 64 * QST * 2, OFF_A = OFF_KDT + 128 * TST * 2, OFF_VS = OFF_A + 64 * TST * 2;
constexpr int OFF_GA = OFF_VS + 64 * VST * 2, OFF_EB = OFF_GA + 16 * 68 * 4, OFF_CS = OFF_EB + 512, OFF_PART = OFF_CS + 2048, LDS_USED = OFF_PART + 2048;
static_assert(LDS_USED <= RING_BYTES && (OFF_VS % 16) == 0, "gla lds");
typedef short v4i16_t __attribute__((ext_vector_type(4)));
__device__ __forceinline__ s16x4 tr16(const LAS bf16_t* p) { return __builtin_bit_cast(s16x4, __builtin_amdgcn_ds_read_tr16_b64_v4i16((LAS v4i16_t*)p)); }
__device__ __forceinline__ float log_sigmoid(float z) { const float az = fabsf(z); return fminf(z, 0.f) - 0.6931471805599453f * __builtin_amdgcn_logf(1.f + __builtin_amdgcn_exp2f(-az * LOG2E)); }

template <bool FULL, bool PARTIAL  >
__device__ __forceinline__ void span(LAS unsigned char* lds, int row0, int nch, int nvalid_, int hd, const bf16_t* QK, const bf16_t* V, bf16_t* AB, const float* GA,
                                     const float* w_alpha, const float* b_alpha, const float* head_norm, const float* S0, float* Sout, float* Dout, bf16_t* dummy = nullptr) {
    const int tid = threadIdx.x, lane = tid & 63, r = lane & 31, h = lane >> 5; const int w = __builtin_amdgcn_readfirstlane(tid >> 6);
    const int kk = tid & 127, tg = tid >> 7;
    const int nvalid = PARTIAL ? nvalid_ : 64;
    LAS bf16_t* QS = (LAS bf16_t*)(lds + OFF_QS); LAS bf16_t* KS = (LAS bf16_t*)(lds + OFF_KS); LAS bf16_t* KdT = (LAS bf16_t*)(lds + OFF_KDT); LAS bf16_t* Ab = (LAS bf16_t*)(lds + OFF_A);
    LAS bf16_t* VS = (LAS bf16_t*)(lds + OFF_VS); LAS float* GAs = (LAS float*)(lds + OFF_GA); LAS float* EB = (LAS float*)(lds + OFF_EB); LAS float* CS = (LAS float*)(lds + OFF_CS);
    LAS float* PART = (LAS float*)(lds + OFF_PART);
    float wal[16];
#pragma unroll
    for (int i = 0; i < 16; ++i) wal[i] = w_alpha[i * 512 + hd * 128 + kk];
    const float bal = b_alpha[hd * 128 + kk];
    f32x16 Sacc[4];
    if (FULL && S0) {
        const float* s0p = S0 + (size_t)(4 * h) * 256 + 32 * w + r;
#pragma unroll
        for (int kb = 0; kb < 4; ++kb)
#pragma unroll
            for (int i = 0; i < 16; ++i) Sacc[kb][i] = s0p[(32 * kb + (i & 3) + 8 * (i >> 2)) * 256];
    } else {
#pragma unroll
        for (int kb = 0; kb < 4; ++kb)
#pragma unroll
            for (int i = 0; i < 16; ++i) Sacc[kb][i] = 0.f;
    }
    float dsum = 0.f;
    f32x4 raw_ga; u32x4 raw_k[2], raw_q[2];
    const int nv1 = nvalid - 1;
    const u32x4 z4 = (u32x4){0u, 0u, 0u, 0u};
#define GLA_FETCH_KG(cc) do { const int crow_ = row0 + 64 * (cc); int t_ = tid; asm volatile("" : "+v"(t_)); \
        const float* gau_ = GA + (size_t)crow_ * 16; const bf16_t* qku_ = QK + (size_t)crow_ * 1024 + hd * 128; \
        raw_ga = *(const f32x4*)(gau_ + (unsigned)(min(t_ >> 2, nv1) * 16 + (t_ & 3) * 4)); if (PARTIAL) { if ((t_ >> 2) >= nvalid) raw_ga = (f32x4){0.f, 0.f, 0.f, 0.f}; } \
        _Pragma("unroll") for (int i_ = 0; i_ < 2; ++i_) { raw_k[i_] = *(const u32x4*)(qku_ + 512 + (unsigned)(min((t_ >> 4) + 32 * i_, nv1) * 1024 + (t_ & 15) * 8)); if (PARTIAL) raw_k[i_] = ((t_ >> 4) + 32 * i_ < nvalid) ? raw_k[i_] : z4; \
            if (FULL) { raw_q[i_] = *(const u32x4*)(qku_ + (unsigned)(min((t_ >> 4) + 32 * i_, nv1) * 1024 + (t_ & 15) * 8)); if (PARTIAL) raw_q[i_] = ((t_ >> 4) + 32 * i_ < nvalid) ? raw_q[i_] : z4; } } } while (0)
#define GLA_FETCH_QV(cc) do { const int crow_ = row0 + 64 * (cc); int t_ = tid; asm volatile("" : "+v"(t_)); \
        const bf16_t* vu_ = V + (size_t)crow_ * 1024 + hd * 256; const bf16_t* qku_ = QK + (size_t)crow_ * 1024 + hd * 128; \
        _Pragma("unroll") for (int i_ = 0; i_ < 4; ++i_) { raw_v[i_] = *(const u32x4*)(vu_ + (unsigned)(min((t_ >> 5) + 16 * i_, nv1) * 1024 + (t_ & 31) * 8)); if (PARTIAL) raw_v[i_] = ((t_ >> 5) + 16 * i_ < nvalid) ? raw_v[i_] : z4; } } while (0)
    GLA_FETCH_KG(0);
    asm volatile("" :: "v"(raw_ga), "v"(raw_k[0]), "v"(raw_k[1]));
    if (FULL) asm volatile("" :: "v"(raw_q[0]), "v"(raw_q[1]));
    for (int c = 0; c < nch; ++c) {
        const int crow0 = row0 + 64 * c;
        if (tid < 256) { LAS float* gp_ = GAs + ((tid & 3) * 4) * 68 + (tid >> 2); gp_[0] = raw_ga[0]; gp_[68] = raw_ga[1]; gp_[136] = raw_ga[2]; gp_[204] = raw_ga[3]; }
        {
            LAS bf16_t* ks_st = opq(KS + (tid >> 4) * QST + (tid & 15) * 8);
#pragma unroll
            for (int i = 0; i < 2; ++i) { *(LAS u32x4*)(ks_st + 32 * i * QST) = raw_k[i]; if (FULL) *(LAS u32x4*)(ks_st - 64 * QST + 32 * i * QST) = raw_q[i]; }
        }
        u32x4 raw_v[4];
        GLA_FETCH_QV(c);
        __syncthreads();
        float bc[16]; float run = 0.f;
        const LAS float* ga_r = opq(GAs + 16 * tg);
        LAS float* cs_p = opq(CS + kk);
#pragma unroll
        for (int j = 0; j < 16; ++j) bc[j] = bal;
#pragma unroll
        for (int r2 = 0; r2 < 16; ++r2)
#pragma unroll
            for (int q4 = 0; q4 < 4; ++q4) { const f32x4 gq = *(const LAS f32x4*)(ga_r + r2 * 68 + q4 * 4);
#pragma unroll
                for (int e = 0; e < 4; ++e) bc[4 * q4 + e] += gq[e] * wal[r2]; }
#pragma unroll
        for (int j = 0; j < 16; ++j) { float la = log_sigmoid(bc[j]) * 0.0625f; if (PARTIAL) la = (16 * tg + j < nvalid) ? la : 0.f; run += la; bc[j] = run; }
        cs_p[tg * 128] = run;
        __syncthreads();
        float offs = 0.f, blast = 0.f;
#pragma unroll
        for (int g2 = 0; g2 < 4; ++g2) { const float cs = cs_p[g2 * 128]; blast += cs; if (g2 < tg) offs += cs; }
        const float eblast = fast_exp(blast);
        if (tg == 0) { EB[kk] = eblast; dsum += blast; }
        {
            LAS bf16_t* qs_e = opq(QS + (16 * tg) * QST + kk); LAS bf16_t* ks_e = qs_e + 64 * QST;
            LAS bf16_t* kdt_w = opq(KdT + kk * TST + 16 * tg);
            unsigned kdw[8];
#pragma unroll
            for (int j = 0; j < 16; j += 2) {
                const float b0 = bc[j] + offs, b1 = bc[j + 1] + offs;
                const float k0 = bf2f(ks_e[j * QST]), k1 = bf2f(ks_e[(j + 1) * QST]);
                const float e0 = fast_exp(b0), e1 = fast_exp(b1), r0 = __builtin_amdgcn_rcpf(e0), r1 = __builtin_amdgcn_rcpf(e1);
                const float kt0 = k0 * r0, kt1 = k1 * r1;
                kdw[j >> 1] = cvtpk(kt0 * eblast, kt1 * eblast);
                if (FULL) {
                    const float q0 = bf2f(qs_e[j * QST]), q1 = bf2f(qs_e[(j + 1) * QST]);
                    qs_e[j * QST] = f2bf(q0 * e0); qs_e[(j + 1) * QST] = f2bf(q1 * e1);
                    ks_e[j * QST] = f2bf(kt0); ks_e[(j + 1) * QST] = f2bf(kt1);
                }
            }
            *(LAS u32x4*)(kdt_w) = (u32x4){kdw[0], kdw[1], kdw[2], kdw[3]};
            *(LAS u32x4*)(kdt_w + 8) = (u32x4){kdw[4], kdw[5], kdw[6], kdw[7]};
        }
        {
            LAS bf16_t* vs_st = opq(VS + (tid >> 5) * VST + (tid & 31) * 8);
#pragma unroll
            for (int i = 0; i < 4; ++i) *(LAS u32x4*)(vs_st + 16 * i * VST) = raw_v[i];
        }
        if (c + 1 < nch) GLA_FETCH_KG(c + 1);
        __syncthreads();
        f32x16 oT[2]; u32x2 grv[2][4]; f32x4 hn[4];
        bf16x8 vfr[4];
        if (FULL) {
            if (w < 3) {
                const int tb = w == 0 ? 0 : 1, sb = w == 2 ? 1 : 0;
                const LAS bf16_t* qa_r = opq(QS + (32 * tb + r) * QST + 8 * h); const LAS bf16_t* kb_r = opq(KS + (32 * sb + r) * QST + 8 * h);
                f32x16 a = {0.f, 0.f, 0.f, 0.f, 0.f, 0.f, 0.f, 0.f, 0.f, 0.f, 0.f, 0.f, 0.f, 0.f, 0.f, 0.f};
#pragma unroll
                for (int s = 0; s < 8; ++s) {
                    const bf16x8 qa = *(const LAS bf16x8*)(qa_r + 16 * s);
                    const bf16x8 kb2 = *(const LAS bf16x8*)(kb_r + 16 * s);
                    a = MFMA32(qa, kb2, a);
                }
                LAS bf16_t* ab_w = opq(Ab + (32 * tb + 4 * h) * TST + 32 * sb + r);
                const int dl = 32 * sb + r - 32 * tb - 4 * h;
#pragma unroll
                for (int i = 0; i < 16; ++i) ab_w[((i & 3) + 8 * (i >> 2)) * TST] = f2bf(dl <= (i & 3) + 8 * (i >> 2) ? a[i] : 0.f);
            }
            const LAS bf16_t* qt_r4 = opq(QS + r * QST + 4 * h);
#pragma unroll
            for (int tb = 0; tb < 2; ++tb) oT[tb] = (f32x16){0.f, 0.f, 0.f, 0.f, 0.f, 0.f, 0.f, 0.f, 0.f, 0.f, 0.f, 0.f, 0.f, 0.f, 0.f, 0.f};
#pragma unroll
            for (int kb = 0; kb < 4; ++kb) {
#pragma unroll
                for (int s2 = 0; s2 < 2; ++s2) {
                    u32x4 sw; sw.x = cvtpk(Sacc[kb][8 * s2 + 0], Sacc[kb][8 * s2 + 1]); sw.y = cvtpk(Sacc[kb][8 * s2 + 2], Sacc[kb][8 * s2 + 3]);
                    sw.z = cvtpk(Sacc[kb][8 * s2 + 4], Sacc[kb][8 * s2 + 5]); sw.w = cvtpk(Sacc[kb][8 * s2 + 6], Sacc[kb][8 * s2 + 7]);
                    const bf16x8 sb = __builtin_bit_cast(bf16x8, sw);
#pragma unroll
                    for (int tb = 0; tb < 2; ++tb) {
                        const LAS bf16_t* qp = qt_r4 + (32 * tb) * QST + 32 * kb + 16 * s2;
                        const s16x4 lo = *(const LAS s16x4*)qp, hi = *(const LAS s16x4*)(qp + 8);
                        const bf16x8 qa = __builtin_shufflevector(lo, hi, 0, 1, 2, 3, 4, 5, 6, 7);
                        oT[tb] = MFMA32(sb, qa, oT[tb]);
                    }
                }
                __builtin_amdgcn_sched_barrier(0);
            }
            __syncthreads();
            {
                const LAS bf16_t* vt_r = opq(VS + (8 * h + ((lane & 15) >> 2)) * VST + 32 * w + 16 * ((lane >> 4) & 1) + 4 * (lane & 3));
#pragma unroll
                for (int s4 = 0; s4 < 4; ++s4) { const s16x4 vlo = tr16(vt_r + (16 * s4) * VST), vhi = tr16(vt_r + (16 * s4 + 4) * VST); vfr[s4] = __builtin_shufflevector(vlo, vhi, 0, 1, 2, 3, 4, 5, 6, 7); }
            }
#pragma unroll
            for (int tb = 0; tb < 2; ++tb)
#pragma unroll
                for (int q4 = 0; q4 < 4; ++q4) grv[tb][q4] = *(const u32x2*)(AB + (size_t)crow0 * 2048 + hd * 256 + 32 * w + 8 * q4 + (unsigned)(min(32 * tb + r, nv1) * 2048 + 4 * h));
#pragma unroll
            for (int q4 = 0; q4 < 4; ++q4) hn[q4] = *(const f32x4*)(head_norm + 32 * w + 4 * h + 8 * q4);
            const LAS bf16_t* ab_r = opq(Ab + r * TST + 8 * h);
#pragma unroll
            for (int tb = 0; tb < 2; ++tb)
#pragma unroll
                for (int sb = 0; sb < 2; ++sb) {
                    if (sb > tb) continue;
#pragma unroll
                    for (int s2 = 0; s2 < 2; ++s2) {
                        const bf16x8 aa = *(const LAS bf16x8*)(ab_r + (32 * tb) * TST + 32 * sb + 16 * s2);
                        oT[tb] = MFMA32(vfr[2 * sb + s2], aa, oT[tb]);
                    }
                }
        }
        const LAS bf16_t* kdt_r = opq(KdT + r * TST + 8 * h);
        if (!FULL) {
            const LAS bf16_t* vt_r2 = opq(VS + (8 * h + ((lane & 15) >> 2)) * VST + 32 * w + 16 * ((lane >> 4) & 1) + 4 * (lane & 3));
#pragma unroll
            for (int s4 = 0; s4 < 4; ++s4) { const s16x4 vlo = tr16(vt_r2 + (16 * s4) * VST), vhi = tr16(vt_r2 + (16 * s4 + 4) * VST); vfr[s4] = __builtin_shufflevector(vlo, vhi, 0, 1, 2, 3, 4, 5, 6, 7); }
        }
        const LAS float* eb_r = opq(EB + 4 * h);
#pragma unroll
        for (int kb = 0; kb < 4; ++kb) {
#pragma unroll
            for (int q4 = 0; q4 < 4; ++q4) { const f32x4 e = *(const LAS f32x4*)(eb_r + 32 * kb + 8 * q4);
#pragma unroll
                for (int e2 = 0; e2 < 4; ++e2) Sacc[kb][4 * q4 + e2] *= e[e2]; }
#pragma unroll
            for (int s = 0; s < 4; ++s) {
                const bf16x8 ka = *(const LAS bf16x8*)(kdt_r + (32 * kb) * TST + 16 * s);
                Sacc[kb] = MFMA32(ka, vfr[s], Sacc[kb]);
            }
            __builtin_amdgcn_sched_barrier(0);
        }
        LAS float* part_p = opq(PART + r);
        if (FULL) {
#pragma unroll
            for (int tb = 0; tb < 2; ++tb) { float p = 0.f;
#pragma unroll
                for (int i = 0; i < 16; ++i) p += oT[tb][i] * oT[tb][i];
                p += __shfl_xor(p, 32);
                if (h == 0) part_p[w * 64 + 32 * tb] = p; }
        }
        __syncthreads();
        if (FULL) {
#pragma unroll
            for (int tb = 0; tb < 2; ++tb) {
                float tot = 0.f;
#pragma unroll
                for (int w2 = 0; w2 < 8; ++w2) tot += part_p[w2 * 64 + 32 * tb];
                const float rs = __builtin_amdgcn_rsqf(tot * (1.0f / 256.0f) + EPS);
                if (32 * tb + r < nvalid) {
                    bf16_t* gp = (dummy ? dummy + (size_t)((crow0 + 32 * tb) & 2047) * 2048 : AB + (size_t)(crow0 + 32 * tb) * 2048) + hd * 256 + 32 * w + (unsigned)(r * 2048 + 4 * h);
#pragma unroll
                    for (int q4 = 0; q4 < 4; ++q4) {
                        const f32x4 g4 = (f32x4){bflo(grv[tb][q4].x), bfhi(grv[tb][q4].x), bflo(grv[tb][q4].y), bfhi(grv[tb][q4].y)};
                        f32x4 y;
#pragma unroll
                        for (int e = 0; e < 4; ++e) y[e] = oT[tb][4 * q4 + e] * rs * hn[q4][e] * siluf_(g4[e]);
                        *(u32x2*)(gp + 8 * q4) = (u32x2){cvtpk(y[0], y[1]), cvtpk(y[2], y[3])};
                    }
                }
            }
        }
    }
#undef GLA_FETCH_KG
#undef GLA_FETCH_QV
    if (Sout) {
#pragma unroll
        for (int kb = 0; kb < 4; ++kb)
#pragma unroll
            for (int i = 0; i < 16; ++i) Sout[(size_t)(32 * kb + crow(i, h)) * 256 + 32 * w + r] = Sacc[kb][i];
    }
    if (!FULL && tg == 0) Dout[kk] = fast_exp(dsum);
    __syncthreads();
}
}


namespace skinny {
typedef float f32x4v __attribute__((ext_vector_type(4)));
template <int NPARTS, int STEPS  , bool FINAL, class Epi>
__device__ __forceinline__ void phase(LAS unsigned char* lds, const bf16_t* A, int lda, const bf16_t* Bt, int ldb, int koff, float* ssq, int G, int bx, const Epi& E,
                                      const float* gain = nullptr, float* out = nullptr, unsigned* cnt = nullptr) {
    const int tid = threadIdx.x, lane = tid & 63, fr = lane & 15, fq = lane >> 4; const int w = __builtin_amdgcn_readfirstlane(tid >> 6);
    LAS f32x4* red = (LAS f32x4*)lds;
    LAS float* sred = (LAS float*)(lds + 8 * NPARTS * 4 * 64 * 16);
    constexpr int UB = STEPS > 4 ? 4 : STEPS;
    for (int pi = bx; pi < 256; pi += G) {
        const int rg = pi >> 4, cg = pi & 15;
        f32x4 acc[NPARTS][4];
#pragma unroll
        for (int p = 0; p < NPARTS; ++p) {
#pragma unroll
            for (int nt = 0; nt < 4; ++nt) acc[p][nt] = (f32x4){0.f, 0.f, 0.f, 0.f};
            const bf16_t* wp = Bt + (size_t)(64 * cg + fr) * ldb + p * koff + w * (STEPS * 32) + 8 * fq;
            const bf16_t* ap = A + (size_t)(MP + 16 * rg + fr) * lda + p * koff + w * (STEPS * 32) + 8 * fq;
            constexpr int NB = (STEPS + UB - 1) / UB;
            bf16x8 af[2][UB], wf[2][UB][4];
#define SK_LOAD(b_, s0_) do { _Pragma("unroll") for (int u = 0; u < UB; ++u) if ((s0_) + u < STEPS) { af[b_][u] = *(const bf16x8*)(ap + ((s0_) + u) * 32); \
                _Pragma("unroll") for (int nt = 0; nt < 4; ++nt) wf[b_][u][nt] = *(const bf16x8*)(wp + (size_t)(16 * nt) * ldb + ((s0_) + u) * 32); } } while (0)
#define SK_MMA(b_, s0_) do { _Pragma("unroll") for (int u = 0; u < UB; ++u) if ((s0_) + u < STEPS) { \
                _Pragma("unroll") for (int nt = 0; nt < 4; ++nt) acc[p][nt] = __builtin_amdgcn_mfma_f32_16x16x32_bf16(wf[b_][u][nt], af[b_][u], acc[p][nt], 0, 0, 0); } } while (0)
            SK_LOAD(0, 0);
#pragma unroll
            for (int b = 0; b < NB; ++b) {
                if (b + 1 < NB) { if ((b & 1) == 0) SK_LOAD(1, (b + 1) * UB); else SK_LOAD(0, (b + 1) * UB); }
                if ((b & 1) == 0) SK_MMA(0, b * UB); else SK_MMA(1, b * UB);
            }
#undef SK_LOAD
#undef SK_MMA
        }
#pragma unroll
        for (int p = 0; p < NPARTS; ++p)
#pragma unroll
            for (int nt = 0; nt < 4; ++nt) red[((w * NPARTS + p) * 4 + nt) * 64 + lane] = acc[p][nt];
        __syncthreads();
        f32x4 o = (f32x4){0.f, 0.f, 0.f, 0.f};
        if (w < 4) {
            f32x4 a2[NPARTS];
#pragma unroll
            for (int p = 0; p < NPARTS; ++p) { a2[p] = (f32x4){0.f, 0.f, 0.f, 0.f};
#pragma unroll
                for (int w2 = 0; w2 < 8; ++w2) a2[p] += red[((w2 * NPARTS + p) * 4 + w) * 64 + lane]; }
            const int row = MP + 16 * rg + fr, c0 = 64 * cg + 16 * w + 4 * fq;
            o = E(row, c0, a2);
            float s = (o[0] * o[0] + o[1] * o[1]) + (o[2] * o[2] + o[3] * o[3]);
            s += __shfl_xor(s, 16); s += __shfl_xor(s, 32);
            if (fq == 0) sred[w * 16 + fr] = s;
        }
        __syncthreads();
        if constexpr (FINAL) {
            float mine = 0.f; if (tid < 16) mine = (sred[tid] + sred[16 + tid]) + (sred[32 + tid] + sred[48 + tid]);
            LAS float* S = sred + 64;
            xchg_rstd(mine, S, 16, ssq + (size_t)(MP + 16 * rg) * 16, cg, 16, cnt + 64 * rg, 16u);
            if (w < 4) { const int row = MP + 16 * rg + fr, c0 = 64 * cg + 16 * w + 4 * fq; const f32x4 g4 = *(const f32x4*)(gain + c0); *(f32x4*)(out + (size_t)row * D + c0) = o * S[fr] * g4; }
        } else {
            if (ssq && tid < 16) ssq[(size_t)(MP + 16 * rg + tid) * 16 + cg] = (sred[tid] + sred[16 + tid]) + (sred[32 + tid] + sred[48 + tid]);
        }
        __syncthreads();
    }
}
__device__ __forceinline__ u32x2 pack4(const f32x4 v) { return (u32x2){cvtpk(v[0], v[1]), cvtpk(v[2], v[3])}; }
__device__ __forceinline__ f32x4 unpack4(const u32x2 w) { return (f32x4){bflo(w.x), bfhi(w.x), bflo(w.y), bfhi(w.y)}; }
template <bool BASE_BF16, bool OUT_F32, bool OUT_BF16> struct EpiResidual {
    const void* base; float* outf; bf16_t* outb; float scale;
    __device__ __forceinline__ f32x4 operator()(int row, int c0, const f32x4 (&acc)[1]) const {
        const size_t off = (size_t)row * D + c0;
        f32x4 b;
        if (BASE_BF16) b = unpack4(*(const u32x2*)((const bf16_t*)base + off)); else b = *(const f32x4*)((const float*)base + (off - (size_t)MP * D));
        const f32x4 v = b + acc[0] * scale;
        if (OUT_F32) *(f32x4*)(outf + off) = v;
        if (OUT_BF16) *(u32x2*)(outb + off) = pack4(v);
        return v;
    }
};
struct EpiMerge {
    bf16_t* G;
    __device__ __forceinline__ f32x4 operator()(int row, int c0, const f32x4 (&acc)[2]) const {
        bf16_t* pt = G + (size_t)row * 2048 + c0;
        const f32x4 rho = unpack4(*(const u32x2*)pt), sgb = unpack4(*(const u32x2*)(pt + 1024));
        const f32x4 m = sgb * (rho * acc[0] + acc[1]);
        *(u32x2*)pt = pack4(m);
        return m;
    }
};
}

__global__ void __launch_bounds__(NTHREADS, 2) fwd_kernel(Params P) {
    extern __shared__ __attribute__((aligned(16))) unsigned char lds_raw[];
    LAS unsigned char* lds = (LAS unsigned char*)lds_raw;
    volatile LAS unsigned* MISC = (volatile LAS unsigned*)(lds + MISC_OFF);
    const int tid = threadIdx.x, lane = tid & 63; const int wave = __builtin_amdgcn_readfirstlane(tid >> 6);
    const int G = gridDim.x, bx = blockIdx.x;
    unsigned char* ws = P.ws; float* out = P.out; unsigned char* outb = (unsigned char*)P.out;
    for (int u = tid; u < (LDS_BYTES - RING_BYTES) / 4; u += NTHREADS) ((LAS unsigned*)(lds + RING_BYTES))[u] = 0u;
    __syncthreads();
    const bool use_bar = (P.ph_hi - P.ph_lo) > 1;
    XcdBarrier bar; bar.bar = (unsigned*)(ws + WS_CTL); bar.x = 0; bar.st = nullptr;
    if (use_bar) bar = xcd_barrier_post((unsigned*)(ws + WS_CTL), MISC + 8);
    const int lo = P.ph_lo, hi = P.ph_hi;
#ifndef PHASE_MASK
#define PHASE_MASK 0xFFF
#endif
#define IN(k) (((PHASE_MASK >> (k)) & 1) && lo <= (k) && (k) < hi)
#define SEAM(k) do { if (IN(k) && IN((k) + 1)) xcd_barrier(bar); } while (0)
    float* ssq0 = (float*)(ws + WS_SSQ); float* ssq1 = (float*)(ws + WS_SSQ + SSQ_STRIDE); float* ssq2 = (float*)(ws + WS_SSQ + 2 * SSQ_STRIDE); float* ssq3 = (float*)(ws + WS_SSQ + 3 * SSQ_STRIDE);
    float* GA = (float*)(ws + WS_GA); float* DV = (float*)(ws + WS_DV);
    bf16_t* XA = (bf16_t*)(ws + WS_XA); bf16_t* QK = (bf16_t*)(ws + WS_QK); bf16_t* Vb = (bf16_t*)(ws + WS_V); bf16_t* Gb = (bf16_t*)(ws + WS_G); bf16_t* AB = (bf16_t*)(ws + WS_AB);
    bf16_t* SKV = (bf16_t*)(ws + WS_SKV); bf16_t* Hb = (bf16_t*)(ws + WS_H); float* X2F = (float*)(ws + WS_AB);
    bf16_t* Wup1 = (bf16_t*)(outb + OW_UP1); bf16_t* Wdn1 = (bf16_t*)(outb + OW_DN1); bf16_t* Win = (bf16_t*)(outb + OW_IN); bf16_t* Wbr = (bf16_t*)(outb + OW_BR);
    bf16_t* Wout = (bf16_t*)(outb + OW_OUT); bf16_t* Wup2 = (bf16_t*)(outb + OW_UP2); bf16_t* Wdn2 = (bf16_t*)(ws + WS_WDN2);
    float* DS = (float*)(outb + O_DS);
    const int gw = bx * NWAVES + wave, NGW = G * NWAVES;

#define CONVERT_LIST(LIST, first_, stride_) convert_list<LIST>((first_), (stride_), P, (LAS float*)(lds + wave * 16384), lane)
#define CONVERT_ON_LIGHT(LIST, nwg_) do { const int rem_ = (nwg_) % G; const int nl_ = rem_ ? G - rem_ : G, lc_ = rem_ ? bx - rem_ : bx; \
        if (lc_ >= 0) CONVERT_LIST(LIST, lc_ * NWAVES + wave, nl_ * NWAVES); } while (0)
    const bool split_conv = (lo == 0 && hi == 12);
    if (IN(0)) {
        CONVERT_LIST(0, gw, NGW);
        if (!split_conv) { CONVERT_LIST(1, gw, NGW); CONVERT_LIST(2, gw, NGW); CONVERT_LIST(3, gw, NGW); }
        {
            f32x4 v[2][4], vn[2][4];
            auto xrow = [&](int m) -> const f32x4* { const float* xr = (m < MP) ? P.in[0] + (size_t)m * D : P.in[1] + (size_t)(m - MP) * D; return (const f32x4*)xr + lane; };
            int m0 = 2 * gw;
            if (m0 < M) {
#pragma unroll
                for (int q = 0; q < 2; ++q) { const f32x4* xv = xrow(m0 + q);
#pragma unroll
                    for (int j = 0; j < 4; ++j) v[q][j] = xv[64 * j]; }
            }
            for (; m0 < M; m0 += 2 * NGW) {
                const int mn = m0 + 2 * NGW; const bool more = mn < M;
                if (more) {
#pragma unroll
                    for (int q = 0; q < 2; ++q) { const f32x4* xv = xrow(mn + q);
#pragma unroll
                        for (int j = 0; j < 4; ++j) vn[q][j] = xv[64 * j]; }
                }
                float sq[2];
#pragma unroll
                for (int q = 0; q < 2; ++q) { float s2 = 0.f;
#pragma unroll
                    for (int j = 0; j < 4; ++j) s2 += (v[q][j][0] * v[q][j][0] + v[q][j][1] * v[q][j][1]) + (v[q][j][2] * v[q][j][2] + v[q][j][3] * v[q][j][3]);
                    sq[q] = wave_sum(s2); }
#pragma unroll
                for (int q = 0; q < 2; ++q) { const int m = m0 + q; u32x2* o8 = (u32x2*)(XA + (size_t)m * D) + lane;
#pragma unroll
                    for (int j = 0; j < 4; ++j) o8[64 * j] = (u32x2){cvtpk(v[q][j][0], v[q][j][1]), cvtpk(v[q][j][2], v[q][j][3])};
                    if (lane == 0) ssq0[(size_t)m * 16] = __builtin_amdgcn_rsqf(sq[q] * (1.0f / D) + EPS); }
                if (more) {
#pragma unroll
                    for (int q = 0; q < 2; ++q)
#pragma unroll
                        for (int j = 0; j < 4; ++j) v[q][j] = vn[q][j];
                }
            }
        }
    }
    SEAM(0);
    LAS float* rtab = (LAS float*)(lds + RING_BYTES + 2048);
#define RSTD_TABLE_FILL(S_, ssq_, DIRECT_) do { \
        const int rr_ = tid & 255, uh_ = tid >> 8; f32x4 tv_[4][4]; bool ok_[4];     \
        _Pragma("unroll") for (int j_ = 0; j_ < 4; ++j_) { pg8::Unit u_; ok_[j_] = (S_).next(2 * j_ + uh_, u_); const float* p_ = (ssq_) + (size_t)((ok_[j_] ? u_.pm : 0) * 256 + rr_) * 16; \
            _Pragma("unroll") for (int q_ = 0; q_ < ((DIRECT_) ? 1 : 4); ++q_) tv_[j_][q_] = *(const f32x4*)(p_ + 4 * q_); } \
        _Pragma("unroll") for (int j_ = 0; j_ < 4; ++j_) { float r_; \
            if (DIRECT_) r_ = tv_[j_][0][0]; \
            else { const f32x4 a_ = tv_[j_][0], b_ = tv_[j_][1], c_ = tv_[j_][2], d_ = tv_[j_][3]; \
                   const float s_ = ((a_[0] + a_[1]) + (a_[2] + a_[3])) + ((b_[0] + b_[1]) + (b_[2] + b_[3])) + ((c_[0] + c_[1]) + (c_[2] + c_[3])) + ((d_[0] + d_[1]) + (d_[2] + d_[3])); \
                   r_ = __builtin_amdgcn_rsqf(s_ * (1.0f / D) + EPS); } \
            if (ok_[j_]) rtab[(2 * j_ + uh_) * 256 + rr_] = r_; } \
        __syncthreads(); } while (0)
    if (IN(1)) {
        pg8::Gemm g{XA, Wup1, D, D, D, 0}; pg8::Sched S; S.init(M, NUP, G, bx, 0);
        RSTD_TABLE_FILL(S, ssq0, true);
        pg8::EpiSwiglu E{Hb, rtab};
        pg8::gemm_phase(lds, g, S, E);
        if (split_conv) CONVERT_ON_LIGHT(1, (M / 256) * (NUP / 256));
    }
    SEAM(1);
    const bool stagger = (G == 256);
    const bool sk_early = stagger && ((bx >> 3) & 1) == 0;
    const int sk_piece = stagger ? (((bx >> 3) & 15) * 16 + 2 * (bx & 7) + (bx >> 7)) : bx;
    if (IN(2)) {
        pg8::Gemm g{Hb, Wdn1, FF, FF, FF, 0}; pg8::Sched S; S.init(MP, D, G, bx, 0);
        pg8::EpiResidual<true, false, true> E{XA, nullptr, nullptr, XA, ssq1, 0.5f};
        skinny::EpiResidual<true, false, true> Es{XA, nullptr, XA, 0.5f};
        if (sk_early) skinny::phase<1, FF / 256, false>(lds, Hb, FF, Wdn1, FF, 0, ssq1, G, sk_piece, Es);
        pg8::gemm_phase(lds, g, S, E);
        if (!sk_early) skinny::phase<1, FF / 256, false>(lds, Hb, FF, Wdn1, FF, 0, ssq1, G, sk_piece, Es);
    }
    SEAM(2);
    if (IN(3)) {
        pg8::Gemm g{XA, Win, D, D, D, 0}; pg8::Sched S; S.init(M, NIN_V, G, bx, 0);
        RSTD_TABLE_FILL(S, ssq1, false);
        pg8::EpiIn E{QK, Vb, Gb, AB, SKV, GA, rtab, P.in[13], P.in[14], out};
        pg8::gemm_phase(lds, g, S, E);
        if (split_conv) CONVERT_ON_LIGHT(2, (M / 256) * (NIN_V / 256));
    }
    SEAM(3);
    if (IN(4)) {
#ifndef P4_SKIP_GLA
#ifndef P4_SKIP_GLA_A
#if defined(PROBE_GLAA)
        for (int it = bx; it < 240; it += G) { const int bh = it / 15, sc = it % 15, b = bh >> 2, hd = bh & 3;
            gla::span<false, false>(lds, b * SEQ + sc * 256, 4, 64, hd, QK, Vb, AB, GA, P.in[10], P.in[11], P.in[12], nullptr, DS + (size_t)it * 32768, DV + (size_t)it * 128); }
#endif
        for (int it = bx; it < 240; it += G) { const int bh = it / 15, sc = it % 15, b = bh >> 2, hd = bh & 3;
            gla::span<false, false>(lds, b * SEQ + sc * 256, 4, 64, hd, QK, Vb, AB, GA, P.in[10], P.in[11], P.in[12], nullptr, DS + (size_t)it * 32768, DV + (size_t)it * 128); }
#endif
#ifndef P4_SKIP_GLA_S
        const int ss0 = G == 256 ? (bx >= 240 ? 2 * (bx - 240) : bx >= 208 ? 32 + (bx - 208) : 64) : G - 1 - bx;
        const int ssn = G == 256 ? (bx >= 240 ? ss0 + 2 : ss0 + 1) : 64, sst = G == 256 ? 1 : G;
        for (int s = ss0; s < ssn && s < 64; s += sst) { const int db = s >> 2, hd = s & 3;
            gla::span<true, true>(lds, MP + db * 16, 1, 16, hd, QK, Vb, AB, GA, P.in[10], P.in[11], P.in[12], P.in[4] + (size_t)s * 32768, out + OUT_GS + (size_t)s * 32768, nullptr); }
#endif
#endif
#ifndef P4_SKIP_SWA
#if defined(PROBE_SWA)
        swa::phase(lds, bx, G, AB, (bf16_t*)(outb + 53 * MiB), SKV, P.in[2], P.in[3], P.in[15], P.in[16]);
#endif
        swa::phase(lds, bx, G, AB, nullptr, SKV, P.in[2], P.in[3], P.in[15], P.in[16]);
#endif
    }
    SEAM(4);
    if (IN(5)) {
        for (int gid = bx * NTHREADS + tid; gid < 16 * 8192; gid += G * NTHREADS) {
            const int bh = gid >> 13, e = gid & 8191, k = e >> 6;
            f32x4 ds[15]; float dd[15];
#pragma unroll
            for (int j = 0; j < 15; ++j) { ds[j] = *((const f32x4*)(DS + (size_t)(bh * 15 + j) * 32768) + e); dd[j] = DV[(size_t)(bh * 15 + j) * 128 + k]; }
            f32x4 Sv = (f32x4){0.f, 0.f, 0.f, 0.f};
#pragma unroll
            for (int j = 0; j < 15; ++j) { Sv = Sv * dd[j] + ds[j]; *((f32x4*)(DS + (size_t)(bh * 15 + j) * 32768) + e) = Sv; }
        }
    }
    SEAM(5);
    if (IN(6)) {
#if defined(PROBE_GLAC)
        for (int it = bx; it < 256; it += G) { const int bh = it >> 4, sc = it & 15, b = bh >> 2, hd = bh & 3;
            gla::span<true, false>(lds, b * SEQ + sc * 256, 4, 64, hd, QK, Vb, AB, GA, P.in[10], P.in[11], P.in[12], sc ? DS + (size_t)(bh * 15 + sc - 1) * 32768 : nullptr, nullptr, nullptr, (bf16_t*)(outb + 53 * MiB)); }
#endif
        for (int it = bx; it < 256; it += G) { const int bh = it >> 4, sc = it & 15, b = bh >> 2, hd = bh & 3;
            gla::span<true, false>(lds, b * SEQ + sc * 256, 4, 64, hd, QK, Vb, AB, GA, P.in[10], P.in[11], P.in[12], sc ? DS + (size_t)(bh * 15 + sc - 1) * 32768 : nullptr,
                            sc == 15 ? out + OUT_GP + (size_t)bh * 32768 : nullptr, nullptr); }
    }
    SEAM(6);
    if (IN(7)) {
        pg8::Gemm g{AB, Wbr, 2048, 2048, D, 1024}; pg8::Sched S; S.init(MP, D, G, bx, 1);
        pg8::EpiMerge E{Gb, Gb, 0x7fffffff};
        skinny::EpiMerge Es{Gb};
        if (sk_early) skinny::phase<2, D / 256, false>(lds, AB, 2048, Wbr, 2048, 1024, nullptr, G, sk_piece, Es);
        pg8::gemm_phase(lds, g, S, E);
        if (!sk_early) skinny::phase<2, D / 256, false>(lds, AB, 2048, Wbr, 2048, 1024, nullptr, G, sk_piece, Es);
    }
    SEAM(7);
    if (IN(8)) {
        pg8::Gemm g{Gb, Wout, 2048, D, D, 0}; pg8::Sched S; S.init(MP, D, G, bx, 0);
        pg8::EpiResidual<true, false, true> E{XA, nullptr, nullptr, QK, ssq2, 1.0f};
        skinny::EpiResidual<true, false, true> Es{XA, nullptr, QK, 1.0f};
        if (sk_early) skinny::phase<1, D / 256, false>(lds, Gb, 2048, Wout, D, 0, ssq2, G, sk_piece, Es);
        pg8::gemm_phase(lds, g, S, E);
        if (!sk_early) skinny::phase<1, D / 256, false>(lds, Gb, 2048, Wout, D, 0, ssq2, G, sk_piece, Es);
    }
    SEAM(8);
    if (IN(9)) {
        pg8::Gemm g{QK, Wup2, D, D, D, 0}; pg8::Sched S; S.init(M, NUP, G, bx, 0);
        RSTD_TABLE_FILL(S, ssq2, false);
        pg8::EpiSwiglu E{Hb, rtab};
        pg8::gemm_phase(lds, g, S, E);
        if (split_conv) CONVERT_ON_LIGHT(3, (M / 256) * (NUP / 256));
    }
    SEAM(9);
    const bool fuse_final = (G == 256) && IN(10) && IN(11);
    if (IN(10)) {
        pg8::Gemm g{Hb, Wdn2, FF, FF, FF, 0}; pg8::Sched S; S.init(MP, D, G, bx, 0);
        unsigned* xcnt = (unsigned*)(ws + WS_CTL) + 4096;
        if (fuse_final) {
            pg8::EpiFinal E{QK, out + OUT_Y, P.in[22], ssq3, xcnt, 0.5f};
            skinny::EpiResidual<true, false, false> Es{QK, nullptr, nullptr, 0.5f};
            if (sk_early) skinny::phase<1, FF / 256, true>(lds, Hb, FF, Wdn2, FF, 0, ssq3, G, sk_piece, Es, P.in[22], out + OUT_Y, xcnt + 64 * 64);
            pg8::gemm_phase(lds, g, S, E);
            if (!sk_early) skinny::phase<1, FF / 256, true>(lds, Hb, FF, Wdn2, FF, 0, ssq3, G, sk_piece, Es, P.in[22], out + OUT_Y, xcnt + 64 * 64);
        } else {
            pg8::EpiResidual<true, true, false> E{QK, nullptr, X2F, nullptr, ssq3, 0.5f};
            pg8::gemm_phase(lds, g, S, E);
            skinny::EpiResidual<true, true, false> Es{QK, X2F, nullptr, 0.5f};
            skinny::phase<1, FF / 256, false>(lds, Hb, FF, Wdn2, FF, 0, ssq3, G, bx, Es);
        }
    }
    if (!fuse_final) SEAM(10);
    if (IN(11) && !fuse_final) {
        const float* fn = P.in[22];
        for (int m = gw; m < M; m += NGW) {
            const float rs = row_rstd(ssq3, m);
            const f32x4* xv = (const f32x4*)(X2F + (size_t)m * D) + lane; f32x4* yv = (f32x4*)(out + OUT_Y + (size_t)m * D) + lane;
#pragma unroll
            for (int j = 0; j < 4; ++j) { const f32x4 g4 = *((const f32x4*)fn + lane + 64 * j); yv[64 * j] = xv[64 * j] * rs * g4; }
        }
    }
#undef IN
#undef SEAM
}

#ifndef N_LAUNCHES
#define N_LAUNCHES 1
#endif
extern "C" void kernel_launch(void* const* d_in, const int* in_sizes, int n_in, void* d_out, int out_size, void* d_ws, size_t ws_size, hipStream_t stream) {
    static int grid = 0;
    if (grid == 0) {
        if (n_in != 23 || ws_size < WS_END) { fprintf(stderr, "kernel_launch: unexpected inputs (n_in %d, ws %zu)\n", n_in, ws_size); grid = -1; return; }
        int dev = 0, cus = 0;
        if (hipGetDevice(&dev) != hipSuccess || hipDeviceGetAttribute(&cus, hipDeviceAttributeMultiprocessorCount, dev) != hipSuccess) { grid = -1; return; }
        if (hipFuncSetAttribute((const void*)fwd_kernel, hipFuncAttributeMaxDynamicSharedMemorySize, LDS_BYTES) != hipSuccess) { fprintf(stderr, "kernel_launch: hipFuncSetAttribute failed\n"); grid = -1; return; }
        (void)hipGetLastError();
        grid = cus;
    }
    if (grid < 0) return;
    (void)hipMemsetAsync((char*)d_ws + WS_CTL, 0, CTL_ZERO_BYTES, stream);
    Params p{};
    for (int i = 0; i < 23; ++i) p.in[i] = (const float*)d_in[i];
    p.out = (float*)d_out; p.ws = (unsigned char*)d_ws;
    if (N_LAUNCHES == 1) { p.ph_lo = 0; p.ph_hi = 12; hipLaunchKernelGGL(fwd_kernel, dim3(grid), dim3(NTHREADS), LDS_BYTES, stream, p); }
    else for (int k = 0; k < 12; ++k) { p.ph_lo = k; p.ph_hi = k + 1; hipLaunchKernelGGL(fwd_kernel, dim3(grid), dim3(NTHREADS), LDS_BYTES, stream, p); }
}
```

```cpp
#include <hip/hip_runtime.h>
#include <cstdio>
#include <cstdint>

#define LAS __attribute__((address_space(3)))
typedef unsigned short bf16_t;
typedef short bf16x8 __attribute__((ext_vector_type(8)));
typedef short s16x4 __attribute__((ext_vector_type(4)));
typedef float f32x4 __attribute__((ext_vector_type(4)));
typedef float f32x16 __attribute__((ext_vector_type(16)));
typedef unsigned u32x4 __attribute__((ext_vector_type(4)));
typedef unsigned u32x2 __attribute__((ext_vector_type(2)));
typedef float f32x2_t __attribute__((ext_vector_type(2)));
typedef __bf16 bf16x2_t __attribute__((ext_vector_type(2)));

constexpr int D = 1024, SEQ = 4096, NBATCH = 4, MP = NBATCH * SEQ, DBATCH = 16, DSEQ = 16, MS = DBATCH * DSEQ, M = MP + MS;
constexpr int FF = 2816, NUP = 2 * FF, NIN_V = 27 * 256;
constexpr int NCACHE = 128;
constexpr float EPS = 1e-6f;
constexpr float LOG2E = 1.4426950408889634f;

constexpr size_t MiB = 1u << 20;
constexpr size_t WS_CTL = 0, CTL_ZERO_BYTES = 64 * 1024;
constexpr size_t SSQ_BYTES = (size_t)M * 16 * 4;
constexpr size_t WS_SSQ = 65536, SSQ_STRIDE = SSQ_BYTES;
constexpr size_t WS_GA = WS_SSQ + 4 * SSQ_STRIDE;
constexpr size_t WS_DV = WS_GA + SSQ_BYTES;
constexpr size_t WS_XA = 5 * MiB + 512 * 1024;
constexpr size_t WS_QK = WS_XA + (size_t)M * 1024 * 2;
constexpr size_t WS_V = WS_QK + (size_t)M * 1024 * 2;
constexpr size_t WS_G = WS_V + (size_t)M * 1024 * 2;
constexpr size_t WS_AB = WS_G + (size_t)M * 2048 * 2;
constexpr size_t WS_SKV = WS_AB + (size_t)M * 2048 * 2;
constexpr size_t WS_WDN2 = WS_SKV + (size_t)M * 512 * 2;
constexpr size_t WS_END = WS_WDN2 + (size_t)1024 * FF * 2;
constexpr size_t WS_H = WS_V;
static_assert(WS_DV + 240 * 128 * 4 <= WS_XA && WS_XA + (size_t)M * 1024 * 2 <= WS_QK && WS_END <= 256 * MiB && (WS_GA % 16) == 0 && (WS_DV % 16) == 0 && (WS_WDN2 % 256) == 0, "ws map");
static_assert(WS_H + (size_t)M * FF * 2 <= WS_AB, "hidden overlay");
constexpr size_t OUT_Y = 0, OUT_KP = (size_t)M * D, OUT_VP = OUT_KP + 131072, OUT_GP = OUT_VP + 131072, OUT_KS = OUT_GP + 524288, OUT_VS = OUT_KS + 65536, OUT_GS = OUT_VS + 65536;
constexpr size_t OW_UP1 = 0, OW_DN1 = 11 * MiB, OW_IN = OW_DN1 + 5 * MiB + 512 * 1024, OW_BR = 30 * MiB, OW_OUT = 34 * MiB, OW_UP2 = 36 * MiB, OW_DN2 = 47 * MiB;
constexpr size_t O_DS = 0;
static_assert(OW_IN + (size_t)NIN_V * 1024 * 2 <= OW_BR && OW_DN2 + (size_t)1024 * FF * 2 <= (size_t)M * D * 4 && 240ull * 32768 * 4 <= OW_BR, "out map");

__device__ __forceinline__ unsigned cvtpk(float lo, float hi) { f32x2_t v = {lo, hi}; bf16x2_t b = __builtin_convertvector(v, bf16x2_t); return __builtin_bit_cast(unsigned, b); }
__device__ __forceinline__ float bf2f(unsigned short x) { return __uint_as_float((unsigned)x << 16); }
__device__ __forceinline__ float bflo(unsigned w) { return __uint_as_float(w << 16); }
__device__ __forceinline__ float bfhi(unsigned w) { return __uint_as_float(w & 0xffff0000u); }
__device__ __forceinline__ unsigned short f2bf(float f) { return (unsigned short)(cvtpk(f, 0.f) & 0xffffu); }
__device__ __forceinline__ float fast_exp(float x) { return __builtin_amdgcn_exp2f(x * LOG2E); }
__device__ __forceinline__ float sigmoidf_(float x) { return __builtin_amdgcn_rcpf(1.f + fast_exp(-x)); }
__device__ __forceinline__ float siluf_(float x) { return x * sigmoidf_(x); }
__device__ __forceinline__ int crow(int r, int hi) { return (r & 3) + 8 * (r >> 2) + 4 * hi; }
#if defined(__HIP_DEVICE_COMPILE__)
template <class T> __device__ __forceinline__ LAS T* opq(LAS T* p) { unsigned a = __builtin_bit_cast(unsigned, p); asm volatile("" : "+v"(a)); return __builtin_bit_cast(LAS T*, a); }
template <class T> __device__ __forceinline__ LAS T* opq_after(LAS T* p, float dep) { unsigned a = __builtin_bit_cast(unsigned, p); asm volatile("" : "+v"(a) : "v"(dep)); return __builtin_bit_cast(LAS T*, a); }
#else
template <class T> __device__ __forceinline__ LAS T* opq(LAS T* p) { return p; }
template <class T> __device__ __forceinline__ LAS T* opq_after(LAS T* p, float) { return p; }
#endif
#define LDS_WAIT() asm volatile("s_waitcnt lgkmcnt(0)" ::: "memory")
#define VM_WAIT() asm volatile("s_waitcnt vmcnt(0)" ::: "memory")
#define MFMA32(a, b, c) __builtin_amdgcn_mfma_f32_32x32x16_bf16((a), (b), (c), 0, 0, 0)

__device__ __forceinline__ float row_rstd(const float* ssq, int row) {
    const f32x4* p = (const f32x4*)(ssq + (size_t)row * 16);
    const f32x4 a = p[0], b = p[1], c = p[2], d = p[3];
    const float s = ((a[0] + a[1]) + (a[2] + a[3])) + ((b[0] + b[1]) + (b[2] + b[3])) + ((c[0] + c[1]) + (c[2] + c[3])) + ((d[0] + d[1]) + (d[2] + d[3]));
    return __builtin_amdgcn_rsqf(s * (1.0f / D) + EPS);
}


#define XC_SPIN_CAP (1u << 22)
__device__ __forceinline__ void xchg_rstd(float mine, LAS float* S, int nrows, float* slots, int myslot, int nslots, unsigned* cnt, unsigned need) {
    const int tid = threadIdx.x;
    if (tid < nrows) __hip_atomic_store((unsigned*)(slots + (size_t)tid * 16 + myslot), __float_as_uint(mine), __ATOMIC_RELAXED, __HIP_MEMORY_SCOPE_AGENT);
    asm volatile("s_waitcnt vmcnt(0)" ::: "memory");
    __syncthreads();
    if (tid < 64) {
        if (tid == 0) (void)__hip_atomic_fetch_add(cnt, 1u, __ATOMIC_RELAXED, __HIP_MEMORY_SCOPE_AGENT);
        unsigned sp = 0;
        while ((unsigned)__builtin_amdgcn_readfirstlane(__hip_atomic_load(cnt, __ATOMIC_RELAXED, __HIP_MEMORY_SCOPE_AGENT)) < need) { __builtin_amdgcn_s_sleep(2); if (++sp > XC_SPIN_CAP) break; }
        __builtin_amdgcn_fence(__ATOMIC_ACQUIRE, "agent");
        asm volatile("s_waitcnt vmcnt(0)" ::: "memory");
    }
    __syncthreads();
    if (tid < nrows) {
        float t = 0.f;
        for (int j = 0; j < nslots; ++j) t += __uint_as_float(__hip_atomic_load((unsigned*)(slots + (size_t)tid * 16 + j), __ATOMIC_RELAXED, __HIP_MEMORY_SCOPE_AGENT));
        S[tid] = __builtin_amdgcn_rsqf(t * (1.0f / D) + EPS);
    }
    __syncthreads();
}

namespace pg8 {
constexpr int BM = 256, BK = 64, HALF = 128, HTB = HALF * BK * 2, STAGE_BYTES = 8 * HTB, NXCD = 8, WGM = 4;
__host__ __device__ __forceinline__ int lds_byte(int r, int c) { const int st = (r >> 4) * 2 + (c >> 5), rr = r & 15, cc = c & 31, ob = rr * 64 + cc * 2; return st * 1024 + (ob ^ (((ob >> 9) & 1) << 5)); }
__host__ __device__ __forceinline__ void stage_rc(int b, int& R, int& C) { const int st = b / 1024, sb = b % 1024, swz = sb ^ (((sb >> 9) & 1) << 5); R = (st >> 1) * 16 + swz / 64; C = (st & 1) * 32 + (swz % 64) / 2; }
__host__ __device__ __forceinline__ int perm32(int rho) { const int n = rho >> 4, i = rho & 15; return 8 * (i >> 2) + 4 * n + (i & 3); }

struct Unit { int pm, pn, part, idx; };
struct Gemm { const bf16_t* A; const bf16_t* Bt; int lda, ldb, K; int koff; };

struct Sched {
    int nM, nN, nwg, G, c, psh;
    __device__ __forceinline__ void init(int M_, int N_, int G_, int c_, int psh_) { nM = M_ / BM; nN = N_ / BM; nwg = nM * nN; G = G_; c = c_; psh = psh_; }
    __device__ __forceinline__ bool next(int i, Unit& u) const {
        const long L = (long)(i >> psh) * G + c; if (L >= nwg) return false;
        int wgid = (int)L; { const int q = nwg / NXCD, r = nwg % NXCD, xcd = wgid % NXCD, off = wgid / NXCD; wgid = (xcd < r ? xcd * (q + 1) : r * (q + 1) + (xcd - r) * q) + off; }
        const int nig = WGM * nN, gid = wgid / nig, fm = gid * WGM, gsz = (nM - fm) < WGM ? (nM - fm) : WGM;
        u.pm = fm + ((wgid % nig) % gsz); u.pn = (wgid % nig) / gsz; u.part = i & ((1 << psh) - 1); u.idx = i; return true;
    }
};

typedef f32x4 Acc[2][2][4][2];

template <class Epi>
__device__ __forceinline__ void gemm_phase(LAS unsigned char* lds, const Gemm g, const Sched& S, const Epi& E) {
    const int tid = threadIdx.x, wid = __builtin_amdgcn_readfirstlane(tid >> 6), lane = tid & 63, wr = wid >> 2, wc = wid & 3, fr = lane & 15, fq = lane >> 4;
    const int K = g.K, nt = K / BK;
    unsigned voffA[2], voffB[2];
#pragma unroll
    for (int i = 0; i < 2; ++i) { int R, C; stage_rc(tid * 16 + i * 8192, R, C); const int Rb = (R & ~31) + perm32(R & 31);
        voffA[i] = (unsigned)(R * g.lda + C) * 2u; voffB[i] = (unsigned)(Rb * g.ldb + C) * 2u; }
    const size_t kstep = (size_t)(BK * 2);
    const size_t hstepA = (size_t)HALF * g.lda * 2, hstepB = (size_t)HALF * g.ldb * 2;
    const size_t tstepA = 2 * hstepA, tstepB = 2 * hstepB;
    const unsigned ldsw = (unsigned)wid * 1024u;
    const int aoff = lds_byte(wr * 64 + fr, fq * 8), boff = lds_byte(wc * 32 + fr, fq * 8);
#define PG8_SA(b, h) (((b) * 2 + (h)) * HTB)
#define PG8_SB(b, h) ((4 + (b) * 2 + (h)) * HTB)
#define PG8_STAGE(bufoff, gbase, voff) do { _Pragma("unroll") for (int _i = 0; _i < 2; ++_i) \
        __builtin_amdgcn_global_load_lds((const unsigned*)((const char*)(gbase) + (voff)[_i]), (LAS unsigned*)(lds + (bufoff) + ldsw + _i * 8192), 16, 0, 0); } while (0)
#define PG8_LDA(dst, b, h) do { _Pragma("unroll") for (int m = 0; m < 4; ++m) _Pragma("unroll") for (int k = 0; k < 2; ++k) dst[m][k] = *(const LAS bf16x8*)(lds + PG8_SA(b, h) + aoff + m * 2048 + k * 1024); } while (0)
#define PG8_LDB(dst, b, h) do { _Pragma("unroll") for (int n = 0; n < 2; ++n) _Pragma("unroll") for (int k = 0; k < 2; ++k) dst[n][k] = *(const LAS bf16x8*)(lds + PG8_SB(b, h) + boff + n * 2048 + k * 1024); } while (0)
#define PG8_MMA(ai, bj, At, Bt) do { __builtin_amdgcn_s_setprio(1); _Pragma("unroll") for (int m = 0; m < 4; ++m) _Pragma("unroll") for (int n = 0; n < 2; ++n) _Pragma("unroll") for (int k = 0; k < 2; ++k) \
        acc[ai][bj][m][n] = __builtin_amdgcn_mfma_f32_16x16x32_bf16(Bt[n][k], At[m][k], acc[ai][bj][m][n], 0, 0, 0); __builtin_amdgcn_s_setprio(0); } while (0)
#define PG8_WAIT_V(n) asm volatile("s_waitcnt vmcnt(" #n ")" ::: "memory")
#define PG8_WAIT_L(n) asm volatile("s_waitcnt lgkmcnt(" #n ")" ::: "memory")
#define PG8_BAR __builtin_amdgcn_s_barrier()
#define PG8_SCHED __builtin_amdgcn_sched_barrier(0)
    Unit cur, nxt; int ui = 0;
    if (!S.next(0, cur)) return;
    Acc acc;
#pragma unroll
    for (int a = 0; a < 2; ++a)
#pragma unroll
        for (int b = 0; b < 2; ++b)
#pragma unroll
            for (int m = 0; m < 4; ++m)
#pragma unroll
                for (int n = 0; n < 2; ++n) acc[a][b][m][n] = (f32x4){0.f, 0.f, 0.f, 0.f};
    bf16x8 At[4][2], B0[2][2], B1[2][2];
    const char* cA = (const char*)g.A + (size_t)cur.pm * tstepA + (size_t)cur.part * g.koff * 2; const char* cB = (const char*)g.Bt + (size_t)cur.pn * tstepB + (size_t)cur.part * g.koff * 2;
    PG8_STAGE(PG8_SB(0, 0), cB, voffB); PG8_STAGE(PG8_SB(0, 1), cB + hstepB, voffB); PG8_STAGE(PG8_SA(0, 0), cA, voffA); PG8_STAGE(PG8_SA(0, 1), cA + hstepA, voffA);
    if (wr == 1) PG8_BAR;
    PG8_WAIT_V(2); PG8_BAR;
    PG8_STAGE(PG8_SB(1, 0), cB + kstep, voffB); PG8_STAGE(PG8_SA(1, 0), cA + kstep, voffA); PG8_STAGE(PG8_SB(1, 1), cB + hstepB + kstep, voffB);
    PG8_WAIT_V(6); PG8_BAR;
    for (;;) {
        const bool has_next = S.next(ui + 1, nxt);
        const char* nA = has_next ? (const char*)g.A + (size_t)nxt.pm * tstepA + (size_t)nxt.part * g.koff * 2 : cA; const char* nB = has_next ? (const char*)g.Bt + (size_t)nxt.pn * tstepB + (size_t)nxt.part * g.koff * 2 : cB;
        for (int t = 0; t < nt; t += 2) {
            const bool last = (t == nt - 2);
            const char* a1 = cA + (size_t)(t + 1) * kstep;
            const char* a2 = last ? nA : cA + (size_t)(t + 2) * kstep; const char* b2 = last ? nB : cB + (size_t)(t + 2) * kstep;
            const char* a3 = a2 + kstep; const char* b3 = b2 + kstep;
            PG8_LDB(B0, 0, 0); PG8_LDB(B1, 0, 1); PG8_SCHED; PG8_LDA(At, 0, 0); PG8_STAGE(PG8_SA(1, 1), a1 + hstepA, voffA);
            PG8_WAIT_V(8); PG8_WAIT_L(0); PG8_BAR; PG8_MMA(0, 0, At, B0); PG8_MMA(0, 1, At, B1); PG8_BAR; PG8_SCHED;
            PG8_LDA(At, 0, 1); PG8_STAGE(PG8_SB(0, 0), b2, voffB); PG8_STAGE(PG8_SB(0, 1), b2 + hstepB, voffB); PG8_STAGE(PG8_SA(0, 0), a2, voffA);
            PG8_WAIT_V(8); PG8_WAIT_L(0); PG8_BAR; PG8_MMA(1, 0, At, B0); PG8_MMA(1, 1, At, B1); PG8_BAR; PG8_SCHED;
            PG8_LDB(B0, 1, 0); PG8_LDB(B1, 1, 1); PG8_SCHED; PG8_LDA(At, 1, 0); PG8_STAGE(PG8_SA(0, 1), a2 + hstepA, voffA);
            PG8_WAIT_V(8); PG8_WAIT_L(0); PG8_BAR; PG8_MMA(0, 0, At, B0); PG8_MMA(0, 1, At, B1); PG8_BAR; PG8_SCHED;
            PG8_LDA(At, 1, 1); PG8_STAGE(PG8_SB(1, 0), b3, voffB); PG8_STAGE(PG8_SB(1, 1), b3 + hstepB, voffB); PG8_STAGE(PG8_SA(1, 0), a3, voffA);
            PG8_WAIT_V(8); PG8_WAIT_L(0); PG8_BAR; PG8_MMA(1, 0, At, B0); PG8_MMA(1, 1, At, B1); PG8_BAR; PG8_SCHED;
        }
        if (wr == 0) PG8_BAR;
        if constexpr (!Epi::AFTER_DRAIN) E(acc, cur, wr, wc, fr, fq);
        if (!has_next) break;
        if (!(Epi::KEEP_PART0 && cur.part == 0))
#pragma unroll
        for (int a = 0; a < 2; ++a)
#pragma unroll
            for (int b = 0; b < 2; ++b)
#pragma unroll
                for (int m = 0; m < 4; ++m)
#pragma unroll
                    for (int n = 0; n < 2; ++n) acc[a][b][m][n] = (f32x4){0.f, 0.f, 0.f, 0.f};
        cur = nxt; cA = nA; cB = nB; ++ui;
        if (wr == 1) PG8_BAR;
    }
    PG8_WAIT_V(0);
    PG8_BAR;
    if constexpr (Epi::AFTER_DRAIN) E.fused(acc, cur, wr, wc, fr, fq, lds);
#undef PG8_SA
#undef PG8_SB
#undef PG8_STAGE
#undef PG8_LDA
#undef PG8_LDB
#undef PG8_MMA
#undef PG8_WAIT_V
#undef PG8_WAIT_L
#undef PG8_BAR
#undef PG8_SCHED
}

__device__ __forceinline__ u32x4 pack8(const f32x4 a, const f32x4 b) { u32x4 w; w.x = cvtpk(a[0], a[1]); w.y = cvtpk(a[2], a[3]); w.z = cvtpk(b[0], b[1]); w.w = cvtpk(b[2], b[3]); return w; }
__device__ __forceinline__ void unpack8(const u32x4 w, f32x4& a, f32x4& b) { a = (f32x4){bflo(w.x), bfhi(w.x), bflo(w.y), bfhi(w.y)}; b = (f32x4){bflo(w.z), bfhi(w.z), bflo(w.w), bfhi(w.w)}; }

struct EpiSwiglu {
    static constexpr bool AFTER_DRAIN = false, KEEP_PART0 = false;
    bf16_t* H; const LAS float* rtab;
    __device__ __forceinline__ void operator()(const Acc& acc, const Unit& u, int wr, int wc, int fr, int fq) const {
        const int col0 = u.pn * 128 + wc * 32 + 8 * fq;
        const LAS float* rt = rtab + u.idx * 256 + wr * 64 + fr;
#pragma unroll
        for (int ai = 0; ai < 2; ++ai)
#pragma unroll
            for (int m = 0; m < 4; ++m) {
                const int row = u.pm * BM + ai * HALF + wr * 64 + m * 16 + fr; const float r = rt[ai * HALF + m * 16];
                f32x4 h0, h1;
#pragma unroll
                for (int e = 0; e < 4; ++e) { h0[e] = siluf_(acc[ai][0][m][0][e] * r) * (acc[ai][1][m][0][e] * r); h1[e] = siluf_(acc[ai][0][m][1][e] * r) * (acc[ai][1][m][1][e] * r); }
                *(u32x4*)(H + (size_t)row * FF + col0) = pack8(h0, h1);
            }
    }
};
template <bool BASE_BF16, bool OUT_F32, bool OUT_BF16> struct EpiResidual {
    static constexpr bool AFTER_DRAIN = false, KEEP_PART0 = false;
    static_assert(BASE_BF16, "the residual stream is bf16");
    const void* base; const void* base_s; float* outf; bf16_t* outb; float* ssq; float scale;
    __device__ __forceinline__ void operator()(const Acc& acc, const Unit& u, int wr, int wc, int fr, int fq) const {
        const size_t off0 = (size_t)(u.pm * BM + wr * 64 + fr) * D + u.pn * BM + wc * 32 + 8 * fq;
        u32x4 bw[2][4][2];
#pragma unroll
        for (int ai = 0; ai < 2; ++ai)
#pragma unroll
            for (int m = 0; m < 4; ++m)
#pragma unroll
                for (int bj = 0; bj < 2; ++bj) bw[ai][m][bj] = *(const u32x4*)((const bf16_t*)base + off0 + (size_t)(ai * HALF + m * 16) * D + bj * HALF);
#pragma unroll
        for (int ai = 0; ai < 2; ++ai)
#pragma unroll
            for (int m = 0; m < 4; ++m) {
                const int row = u.pm * BM + ai * HALF + wr * 64 + m * 16 + fr; float s = 0.f;
#pragma unroll
                for (int bj = 0; bj < 2; ++bj) {
                    const size_t off = off0 + (size_t)(ai * HALF + m * 16) * D + bj * HALF;
                    f32x4 b0, b1; unpack8(bw[ai][m][bj], b0, b1);
                    const f32x4 v0 = b0 + acc[ai][bj][m][0] * scale, v1 = b1 + acc[ai][bj][m][1] * scale;
                    s += (v0[0] * v0[0] + v0[1] * v0[1]) + (v0[2] * v0[2] + v0[3] * v0[3]) + (v1[0] * v1[0] + v1[1] * v1[1]) + (v1[2] * v1[2] + v1[3] * v1[3]);
                    if (OUT_F32) { *(f32x4*)(outf + off) = v0; *(f32x4*)(outf + off + 4) = v1; }
                    if (OUT_BF16) *(u32x4*)(outb + off) = pack8(v0, v1);
                }
                s += __shfl_xor(s, 16); s += __shfl_xor(s, 32);
                if (fq == 0) ssq[(size_t)row * 16 + u.pn * 4 + wc] = s;
            }
    }
};
struct EpiIn {
    static constexpr bool AFTER_DRAIN = false, KEEP_PART0 = false;
    bf16_t *QK, *V, *G, *AB, *SKV; float* GA; const LAS float* rtab; const float *qn, *kn; float* out;
#define EPI_IN_ROWS(...) _Pragma("unroll") for (int ai = 0; ai < 2; ++ai) _Pragma("unroll") for (int m = 0; m < 4; ++m) { \
            const int row = u.pm * BM + ai * HALF + wr * 64 + m * 16 + fr; const float r = rt[ai * HALF + m * 16]; f32x4 v[2][2]; \
            _Pragma("unroll") for (int bj = 0; bj < 2; ++bj) _Pragma("unroll") for (int n = 0; n < 2; ++n) v[bj][n] = acc[ai][bj][m][n] * r; \
            __VA_ARGS__ }
    __device__ __forceinline__ void operator()(const Acc& acc, const Unit& u, int wr, int wc, int fr, int fq) const {
        const int pn = u.pn, cpos = wc * 32 + 8 * fq;
        const LAS float* rt = rtab + u.idx * 256 + wr * 64 + fr;
        if (pn >= 18 && pn < 26) {
            EPI_IN_ROWS({
                bf16_t* dst = G + (size_t)row * 2048 + (pn - 18) * 128 + cpos;
                f32x4 r0, r1, s0, s1;
                _Pragma("unroll") for (int e = 0; e < 4; ++e) {
                    const float pa0 = 1.f + fast_exp(fminf(-v[0][0][e], 40.f)), pa1 = 1.f + fast_exp(fminf(-v[0][1][e], 40.f)), pb0 = 1.f + fast_exp(fminf(-v[1][0][e], 40.f)), pb1 = 1.f + fast_exp(fminf(-v[1][1][e], 40.f));
                    const float q0 = __builtin_amdgcn_rcpf(pa0 * pb0), q1 = __builtin_amdgcn_rcpf(pa1 * pb1);
                    s0[e] = pa0 * q0; s1[e] = pa1 * q1;
                    r0[e] = pb0 * (pb0 * q0); r1[e] = pb1 * (pb1 * q1);
                }
                *(u32x4*)dst = pack8(r0, r1); *(u32x4*)(dst + 1024) = pack8(s0, s1);
            })
        } else if (pn < 12 || pn == 17) {
            bf16_t* dst0; size_t ld; float sc = 1.f;
            if (pn < 4) { dst0 = QK + pn * 256; ld = 1024; if (pn < 2) sc = 0.08838834764831845f; }
            else if (pn < 8) { dst0 = V + (pn - 4) * 256; ld = 1024; }
            else if (pn < 12) { dst0 = AB + (pn - 8) * 256; ld = 2048; }
            else { dst0 = SKV + 256; ld = 512; }
            EPI_IN_ROWS({
                bf16_t* dst = dst0 + (size_t)row * ld;
                _Pragma("unroll") for (int bj = 0; bj < 2; ++bj) *(u32x4*)(dst + bj * HALF + cpos) = pack8(v[bj][0] * sc, v[bj][1] * sc);
                if (pn == 17) {
                    float* o = nullptr;
                    if (u.pm == 64) o = out + OUT_VS + (size_t)(row - MP) * 256;
                    else if ((u.pm & 15) == 15 && ai == 1) o = out + OUT_VP + (size_t)((row >> 12) * 128 + ((row & 4095) - 3968)) * 256;
                    if (o) {
                        _Pragma("unroll") for (int bj = 0; bj < 2; ++bj) { *(f32x4*)(o + bj * HALF + cpos) = v[bj][0]; *(f32x4*)(o + bj * HALF + cpos + 4) = v[bj][1]; }
                    }
                }
            })
        } else if (pn < 17) {
            f32x4 gq[2][2];
            { const float* gn = pn < 16 ? qn : kn;
              _Pragma("unroll") for (int bj = 0; bj < 2; ++bj) { gq[bj][0] = *(const f32x4*)(gn + bj * 32 + 8 * fq); gq[bj][1] = *(const f32x4*)(gn + bj * 32 + 8 * fq + 4); } }
            const bool isq = pn < 16;
            EPI_IN_ROWS({
                float s = 0.f;
                _Pragma("unroll") for (int bj = 0; bj < 2; ++bj)
                    _Pragma("unroll") for (int n = 0; n < 2; ++n) s += (v[bj][n][0] * v[bj][n][0] + v[bj][n][1] * v[bj][n][1]) + (v[bj][n][2] * v[bj][n][2] + v[bj][n][3] * v[bj][n][3]);
                s += __shfl_xor(s, 16); s += __shfl_xor(s, 32);
                const float hr = __builtin_amdgcn_rsqf(s * (1.0f / 64.0f) + EPS);
                const float sc = isq ? (0.125f * LOG2E) * hr : hr;
                bf16_t* dst = isq ? AB + (size_t)row * 2048 + 1024 + ((pn - 12) * 4 + wc) * 64 : SKV + (size_t)row * 512 + wc * 64;
                float* o = nullptr;
                if (!isq) { if (u.pm == 64) o = out + OUT_KS + (size_t)(row - MP) * 256 + wc * 64;
                            else if ((u.pm & 15) == 15 && ai == 1) o = out + OUT_KP + (size_t)((row >> 12) * 128 + ((row & 4095) - 3968)) * 256 + wc * 64; }
                _Pragma("unroll") for (int bj = 0; bj < 2; ++bj) {
                    const int ch = bj * 32 + 8 * fq;
                    const f32x4 w0 = v[bj][0] * sc * gq[bj][0], w1 = v[bj][1] * sc * gq[bj][1];
                    *(u32x4*)(dst + ch) = pack8(w0, w1);
                    if (o) { *(f32x4*)(o + ch) = w0; *(f32x4*)(o + ch + 4) = w1; }
                }
            })
        } else {
            EPI_IN_ROWS({
                if (wc == 0 && fq < 2) { *(f32x4*)(GA + (size_t)row * 16 + 8 * fq) = v[0][0]; *(f32x4*)(GA + (size_t)row * 16 + 8 * fq + 4) = v[0][1]; }
            })
        }
    }
#undef EPI_IN_ROWS
};
struct EpiMerge {
    static constexpr bool AFTER_DRAIN = false, KEEP_PART0 = true;
    bf16_t* G; bf16_t* Go; int omask;
    __device__ __forceinline__ void operator()(Acc& acc, const Unit& u, int wr, int wc, int fr, int fq) const {
        const size_t off0 = (size_t)(u.pm * BM + wr * 64 + fr) * 2048 + u.pn * BM + wc * 32 + 8 * fq + (u.part ? 1024 : 0);
        u32x4 gw[2][4][2];
#pragma unroll
        for (int ai = 0; ai < 2; ++ai)
#pragma unroll
            for (int m = 0; m < 4; ++m)
#pragma unroll
                for (int bj = 0; bj < 2; ++bj) gw[ai][m][bj] = *(const u32x4*)(G + off0 + (size_t)(ai * HALF + m * 16) * 2048 + bj * HALF);
#pragma unroll
        for (int ai = 0; ai < 2; ++ai)
#pragma unroll
            for (int m = 0; m < 4; ++m) {
                const int row = u.pm * BM + ai * HALF + wr * 64 + m * 16 + fr;
#pragma unroll
                for (int bj = 0; bj < 2; ++bj) {
                    f32x4 a0, a1; unpack8(gw[ai][m][bj], a0, a1);
                    if (u.part == 0) { acc[ai][bj][m][0] *= a0; acc[ai][bj][m][1] *= a1; }
                    else {
                        bf16_t* po = Go + (size_t)(row & omask) * 2048 + u.pn * BM + bj * HALF + wc * 32 + 8 * fq;
                        *(u32x4*)po = pack8(a0 * acc[ai][bj][m][0], a1 * acc[ai][bj][m][1]);
                    }
                }
            }
    }
};
struct EpiFinal {
    static constexpr bool AFTER_DRAIN = true, KEEP_PART0 = false;
    const bf16_t* base; float* out; const float* gain; float* slots; unsigned* cnt; float scale;
    __device__ __forceinline__ void fused(Acc& acc, const Unit& u, int wr, int wc, int fr, int fq, LAS unsigned char* lds) const {
        LAS float* Pw = (LAS float*)lds; LAS float* S = (LAS float*)(lds + 4096);
#pragma unroll
        for (int ai = 0; ai < 2; ++ai)
#pragma unroll
            for (int m = 0; m < 4; ++m) {
                const int rt = ai * HALF + wr * 64 + m * 16 + fr; const int row = u.pm * BM + rt; float s = 0.f;
#pragma unroll
                for (int bj = 0; bj < 2; ++bj) {
                    const size_t off = (size_t)row * D + u.pn * BM + bj * HALF + wc * 32 + 8 * fq;
                    f32x4 b0, b1; unpack8(*(const u32x4*)(base + off), b0, b1);
                    const f32x4 v0 = b0 + acc[ai][bj][m][0] * scale, v1 = b1 + acc[ai][bj][m][1] * scale;
                    acc[ai][bj][m][0] = v0; acc[ai][bj][m][1] = v1;
                    s += (v0[0] * v0[0] + v0[1] * v0[1]) + (v0[2] * v0[2] + v0[3] * v0[3]) + (v1[0] * v1[0] + v1[1] * v1[1]) + (v1[2] * v1[2] + v1[3] * v1[3]);
                }
                s += __shfl_xor(s, 16); s += __shfl_xor(s, 32);
                if (fq == 0) Pw[rt * 4 + wc] = s;
            }
        __syncthreads();
        float mine = 0.f;
        if (threadIdx.x < 256) { const f32x4 p = *(const LAS f32x4*)(Pw + threadIdx.x * 4); mine = (p[0] + p[1]) + (p[2] + p[3]); }
        xchg_rstd(mine, S, 256, slots + (size_t)u.pm * BM * 16, u.pn, 4, cnt + 64 * u.pm, 4u);
        f32x4 gg[2][2];
#pragma unroll
        for (int bj = 0; bj < 2; ++bj) { const int col = u.pn * BM + bj * HALF + wc * 32 + 8 * fq; gg[bj][0] = *(const f32x4*)(gain + col); gg[bj][1] = *(const f32x4*)(gain + col + 4); }
#pragma unroll
        for (int ai = 0; ai < 2; ++ai)
#pragma unroll
            for (int m = 0; m < 4; ++m) {
                const int rt = ai * HALF + wr * 64 + m * 16 + fr; const int row = u.pm * BM + rt; const float rs = S[rt];
#pragma unroll
                for (int bj = 0; bj < 2; ++bj) {
                    const int col = u.pn * BM + bj * HALF + wc * 32 + 8 * fq; const size_t off = (size_t)row * D + col;
                    *(f32x4*)(out + off) = acc[ai][bj][m][0] * rs * gg[bj][0]; *(f32x4*)(out + off + 4) = acc[ai][bj][m][1] * rs * gg[bj][1];
                }
            }
    }
};
}

#define XB_TMO      128
#define XB_XCNT(j)  (256  + 64 * (j))
#define XB_XSUB(j)  (1280 + 64 * (j))
#define XB_XGEN(j)  (2304 + 64 * (j))
#define XB_TOP      3328
#define XB_TOPGEN   3392
#define XCD_BAR_WORDS 3456
#define XB_SPIN_CAP (1u << 20)
__device__ __forceinline__ unsigned xb_ld(unsigned* p)              { return __hip_atomic_load(p, __ATOMIC_RELAXED, __HIP_MEMORY_SCOPE_AGENT); }
__device__ __forceinline__ unsigned xb_add(unsigned* p, unsigned v) { return __hip_atomic_fetch_add(p, v, __ATOMIC_RELAXED, __HIP_MEMORY_SCOPE_AGENT); }
__device__ __forceinline__ unsigned xb_xcc_id() { return (unsigned)__builtin_amdgcn_s_getreg((3 << 11) | 20) & 0xFu; }
#define XB_SPIN(cond, bar) do { unsigned _sp = 0; while (cond) { __builtin_amdgcn_s_sleep(1); \
    if ((++_sp & 255u) == 0u) { if (xb_ld(&(bar)[XB_TMO])) break; if (_sp > XB_SPIN_CAP) { atomicAdd(&(bar)[XB_TMO], 1u); break; } } } } while (0)
struct XcdBarrier { unsigned* bar; unsigned x; volatile LAS unsigned* st; };
__device__ __forceinline__ XcdBarrier xcd_barrier_post(unsigned* bar, volatile LAS unsigned* st) {
    XcdBarrier b; b.bar = bar; b.x = xb_xcc_id(); b.st = st;
    if (threadIdx.x == 0) (void)xb_add(&bar[XB_XCNT(b.x)], 1u);
    return b;
}
__device__ __forceinline__ void xcd_barrier_complete(unsigned* bar, unsigned x, unsigned& nloc, unsigned& nx) {
    const unsigned G = gridDim.x * gridDim.y * gridDim.z;
    unsigned sum, cnt, mine, sp = 0u;
    for (;;) {
        sum = 0u; cnt = 0u; mine = 0u;
#pragma unroll
        for (unsigned j = 0; j < 16; ++j) { const unsigned c = xb_ld(&bar[XB_XCNT(j)]); sum += c; cnt += (c > 0u) ? 1u : 0u; mine = (j == x) ? c : mine; }
        if (sum == G) break;
        __builtin_amdgcn_s_sleep(1);
        if ((++sp & 255u) == 0u) { if (xb_ld(&bar[XB_TMO])) break; if (sp > XB_SPIN_CAP) { atomicAdd(&bar[XB_TMO], 1u); break; } }
    }
    nloc = mine > 0u ? mine : 1u; nx = cnt > 0u ? cnt : 1u;
}
__device__ __forceinline__ void xcd_barrier(const XcdBarrier& b) {
    asm volatile("s_waitcnt vmcnt(0)" ::: "memory");
    __syncthreads();
    if (threadIdx.x == 0) {
        unsigned* bar = b.bar;
        __builtin_amdgcn_s_waitcnt(0);
        unsigned nloc = b.st[0], nx = b.st[1];
        if (nloc == 0u) { xcd_barrier_complete(bar, b.x, nloc, nx); b.st[0] = nloc; b.st[1] = nx; }
        const unsigned old = xb_add(&bar[XB_XSUB(b.x)], 1u);
        const unsigned gen = old / nloc;
        if (old + 1u == (gen + 1u) * nloc) {
            __builtin_amdgcn_fence(__ATOMIC_RELEASE, "agent");
            asm volatile("s_waitcnt vmcnt(0)" ::: "memory");
            const unsigned og = xb_add(&bar[XB_TOP], 1u);
            const unsigned tg = og / nx;
            if (og + 1u == (tg + 1u) * nx) xb_add(&bar[XB_TOPGEN], 1u);
            else XB_SPIN(xb_ld(&bar[XB_TOPGEN]) == tg, bar);
            __builtin_amdgcn_fence(__ATOMIC_ACQUIRE, "agent");
            xb_add(&bar[XB_XGEN(b.x)], 1u);
            asm volatile("s_waitcnt vmcnt(0)" ::: "memory");
        } else {
            XB_SPIN(xb_ld(&bar[XB_XGEN(b.x)]) == gen, bar);
            __builtin_amdgcn_fence(__ATOMIC_ACQUIRE, "agent");
            asm volatile("s_waitcnt vmcnt(0)" ::: "memory");
        }
    }
    __syncthreads();
}

constexpr int NWAVES = 8, NTHREADS = 512;
constexpr int RING_BYTES = 131072;
constexpr int MISC_OFF = RING_BYTES + 320;
constexpr int LDS_BYTES = 147456;

struct Params {
    const float* in[23]; float* out; unsigned char* ws; int ph_lo, ph_hi;
};

__device__ __forceinline__ float wave_sum(float v) {
#pragma unroll
    for (int o = 1; o < 64; o <<= 1) v += __shfl_xor(v, o);
    return v;
}

__device__ __forceinline__ int vgroup_src(int kind, int g, int& cnt) {
    cnt = 32;
    if (kind == 0) return g * 32;
    if (kind == 1) { const int pn = g >> 3, tg = g & 7; return (tg >> 2) * FF + pn * 128 + (tg & 3) * 32; }
    const int tile = g >> 3, tg = g & 7;
    if (tile < 12) return g * 32;
    if (tile < 17) { const int bj = tg >> 2, wc = tg & 3; const int base = tile < 16 ? 3088 + (tile - 12) * 256 : 4112; return base + 64 * wc + 32 * bj; }
    if (tile == 17) return 4368 + tg * 32;
    if (tile < 26) return 4624 + (tg >> 2) * 1024 + (tile - 18) * 128 + (tg & 3) * 32;
    if (tg == 0) { cnt = 16; return 3072; }
    cnt = 0; return 0;
}
struct ConvSet { f32x4 v[8]; f32x4 g0, g1; };
struct ConvJob { const float* W; const float* gain; bf16_t* WT; int K, Norig, kind, kb, g; };
constexpr int G_UP = NUP / 32, G_DN = D / 32, G_IN = NIN_V / 32, G_BR = D / 32;
constexpr int I_UP = (D / 64) * G_UP, I_DN = (FF / 64) * G_DN, I_IN = (D / 64) * G_IN, I_BR = (2048 / 64) * G_BR, I_OUT = (D / 64) * G_BR;
template <int LIST> __host__ __device__ constexpr int conv_count() { return LIST == 0 ? I_UP : LIST == 1 ? I_DN + I_IN + I_BR + I_OUT : LIST == 2 ? I_UP : I_DN; }
template <int LIST> __device__ __forceinline__ ConvJob conv_job(int r, const Params& P) {
    unsigned char* outb = (unsigned char*)P.out; ConvJob j;
#define CJ_SET(W_, K_, N_, kind_, gain_, WT_, NG_) do { j.W = (W_); j.K = (K_); j.Norig = (N_); j.kind = (kind_); j.gain = (gain_); j.WT = (bf16_t*)(WT_); j.kb = r / (NG_); j.g = r % (NG_); } while (0)
    if (LIST == 0) CJ_SET(P.in[6], D, NUP, 1, P.in[5], outb + OW_UP1, G_UP);
    else if (LIST == 2) CJ_SET(P.in[20], D, NUP, 1, P.in[19], outb + OW_UP2, G_UP);
    else if (LIST == 3) CJ_SET(P.in[21], FF, D, 0, nullptr, P.ws + WS_WDN2, G_DN);
    else if (r < I_DN) CJ_SET(P.in[7], FF, D, 0, nullptr, outb + OW_DN1, G_DN);
    else if ((r -= I_DN) < I_IN) CJ_SET(P.in[9], D, 6672, 2, P.in[8], outb + OW_IN, G_IN);
    else if ((r -= I_IN) < I_BR) CJ_SET(P.in[17], 2048, D, 0, nullptr, outb + OW_BR, G_BR);
    else { r -= I_BR; CJ_SET(P.in[18], D, D, 0, nullptr, outb + OW_OUT, G_BR); }
#undef CJ_SET
    return j;
}
__device__ __forceinline__ void conv_fetch(const ConvJob& j, int lane, ConvSet& s) {
    const int k0 = 64 * j.kb; int cnt; const int src = vgroup_src(j.kind, j.g, cnt);
    const int ks = lane >> 3, n4 = (lane & 7) * 4, c = lane & 7; const bool okc = n4 < cnt;
    const float* gp = j.gain ? j.gain + k0 + 8 * c : j.W;
    s.g0 = *(const f32x4*)gp; s.g1 = *(const f32x4*)(gp + 4);
    const float* wp = j.W + (size_t)(k0 + ks) * j.Norig + src + (okc ? n4 : 0);
#pragma unroll
    for (int i = 0; i < 8; ++i) s.v[i] = *(const f32x4*)(wp + (size_t)(8 * i) * j.Norig);
}
__device__ __forceinline__ void conv_emit(const ConvJob& j, int lane, const ConvSet& s, LAS float* scr) {
    const int k0 = 64 * j.kb; int cnt; (void)vgroup_src(j.kind, j.g, cnt);
    const int ks = lane >> 3, n4 = (lane & 7) * 4, c = lane & 7; const bool okc = n4 < cnt;
    const f32x4 one = (f32x4){1.f, 1.f, 1.f, 1.f}; const f32x4 g0 = j.gain ? s.g0 : one, g1 = j.gain ? s.g1 : one;
#pragma unroll
    for (int i = 0; i < 8; ++i) { LAS float* sp = scr + (8 * i + ks) * 33 + n4;
#pragma unroll
        for (int e = 0; e < 4; ++e) sp[e] = okc ? s.v[i][e] : 0.f; }
    LDS_WAIT(); asm volatile("" ::: "memory");
#pragma unroll
    for (int q = 0; q < 4; ++q) { const int nn = (lane >> 3) + 8 * q; const LAS float* sr = scr + (8 * c) * 33 + nn;
        u32x4 o; o.x = cvtpk(sr[0 * 33] * g0[0], sr[1 * 33] * g0[1]); o.y = cvtpk(sr[2 * 33] * g0[2], sr[3 * 33] * g0[3]); o.z = cvtpk(sr[4 * 33] * g1[0], sr[5 * 33] * g1[1]); o.w = cvtpk(sr[6 * 33] * g1[2], sr[7 * 33] * g1[3]);
        *(u32x4*)(j.WT + (size_t)(j.g * 32 + nn) * j.K + k0 + 8 * c) = o; }
    LDS_WAIT(); asm volatile("" ::: "memory");
}
#define CONV_LANDED(s_) do { asm volatile("" :: "v"((s_).v[0]), "v"((s_).v[1]), "v"((s_).v[2]), "v"((s_).v[3]), "v"((s_).v[4]), "v"((s_).v[5]), "v"((s_).v[6]), "v"((s_).v[7]), "v"((s_).g0), "v"((s_).g1)); } while (0)
template <int LIST> __device__ __forceinline__ void convert_list(int first, int stride, const Params& P, LAS float* scr, int lane) {
    constexpr int n = conv_count<LIST>();
    if (first >= n) return;
    ConvSet A, B, C;
#define CONV_JOB(it_) conv_job<LIST>((it_) < n ? (it_) : n - 1, P)
    conv_fetch(CONV_JOB(first), lane, A); conv_fetch(CONV_JOB(first + stride), lane, B);
    CONV_LANDED(A); CONV_LANDED(B);
    for (int it = first; it < n; it += 3 * stride) {
        conv_fetch(CONV_JOB(it + 2 * stride), lane, C); conv_emit(CONV_JOB(it), lane, A, scr);
        conv_fetch(CONV_JOB(it + 3 * stride), lane, A); if (it + stride < n) conv_emit(CONV_JOB(it + stride), lane, B, scr);
        conv_fetch(CONV_JOB(it + 4 * stride), lane, B); if (it + 2 * stride < n) conv_emit(CONV_JOB(it + 2 * stride), lane, C, scr);
    }
#undef CONV_JOB
}

namespace swa {
constexpr int KST = 72, VSS = 96;
constexpr int OFF_K = 0, OFF_V = 192 * KST * 2, OFF_TBL = OFF_V + 192 * VSS * 2, LDS_USED = OFF_TBL + 4 * 256 * 4;
typedef short v4i16_t __attribute__((ext_vector_type(4)));
__device__ __forceinline__ s16x4 tr16(const LAS bf16_t* p) { return __builtin_bit_cast(s16x4, __builtin_amdgcn_ds_read_tr16_b64_v4i16((LAS v4i16_t*)p)); }
__device__ __forceinline__ int t5_bucket(int rel) {
    const int n = rel < 0 ? -rel : rel; const int ret = rel > 0 ? 16 : 0;
    if (n < 8) return ret + n;
    int large = 8 + (int)(2.0f * __log2f((float)n * 0.125f) + 1e-4f); if (large > 15) large = 15;
    return ret + large;
}
struct Item { int b, kh, c, kvmin, kvmax; bool samp; };
__device__ __forceinline__ Item decode(int item) {
    Item t; t.samp = item >= 1024;
    if (!t.samp) { t.b = item >> 8; t.kh = (item >> 6) & 3; t.c = item & 63; } else { const int s = item - 1024; t.b = s >> 2; t.kh = s & 3; t.c = 0; }
    t.kvmin = t.samp ? 0 : (t.c >= 2 ? 0 : 128 - 64 * t.c); t.kvmax = t.samp ? 144 : 192; return t;
}
__device__ __forceinline__ void fetch(const Item& t, const bf16_t* SKV, const float* cache_k, const float* cache_v, u32x4 (&kw)[3], u32x4 (&vw)[3]) {
    const int tid = threadIdx.x, ch = tid & 7;
#pragma unroll
    for (int i = 0; i < 3; ++i) {
        const int kv = (tid >> 3) + 64 * i;
        kw[i] = (u32x4){0u, 0u, 0u, 0u}; vw[i] = kw[i];
        if (t.samp && i < 2) {
            const float* pk = cache_k + ((size_t)(t.b * 128 + kv) * 4 + t.kh) * 64 + ch * 8; const float* pv = cache_v + ((size_t)(t.b * 128 + kv) * 4 + t.kh) * 64 + ch * 8;
            const f32x4 k0 = *(const f32x4*)pk, k1 = *(const f32x4*)(pk + 4), v0 = *(const f32x4*)pv, v1 = *(const f32x4*)(pv + 4);
            kw[i] = pg8::pack8(k0, k1); vw[i] = pg8::pack8(v0, v1);
        } else {
            const int kvc = kv < t.kvmin ? t.kvmin : (kv >= t.kvmax ? t.kvmax - 1 : kv);
            const size_t row = t.samp ? (size_t)(MP + t.b * 16 + (kvc - 128)) : (size_t)(t.b * SEQ + 64 * (t.c - 2) + kvc);
            const bf16_t* p = SKV + row * 512 + t.kh * 64 + ch * 8;
            kw[i] = *(const u32x4*)p; vw[i] = *(const u32x4*)(p + 256);
        }
    }
}
__device__ __forceinline__ void phase(LAS unsigned char* lds, int bx, int G, bf16_t* AB, bf16_t* dummy, const bf16_t* SKV, const float* cache_k, const float* cache_v, const float* sinks, const float* rel_bias) {
    const int tid = threadIdx.x, lane = tid & 63, r = lane & 31, h = lane >> 5; const int w = __builtin_amdgcn_readfirstlane(tid >> 6);
    LAS bf16_t* Ks = (LAS bf16_t*)(lds + OFF_K); LAS bf16_t* Vs = (LAS bf16_t*)(lds + OFF_V); LAS float* tbl = (LAS float*)(lds + OFF_TBL);
    constexpr int NITEMS = 1024 + 64;
    const bool bal = (G == 256);
    int cnt;
    if (!bal) cnt = bx < NITEMS ? (NITEMS - bx + G - 1) / G : 0;
    else if (bx < 208) cnt = ((bx & 63) < 16 || (bx >= 160 && bx < 192)) ? 5 : 4;
    else cnt = bx < 240 ? 3 : 4;
    if (cnt == 0) return;
    auto item_of = [&](int k) -> int {
        if (!bal) return bx + k * G;
        if (bx >= 240) return k * 256 + 208 + (bx - 240);
        if (bx >= 208) return k * 256 + 224 + (bx - 208);
        if (k < 4) return k * 256 + bx;
        return (bx & 63) < 16 ? 1024 + 4 * (bx & 63) + (bx >> 6) : 3 * 256 + 224 + (bx - 160);
    };
    int cur_kh = -1;
    u32x4 kw[3], vw[3]; bf16x8 qn[4];
#define SWA_QFETCH(tt) do { size_t qrow_; int g_; if (!(tt).samp) { g_ = w >> 1; qrow_ = (size_t)((tt).b * SEQ + 64 * (tt).c + 32 * (w & 1) + r); } \
        else { const int ir_ = (32 * w + r) & 63; g_ = ir_ >> 4; qrow_ = (size_t)(MP + (tt).b * 16 + (ir_ & 15)); } \
        const bf16_t* Qp_ = AB + qrow_ * 2048 + 1024 + (4 * (tt).kh + g_) * 64; \
        _Pragma("unroll") for (int s_ = 0; s_ < 4; ++s_) qn[s_] = *(const bf16x8*)(Qp_ + 16 * s_ + 8 * h); } while (0)
    { const Item t0 = decode(item_of(0)); fetch(t0, SKV, cache_k, cache_v, kw, vw); SWA_QFETCH(t0); }
    asm volatile("" :: "v"(kw[0]), "v"(kw[1]), "v"(kw[2]), "v"(vw[0]), "v"(vw[1]), "v"(vw[2]));
    asm volatile("" :: "v"(qn[0]), "v"(qn[1]), "v"(qn[2]), "v"(qn[3]));
    for (int k = 0; k < cnt; ++k) {
        const Item t = decode(item_of(k));
        const bool samp = t.samp; const int b = t.b, kh = t.kh, c = t.c, kvmin = t.kvmin, kvmax = t.kvmax;
        {
            LAS bf16_t* kwp = opq(Ks + (tid >> 3) * KST + (tid & 7) * 8); LAS bf16_t* vwp = opq(Vs + (tid >> 3) * VSS + (tid & 7) * 8);
#pragma unroll
            for (int i = 0; i < 3; ++i) { const int kv = (tid >> 3) + 64 * i; const bool ok = kv >= kvmin && kv < kvmax; const u32x4 z4 = (u32x4){0u, 0u, 0u, 0u};
                *(LAS u32x4*)(kwp + 64 * i * KST) = ok ? kw[i] : z4; *(LAS u32x4*)(vwp + 64 * i * VSS) = ok ? vw[i] : z4; }
            if (kh != cur_kh) {
                LAS float* twp = opq(tbl + tid);
#pragma unroll
                for (int i = 0; i < 2; ++i) { const int idx = tid + 512 * i, g = idx >> 8, ii = idx & 255; twp[512 * i] = ii == 255 ? LOG2E * sinks[4 * kh + g] : LOG2E * rel_bias[t5_bucket(ii - 191) * 16 + 4 * kh + g]; }
                cur_kh = kh;
            }
        }
        __syncthreads();
        const bool active = !samp || w < 2;
        int g = 0, tq = 0;
        if (!samp) { g = w >> 1; tq = 32 * (w & 1) + r; }
        else { const int ir = (32 * w + r) & 63; g = ir >> 4; tq = ir & 15; }
        bf16x8 qf[4];
#pragma unroll
        for (int s = 0; s < 4; ++s) qf[s] = qn[s];
        if (k + 1 < cnt) { const Item tn = decode(item_of(k + 1)); fetch(tn, SKV, cache_k, cache_v, kw, vw); SWA_QFETCH(tn); }
        if (active) {
            const unsigned vm = (kvmax >= 192 ? 0xffffffu : ((1u << (kvmax >> 3)) - 1u)) & ~((1u << (kvmin >> 3)) - 1u);
            f32x16 sc[6];
            {
                const LAS bf16_t* krp = opq(Ks + r * KST + 8 * h);
#pragma unroll
                for (int blk = 0; blk < 6; ++blk) {
                    f32x16 a;
#pragma unroll
                    for (int i = 0; i < 16; ++i) a[i] = ((vm >> (4 * blk + (i >> 2))) & 1u) ? 0.f : -1e30f;
#pragma unroll
                    for (int s = 0; s < 4; ++s) { const bf16x8 kf = *(const LAS bf16x8*)(krp + (32 * blk) * KST + 16 * s); a = MFMA32(kf, qf[s], a); }
                    sc[blk] = a;
                }
            }
            const float sink = tbl[g * 256 + 255];
            const LAS float* tb = opq(tbl + g * 256 + 63 - tq + 4 * h);
            typedef float f32x2 __attribute__((ext_vector_type(2)));
            float mx = sink;
#pragma unroll
            for (int blk = 0; blk < 6; ++blk) {
#pragma unroll
                for (int q4 = 0; q4 < 4; ++q4) {
                    const LAS float* tp = tb + 32 * blk + 8 * q4;
                    f32x2 a = (f32x2){sc[blk][4 * q4], sc[blk][4 * q4 + 1]} + (f32x2){tp[0], tp[1]};
                    f32x2 b = (f32x2){sc[blk][4 * q4 + 2], sc[blk][4 * q4 + 3]} + (f32x2){tp[2], tp[3]};
                    sc[blk][4 * q4] = a[0]; sc[blk][4 * q4 + 1] = a[1]; sc[blk][4 * q4 + 2] = b[0]; sc[blk][4 * q4 + 3] = b[1];
                    mx = fmaxf(fmaxf(mx, a[0]), a[1]); mx = fmaxf(fmaxf(mx, b[0]), b[1]);
                }
                __builtin_amdgcn_sched_barrier(0);
            }
            mx = fmaxf(mx, __shfl_xor(mx, 32));
            const f32x2 nm = (f32x2){-mx, -mx};
            f32x2 l2 = (f32x2){0.f, 0.f};
#pragma unroll
            for (int blk = 0; blk < 6; ++blk)
#pragma unroll
                for (int q2 = 0; q2 < 8; ++q2) {
                    const f32x2 a = (f32x2){sc[blk][2 * q2], sc[blk][2 * q2 + 1]} + nm;
                    const f32x2 pe = (f32x2){__builtin_amdgcn_exp2f(a[0]), __builtin_amdgcn_exp2f(a[1])};
                    sc[blk][2 * q2] = pe[0]; sc[blk][2 * q2 + 1] = pe[1]; l2 += pe;
                }
            float l = l2[0] + l2[1];
            l += __shfl_xor(l, 32);
            l += __builtin_amdgcn_exp2f(sink - mx);
            const float inv = 1.0f / l;
            f32x16 o[2];
#pragma unroll
            for (int d = 0; d < 2; ++d) o[d] = (f32x16){0.f, 0.f, 0.f, 0.f, 0.f, 0.f, 0.f, 0.f, 0.f, 0.f, 0.f, 0.f, 0.f, 0.f, 0.f, 0.f};
            const LAS bf16_t* vrp = opq_after(Vs + (4 * h + ((lane & 15) >> 2)) * VSS + 16 * ((lane >> 4) & 1) + 4 * (lane & 3), inv);
#pragma unroll
            for (int blk = 0; blk < 6; ++blk) {
#pragma unroll
                for (int s2 = 0; s2 < 2; ++s2) {
                    u32x4 pw; pw.x = cvtpk(sc[blk][8 * s2 + 0] * inv, sc[blk][8 * s2 + 1] * inv); pw.y = cvtpk(sc[blk][8 * s2 + 2] * inv, sc[blk][8 * s2 + 3] * inv);
                    pw.z = cvtpk(sc[blk][8 * s2 + 4] * inv, sc[blk][8 * s2 + 5] * inv); pw.w = cvtpk(sc[blk][8 * s2 + 6] * inv, sc[blk][8 * s2 + 7] * inv);
                    const bf16x8 pa = __builtin_bit_cast(bf16x8, pw);
#pragma unroll
                    for (int d = 0; d < 2; ++d) {
                        const LAS bf16_t* vp = vrp + (32 * blk + 16 * s2) * VSS + 32 * d;
                        const s16x4 lo = tr16(vp), hi = tr16(vp + 8 * VSS);
                        const bf16x8 vb = __builtin_shufflevector(lo, hi, 0, 1, 2, 3, 4, 5, 6, 7);
                        o[d] = MFMA32(pa, vb, o[d]);
                    }
                }
                __builtin_amdgcn_sched_barrier(0);
            }
            {
                const size_t orow0 = samp ? (size_t)(MP + b * 16) : (size_t)(b * SEQ + 64 * c + 32 * (w & 1));
                const int og0 = samp ? 2 * w : (w >> 1);
                bf16_t* ub = (dummy ? dummy + (orow0 & 2047) * 2048 : AB + orow0 * 2048) + 1024 + (4 * kh + og0) * 64;
                const unsigned lo = (unsigned)(4 * h * 2048 + r);
#pragma unroll
                for (int i = 0; i < 16; ++i) {
                    const int ro = samp ? ((i & 3) + 8 * ((i >> 2) & 1)) * 2048 + (i >> 3) * 64 : ((i & 3) + 8 * (i >> 2)) * 2048;
                    (ub + ro)[lo] = f2bf(o[0][i]); (ub + ro + 32)[lo] = f2bf(o[1][i]);
                }
            }
        }
        __syncthreads();
    }
#undef SWA_QFETCH
}
}

namespace gla {
constexpr int QST = 136, TST = 72, VST = 288;
constexpr int OFF_QS = 0, OFF_KS = OFF_QS + 64 * QST * 2, OFF_KDT = OFF_KS + 64 * QST * 2, OFF_A = OFF_KDT + 128 * TST * 2, OFF_VS = OFF_A + 64 * TST * 2;
constexpr int OFF_GA = OFF_VS + 64 * VST * 2, OFF_EB = OFF_GA + 16 * 68 * 4, OFF_CS = OFF_EB + 512, OFF_PART = OFF_CS + 2048, OFF_HN = OFF_PART + 2048, LDS_USED = OFF_HN + 1024;
static_assert(LDS_USED <= RING_BYTES && (OFF_VS % 16) == 0, "gla lds");
typedef short v4i16_t __attribute__((ext_vector_type(4)));
__device__ __forceinline__ s16x4 tr16(const LAS bf16_t* p) { return __builtin_bit_cast(s16x4, __builtin_amdgcn_ds_read_tr16_b64_v4i16((LAS v4i16_t*)p)); }
__device__ __forceinline__ float log_sigmoid(float z) { const float az = fabsf(z); return fminf(z, 0.f) - 0.6931471805599453f * __builtin_amdgcn_logf(1.f + __builtin_amdgcn_exp2f(-az * LOG2E)); }

template <bool FULL, bool PARTIAL  >
__device__ __forceinline__ void span(LAS unsigned char* lds, int row0, int nch, int nvalid_, int hd, const bf16_t* QK, const bf16_t* V, bf16_t* AB, const float* GA,
                                     const float* w_alpha, const float* b_alpha, const float* head_norm, const float* S0, float* Sout, float* Dout, bf16_t* dummy = nullptr) {
    const int tid = threadIdx.x, lane = tid & 63, r = lane & 31, h = lane >> 5; const int w = __builtin_amdgcn_readfirstlane(tid >> 6);
    const int kt = w & 3, tt = w >> 2, kk = 32 * kt + r;
    const int nvalid = PARTIAL ? nvalid_ : 64;
    LAS bf16_t* QS = (LAS bf16_t*)(lds + OFF_QS); LAS bf16_t* KS = (LAS bf16_t*)(lds + OFF_KS); LAS bf16_t* KdT = (LAS bf16_t*)(lds + OFF_KDT); LAS bf16_t* Ab = (LAS bf16_t*)(lds + OFF_A);
    LAS bf16_t* VS = (LAS bf16_t*)(lds + OFF_VS); LAS float* GAs = (LAS float*)(lds + OFF_GA); LAS float* EB = (LAS float*)(lds + OFF_EB); LAS float* CS = (LAS float*)(lds + OFF_CS);
    LAS float* PART = (LAS float*)(lds + OFF_PART);
    float wal[8];
#pragma unroll
    for (int i = 0; i < 8; ++i) wal[i] = w_alpha[(2 * i + h) * 512 + hd * 128 + kk];
    const float bal = b_alpha[hd * 128 + kk];
    f32x16 Sacc[4];
    float dsum = 0.f;
    if (FULL && tid < 256) ((LAS float*)(lds + OFF_HN))[tid] = head_norm[tid];
    f32x4 raw_ga; u32x4 raw_k[2], raw_q[2];
    const int nv1 = nvalid - 1;
    const u32x4 z4 = (u32x4){0u, 0u, 0u, 0u};
#define GLA_FETCH_KG(cc) do { const int crow_ = row0 + 64 * (cc); int t_ = tid; asm volatile("" : "+v"(t_)); \
        const float* gau_ = GA + (size_t)crow_ * 16; const bf16_t* qku_ = QK + (size_t)crow_ * 1024 + hd * 128; \
        raw_ga = *(const f32x4*)(gau_ + (unsigned)(min(t_ >> 2, nv1) * 16 + (t_ & 3) * 4)); if (PARTIAL) { if ((t_ >> 2) >= nvalid) raw_ga = (f32x4){0.f, 0.f, 0.f, 0.f}; } \
        _Pragma("unroll") for (int i_ = 0; i_ < 2; ++i_) { raw_k[i_] = *(const u32x4*)(qku_ + 512 + (unsigned)(min((t_ >> 4) + 32 * i_, nv1) * 1024 + (t_ & 15) * 8)); if (PARTIAL) raw_k[i_] = ((t_ >> 4) + 32 * i_ < nvalid) ? raw_k[i_] : z4; \
            if (FULL) { raw_q[i_] = *(const u32x4*)(qku_ + (unsigned)(min((t_ >> 4) + 32 * i_, nv1) * 1024 + (t_ & 15) * 8)); if (PARTIAL) raw_q[i_] = ((t_ >> 4) + 32 * i_ < nvalid) ? raw_q[i_] : z4; } } } while (0)
#define GLA_FETCH_QV(cc) do { const int crow_ = row0 + 64 * (cc); int t_ = tid; asm volatile("" : "+v"(t_)); \
        const bf16_t* vu_ = V + (size_t)crow_ * 1024 + hd * 256; const bf16_t* qku_ = QK + (size_t)crow_ * 1024 + hd * 128; \
        _Pragma("unroll") for (int i_ = 0; i_ < 4; ++i_) { raw_v[i_] = *(const u32x4*)(vu_ + (unsigned)(min((t_ >> 5) + 16 * i_, nv1) * 1024 + (t_ & 31) * 8)); if (PARTIAL) raw_v[i_] = ((t_ >> 5) + 16 * i_ < nvalid) ? raw_v[i_] : z4; } } while (0)
    GLA_FETCH_KG(0);
    asm volatile("" :: "v"(raw_ga), "v"(raw_k[0]), "v"(raw_k[1]));
    if (FULL) asm volatile("" :: "v"(raw_q[0]), "v"(raw_q[1]));
    if (FULL && S0) {
        const float* s0p = S0 + (size_t)(4 * h) * 256 + 32 * w + r;
#pragma unroll
        for (int kb = 0; kb < 4; ++kb)
#pragma unroll
            for (int i = 0; i < 16; ++i) Sacc[kb][i] = s0p[(32 * kb + (i & 3) + 8 * (i >> 2)) * 256];
    } else {
#pragma unroll
        for (int kb = 0; kb < 4; ++kb)
#pragma unroll
            for (int i = 0; i < 16; ++i) Sacc[kb][i] = 0.f;
    }
    f32x16 oT[2]; u32x2 grv[2][4];
    const LAS float* hn_r = opq((LAS float*)(lds + OFF_HN) + 32 * w + 4 * h);
    LAS float* part_p = opq(PART + r);
#define GLA_S6(crow_) do { \
        _Pragma("unroll") for (int tb = 0; tb < 2; ++tb) { \
            float tot = 0.f; \
            _Pragma("unroll") for (int w2 = 0; w2 < 8; ++w2) tot += part_p[w2 * 64 + 32 * tb]; \
            const float rs = __builtin_amdgcn_rsqf(tot * (1.0f / 256.0f) + EPS); \
            if (32 * tb + r < nvalid) { \
                bf16_t* gp = (dummy ? dummy + (size_t)(((crow_) + 32 * tb) & 2047) * 2048 : AB + (size_t)((crow_) + 32 * tb) * 2048) + hd * 256 + 32 * w + (unsigned)(r * 2048 + 4 * h); \
                _Pragma("unroll") for (int q4 = 0; q4 < 4; ++q4) { \
                    const f32x4 g4 = (f32x4){bflo(grv[tb][q4].x), bfhi(grv[tb][q4].x), bflo(grv[tb][q4].y), bfhi(grv[tb][q4].y)}; \
                    f32x4 y; \
                    const f32x4 hn4 = *(const LAS f32x4*)(hn_r + 8 * q4); \
                    _Pragma("unroll") for (int e = 0; e < 4; ++e) y[e] = oT[tb][4 * q4 + e] * rs * hn4[e] * siluf_(g4[e]); \
                    *(u32x2*)(gp + 8 * q4) = (u32x2){cvtpk(y[0], y[1]), cvtpk(y[2], y[3])}; \
                } } } } while (0)
    for (int c = 0; c < nch; ++c) {
        const int crow0 = row0 + 64 * c;
        if (tid < 256) { LAS float* gp_ = GAs + ((tid & 3) * 4) * 68 + (tid >> 2); gp_[0] = raw_ga[0]; gp_[68] = raw_ga[1]; gp_[136] = raw_ga[2]; gp_[204] = raw_ga[3]; }
        {
            LAS bf16_t* ks_st = opq(KS + (tid >> 4) * QST + (tid & 15) * 8);
#pragma unroll
            for (int i = 0; i < 2; ++i) { *(LAS u32x4*)(ks_st + 32 * i * QST) = raw_k[i]; if (FULL) *(LAS u32x4*)(ks_st - 64 * QST + 32 * i * QST) = raw_q[i]; }
        }
        u32x4 raw_v[4];
        GLA_FETCH_QV(c);
        __syncthreads();
        if (FULL && c > 0) GLA_S6(crow0 - 64);
        float bc[16];
        {
            f32x16 bacc;
#pragma unroll
            for (int i = 0; i < 16; ++i) bacc[i] = bal;
            const LAS float* ga_r = opq(GAs + h * 68 + 32 * tt + r);
#pragma unroll
            for (int s = 0; s < 8; ++s) bacc = __builtin_amdgcn_mfma_f32_32x32x2f32(ga_r[2 * s * 68], wal[s], bacc, 0, 0, 0);
            float sg[4], pg[4];
#pragma unroll
            for (int g2 = 0; g2 < 4; ++g2) { float s4 = 0.f;
#pragma unroll
                for (int e = 0; e < 4; ++e) { float la = log_sigmoid(bacc[4 * g2 + e]) * 0.0625f; if (PARTIAL) la = (32 * tt + 8 * g2 + 4 * h + e < nvalid) ? la : 0.f; bc[4 * g2 + e] = la; s4 += la; }
                sg[g2] = s4; }
#pragma unroll
            for (int g2 = 0; g2 < 4; ++g2) pg[g2] = __shfl_xor(sg[g2], 32);
            float pre = 0.f;
#pragma unroll
            for (int g2 = 0; g2 < 4; ++g2) { float run = pre + (h ? pg[g2] : 0.f);
#pragma unroll
                for (int e = 0; e < 4; ++e) { run += bc[4 * g2 + e]; bc[4 * g2 + e] = run; }
                pre += sg[g2] + pg[g2]; }
            if (h == 0) CS[tt * 128 + kk] = pre;
        }
        __syncthreads();
        const float offs = tt ? CS[kk] : 0.f, blast = CS[kk] + CS[128 + kk];
        const float eblast = fast_exp(blast);
        if (tt == 0 && h == 0) { EB[kk] = eblast; dsum += blast; }
        {
            LAS bf16_t* qs_e = opq(QS + (32 * tt + 4 * h) * QST + kk); LAS bf16_t* ks_e = qs_e + 64 * QST;
            LAS bf16_t* kdt_w = opq(KdT + kk * TST + 32 * tt + 4 * h);
#pragma unroll
            for (int g2 = 0; g2 < 4; ++g2) {
                unsigned kdw[2];
#pragma unroll
                for (int e = 0; e < 4; e += 2) {
                    const int j = 4 * g2 + e, t0 = 8 * g2 + e;
                    const float b0 = bc[j] + offs, b1 = bc[j + 1] + offs;
                    const float k0 = bf2f(ks_e[t0 * QST]), k1 = bf2f(ks_e[(t0 + 1) * QST]);
                    float e0 = 0.f, e1 = 0.f, r0, r1;
                    if (FULL) { e0 = fast_exp(b0); e1 = fast_exp(b1); r0 = __builtin_amdgcn_rcpf(e0); r1 = __builtin_amdgcn_rcpf(e1); } else { r0 = fast_exp(-b0); r1 = fast_exp(-b1); }
                    const float kt0 = k0 * r0, kt1 = k1 * r1;
                    kdw[e >> 1] = cvtpk(kt0 * eblast, kt1 * eblast);
                    if (FULL) {
                        const float q0 = bf2f(qs_e[t0 * QST]), q1 = bf2f(qs_e[(t0 + 1) * QST]);
                        qs_e[t0 * QST] = f2bf(q0 * e0); qs_e[(t0 + 1) * QST] = f2bf(q1 * e1);
                        ks_e[t0 * QST] = f2bf(kt0); ks_e[(t0 + 1) * QST] = f2bf(kt1);
                    }
                }
                *(LAS u32x2*)(kdt_w + 8 * g2) = (u32x2){kdw[0], kdw[1]};
            }
        }
        {
            LAS bf16_t* vs_st = opq(VS + (tid >> 5) * VST + (tid & 31) * 8);
#pragma unroll
            for (int i = 0; i < 4; ++i) *(LAS u32x4*)(vs_st + 16 * i * VST) = raw_v[i];
        }
        if (c + 1 < nch) GLA_FETCH_KG(c + 1);
        __syncthreads();
        bf16x8 vfr[4];
        if (FULL) {
            if (w < 3) {
                const int tb = w == 0 ? 0 : 1, sb = w == 2 ? 1 : 0;
                const LAS bf16_t* qa_r = opq(QS + (32 * tb + r) * QST + 8 * h); const LAS bf16_t* kb_r = opq(KS + (32 * sb + r) * QST + 8 * h);
                f32x16 a = {0.f, 0.f, 0.f, 0.f, 0.f, 0.f, 0.f, 0.f, 0.f, 0.f, 0.f, 0.f, 0.f, 0.f, 0.f, 0.f};
#pragma unroll
                for (int s = 0; s < 8; ++s) {
                    const bf16x8 qa = *(const LAS bf16x8*)(qa_r + 16 * s);
                    const bf16x8 kb2 = *(const LAS bf16x8*)(kb_r + 16 * s);
                    a = MFMA32(qa, kb2, a);
                }
                LAS bf16_t* ab_w = opq(Ab + (32 * tb + 4 * h) * TST + 32 * sb + r);
                const int dl = 32 * sb + r - 32 * tb - 4 * h;
#pragma unroll
                for (int i = 0; i < 16; ++i) ab_w[((i & 3) + 8 * (i >> 2)) * TST] = f2bf(dl <= (i & 3) + 8 * (i >> 2) ? a[i] : 0.f);
            }
            const LAS bf16_t* qt_r4 = opq(QS + r * QST + 4 * h);
#pragma unroll
            for (int tb = 0; tb < 2; ++tb) oT[tb] = (f32x16){0.f, 0.f, 0.f, 0.f, 0.f, 0.f, 0.f, 0.f, 0.f, 0.f, 0.f, 0.f, 0.f, 0.f, 0.f, 0.f};
#pragma unroll
            for (int kb = 0; kb < 4; ++kb) {
#pragma unroll
                for (int s2 = 0; s2 < 2; ++s2) {
                    u32x4 sw; sw.x = cvtpk(Sacc[kb][8 * s2 + 0], Sacc[kb][8 * s2 + 1]); sw.y = cvtpk(Sacc[kb][8 * s2 + 2], Sacc[kb][8 * s2 + 3]);
                    sw.z = cvtpk(Sacc[kb][8 * s2 + 4], Sacc[kb][8 * s2 + 5]); sw.w = cvtpk(Sacc[kb][8 * s2 + 6], Sacc[kb][8 * s2 + 7]);
                    const bf16x8 sb = __builtin_bit_cast(bf16x8, sw);
#pragma unroll
                    for (int tb = 0; tb < 2; ++tb) {
                        const LAS bf16_t* qp = qt_r4 + (32 * tb) * QST + 32 * kb + 16 * s2;
                        const s16x4 lo = *(const LAS s16x4*)qp, hi = *(const LAS s16x4*)(qp + 8);
                        const bf16x8 qa = __builtin_shufflevector(lo, hi, 0, 1, 2, 3, 4, 5, 6, 7);
                        oT[tb] = MFMA32(sb, qa, oT[tb]);
                    }
                }
                __builtin_amdgcn_sched_barrier(0);
            }
            __syncthreads();
            {
                const LAS bf16_t* vt_r = opq(VS + (8 * h + ((lane & 15) >> 2)) * VST + 32 * w + 16 * ((lane >> 4) & 1) + 4 * (lane & 3));
#pragma unroll
                for (int s4 = 0; s4 < 4; ++s4) { const s16x4 vlo = tr16(vt_r + (16 * s4) * VST), vhi = tr16(vt_r + (16 * s4 + 4) * VST); vfr[s4] = __builtin_shufflevector(vlo, vhi, 0, 1, 2, 3, 4, 5, 6, 7); }
            }
#pragma unroll
            for (int tb = 0; tb < 2; ++tb)
#pragma unroll
                for (int q4 = 0; q4 < 4; ++q4) grv[tb][q4] = *(const u32x2*)(AB + (size_t)crow0 * 2048 + hd * 256 + 32 * w + 8 * q4 + (unsigned)(min(32 * tb + r, nv1) * 2048 + 4 * h));
            const LAS bf16_t* ab_r = opq(Ab + r * TST + 8 * h);
#pragma unroll
            for (int tb = 0; tb < 2; ++tb)
#pragma unroll
                for (int sb = 0; sb < 2; ++sb) {
                    if (sb > tb) continue;
#pragma unroll
                    for (int s2 = 0; s2 < 2; ++s2) {
                        const bf16x8 aa = *(const LAS bf16x8*)(ab_r + (32 * tb) * TST + 32 * sb + 16 * s2);
                        oT[tb] = MFMA32(vfr[2 * sb + s2], aa, oT[tb]);
                    }
                }
        }
        const LAS bf16_t* kdt_r = opq(KdT + r * TST + 8 * h);
        if (!FULL) {
            const LAS bf16_t* vt_r2 = opq(VS + (8 * h + ((lane & 15) >> 2)) * VST + 32 * w + 16 * ((lane >> 4) & 1) + 4 * (lane & 3));
#pragma unroll
            for (int s4 = 0; s4 < 4; ++s4) { const s16x4 vlo = tr16(vt_r2 + (16 * s4) * VST), vhi = tr16(vt_r2 + (16 * s4 + 4) * VST); vfr[s4] = __builtin_shufflevector(vlo, vhi, 0, 1, 2, 3, 4, 5, 6, 7); }
        }
        const LAS float* eb_r = opq(EB + 4 * h);
#pragma unroll
        for (int kb = 0; kb < 4; ++kb) {
#pragma unroll
            for (int q4 = 0; q4 < 4; ++q4) { const f32x4 e = *(const LAS f32x4*)(eb_r + 32 * kb + 8 * q4);
#pragma unroll
                for (int e2 = 0; e2 < 4; ++e2) Sacc[kb][4 * q4 + e2] *= e[e2]; }
#pragma unroll
            for (int s = 0; s < 4; ++s) {
                const bf16x8 ka = *(const LAS bf16x8*)(kdt_r + (32 * kb) * TST + 16 * s);
                Sacc[kb] = MFMA32(ka, vfr[s], Sacc[kb]);
            }
            __builtin_amdgcn_sched_barrier(0);
        }
        if (FULL) {
#pragma unroll
            for (int tb = 0; tb < 2; ++tb) { float p = 0.f;
#pragma unroll
                for (int i = 0; i < 16; ++i) p += oT[tb][i] * oT[tb][i];
                p += __shfl_xor(p, 32);
                if (h == 0) part_p[w * 64 + 32 * tb] = p; }
        }
        __syncthreads();
    }
    if (FULL) GLA_S6(row0 + 64 * (nch - 1));
#undef GLA_S6
#undef GLA_FETCH_KG
#undef GLA_FETCH_QV
    if (Sout) {
#pragma unroll
        for (int kb = 0; kb < 4; ++kb)
#pragma unroll
            for (int i = 0; i < 16; ++i) Sout[(size_t)(32 * kb + crow(i, h)) * 256 + 32 * w + r] = Sacc[kb][i];
    }
    if (!FULL && tt == 0 && h == 0) Dout[kk] = fast_exp(dsum);
    __syncthreads();
}
}


namespace skinny {
typedef float f32x4v __attribute__((ext_vector_type(4)));
__device__ __forceinline__ bf16x8 sk_perm(const bf16x8 v, int pidx) {
    const u32x4 r = __builtin_bit_cast(u32x4, v); u32x4 o;
    o.x = (unsigned)__builtin_amdgcn_ds_bpermute(pidx, (int)r.x); o.y = (unsigned)__builtin_amdgcn_ds_bpermute(pidx, (int)r.y);
    o.z = (unsigned)__builtin_amdgcn_ds_bpermute(pidx, (int)r.z); o.w = (unsigned)__builtin_amdgcn_ds_bpermute(pidx, (int)r.w);
    return __builtin_bit_cast(bf16x8, o);
}
template <int NPARTS, int STEPS  , bool FINAL, class Epi>
__device__ __forceinline__ void phase(LAS unsigned char* lds, const bf16_t* A, int lda, const bf16_t* Bt, int ldb, int koff, float* ssq, int G, int bx, const Epi& E,
                                      const float* gain = nullptr, float* out = nullptr, unsigned* cnt = nullptr) {
    const int tid = threadIdx.x, lane = tid & 63, fr = lane & 15, fq = lane >> 4; const int w = __builtin_amdgcn_readfirstlane(tid >> 6);
    const int pidx = 4 * (4 * (lane & 15) + (lane >> 4));
    LAS f32x4* red = (LAS f32x4*)lds;
    LAS float* sred = (LAS float*)(lds + 8 * NPARTS * 4 * 64 * 16);
    constexpr int UB = STEPS > 4 ? 4 : STEPS;
    for (int pi = bx; pi < 256; pi += G) {
        const int rg = pi >> 4, cg = pi & 15;
        f32x4 acc[NPARTS][4];
#pragma unroll
        for (int p = 0; p < NPARTS; ++p) {
#pragma unroll
            for (int nt = 0; nt < 4; ++nt) acc[p][nt] = (f32x4){0.f, 0.f, 0.f, 0.f};
            const bf16_t* wp = Bt + (size_t)(64 * cg + (lane >> 2)) * ldb + p * koff + w * (STEPS * 32) + 8 * (lane & 3);
            const bf16_t* ap = A + (size_t)(MP + 16 * rg + (lane >> 2)) * lda + p * koff + w * (STEPS * 32) + 8 * (lane & 3);
            constexpr int NB = (STEPS + UB - 1) / UB;
            bf16x8 af[2][UB], wf[2][UB][4];
#define SK_LOAD(b_, s0_) do { _Pragma("unroll") for (int u = 0; u < UB; ++u) if ((s0_) + u < STEPS) { af[b_][u] = *(const bf16x8*)(ap + ((s0_) + u) * 32); \
                _Pragma("unroll") for (int nt = 0; nt < 4; ++nt) wf[b_][u][nt] = *(const bf16x8*)(wp + (size_t)(16 * nt) * ldb + ((s0_) + u) * 32); } } while (0)
#define SK_MMA(b_, s0_) do { _Pragma("unroll") for (int u = 0; u < UB; ++u) if ((s0_) + u < STEPS) { const bf16x8 afp = sk_perm(af[b_][u], pidx); \
                _Pragma("unroll") for (int nt = 0; nt < 4; ++nt) acc[p][nt] = __builtin_amdgcn_mfma_f32_16x16x32_bf16(sk_perm(wf[b_][u][nt], pidx), afp, acc[p][nt], 0, 0, 0); } } while (0)
            SK_LOAD(0, 0);
#pragma unroll
            for (int b = 0; b < NB; ++b) {
                if (b + 1 < NB) { if ((b & 1) == 0) SK_LOAD(1, (b + 1) * UB); else SK_LOAD(0, (b + 1) * UB); }
                if ((b & 1) == 0) SK_MMA(0, b * UB); else SK_MMA(1, b * UB);
            }
#undef SK_LOAD
#undef SK_MMA
        }
#pragma unroll
        for (int p = 0; p < NPARTS; ++p)
#pragma unroll
            for (int nt = 0; nt < 4; ++nt) red[((w * NPARTS + p) * 4 + nt) * 64 + lane] = acc[p][nt];
        __syncthreads();
        f32x4 o = (f32x4){0.f, 0.f, 0.f, 0.f};
        if (w < 4) {
            f32x4 a2[NPARTS];
#pragma unroll
            for (int p = 0; p < NPARTS; ++p) { a2[p] = (f32x4){0.f, 0.f, 0.f, 0.f};
#pragma unroll
                for (int w2 = 0; w2 < 8; ++w2) a2[p] += red[((w2 * NPARTS + p) * 4 + w) * 64 + lane]; }
            const int row = MP + 16 * rg + fr, c0 = 64 * cg + 16 * w + 4 * fq;
            o = E(row, c0, a2);
            float s = (o[0] * o[0] + o[1] * o[1]) + (o[2] * o[2] + o[3] * o[3]);
            s += __shfl_xor(s, 16); s += __shfl_xor(s, 32);
            if (fq == 0) sred[w * 16 + fr] = s;
        }
        __syncthreads();
        if constexpr (FINAL) {
            float mine = 0.f; if (tid < 16) mine = (sred[tid] + sred[16 + tid]) + (sred[32 + tid] + sred[48 + tid]);
            LAS float* S = sred + 64;
            xchg_rstd(mine, S, 16, ssq + (size_t)(MP + 16 * rg) * 16, cg, 16, cnt + 64 * rg, 16u);
            if (w < 4) { const int row = MP + 16 * rg + fr, c0 = 64 * cg + 16 * w + 4 * fq; const f32x4 g4 = *(const f32x4*)(gain + c0); *(f32x4*)(out + (size_t)row * D + c0) = o * S[fr] * g4; }
        } else {
            if (ssq && tid < 16) ssq[(size_t)(MP + 16 * rg + tid) * 16 + cg] = (sred[tid] + sred[16 + tid]) + (sred[32 + tid] + sred[48 + tid]);
        }
        __syncthreads();
    }
}
__device__ __forceinline__ u32x2 pack4(const f32x4 v) { return (u32x2){cvtpk(v[0], v[1]), cvtpk(v[2], v[3])}; }
__device__ __forceinline__ f32x4 unpack4(const u32x2 w) { return (f32x4){bflo(w.x), bfhi(w.x), bflo(w.y), bfhi(w.y)}; }
template <bool BASE_BF16, bool OUT_F32, bool OUT_BF16> struct EpiResidual {
    const void* base; float* outf; bf16_t* outb; float scale;
    __device__ __forceinline__ f32x4 operator()(int row, int c0, const f32x4 (&acc)[1]) const {
        const size_t off = (size_t)row * D + c0;
        f32x4 b;
        if (BASE_BF16) b = unpack4(*(const u32x2*)((const bf16_t*)base + off)); else b = *(const f32x4*)((const float*)base + (off - (size_t)MP * D));
        const f32x4 v = b + acc[0] * scale;
        if (OUT_F32) *(f32x4*)(outf + off) = v;
        if (OUT_BF16) *(u32x2*)(outb + off) = pack4(v);
        return v;
    }
};
struct EpiMerge {
    bf16_t* G;
    __device__ __forceinline__ f32x4 operator()(int row, int c0, const f32x4 (&acc)[2]) const {
        bf16_t* pt = G + (size_t)row * 2048 + c0;
        const f32x4 rho = unpack4(*(const u32x2*)pt), sgb = unpack4(*(const u32x2*)(pt + 1024));
        const f32x4 m = sgb * (rho * acc[0] + acc[1]);
        *(u32x2*)pt = pack4(m);
        return m;
    }
};
}

__global__ void __launch_bounds__(NTHREADS, 2) fwd_kernel(Params P) {
    extern __shared__ __attribute__((aligned(16))) unsigned char lds_raw[];
    LAS unsigned char* lds = (LAS unsigned char*)lds_raw;
    volatile LAS unsigned* MISC = (volatile LAS unsigned*)(lds + MISC_OFF);
    const int tid = threadIdx.x, lane = tid & 63; const int wave = __builtin_amdgcn_readfirstlane(tid >> 6);
    const int G = gridDim.x, bx = blockIdx.x;
    unsigned char* ws = P.ws; float* out = P.out; unsigned char* outb = (unsigned char*)P.out;
    for (int u = tid; u < (LDS_BYTES - RING_BYTES) / 4; u += NTHREADS) ((LAS unsigned*)(lds + RING_BYTES))[u] = 0u;
    __syncthreads();
    const bool use_bar = (P.ph_hi - P.ph_lo) > 1;
    XcdBarrier bar; bar.bar = (unsigned*)(ws + WS_CTL); bar.x = 0; bar.st = nullptr;
    if (use_bar) bar = xcd_barrier_post((unsigned*)(ws + WS_CTL), MISC + 8);
    const int lo = P.ph_lo, hi = P.ph_hi;
#ifndef PHASE_MASK
#define PHASE_MASK 0xFFF
#endif
#define IN(k) (((PHASE_MASK >> (k)) & 1) && lo <= (k) && (k) < hi)
#define SEAM(k) do { if (IN(k) && IN((k) + 1)) xcd_barrier(bar); } while (0)
    float* ssq0 = (float*)(ws + WS_SSQ); float* ssq1 = (float*)(ws + WS_SSQ + SSQ_STRIDE); float* ssq2 = (float*)(ws + WS_SSQ + 2 * SSQ_STRIDE); float* ssq3 = (float*)(ws + WS_SSQ + 3 * SSQ_STRIDE);
    float* GA = (float*)(ws + WS_GA); float* DV = (float*)(ws + WS_DV);
    bf16_t* XA = (bf16_t*)(ws + WS_XA); bf16_t* QK = (bf16_t*)(ws + WS_QK); bf16_t* Vb = (bf16_t*)(ws + WS_V); bf16_t* Gb = (bf16_t*)(ws + WS_G); bf16_t* AB = (bf16_t*)(ws + WS_AB);
    bf16_t* SKV = (bf16_t*)(ws + WS_SKV); bf16_t* Hb = (bf16_t*)(ws + WS_H); float* X2F = (float*)(ws + WS_AB);
    bf16_t* Wup1 = (bf16_t*)(outb + OW_UP1); bf16_t* Wdn1 = (bf16_t*)(outb + OW_DN1); bf16_t* Win = (bf16_t*)(outb + OW_IN); bf16_t* Wbr = (bf16_t*)(outb + OW_BR);
    bf16_t* Wout = (bf16_t*)(outb + OW_OUT); bf16_t* Wup2 = (bf16_t*)(outb + OW_UP2); bf16_t* Wdn2 = (bf16_t*)(ws + WS_WDN2);
    float* DS = (float*)(outb + O_DS);
    const int gw = bx * NWAVES + wave, NGW = G * NWAVES;

#define CONVERT_LIST(LIST, first_, stride_) convert_list<LIST>((first_), (stride_), P, (LAS float*)(lds + wave * 16384), lane)
#define CONVERT_ON_LIGHT(LIST, nwg_) do { const int rem_ = (nwg_) % G; const int nl_ = rem_ ? G - rem_ : G, lc_ = rem_ ? bx - rem_ : bx; \
        if (lc_ >= 0) CONVERT_LIST(LIST, lc_ * NWAVES + wave, nl_ * NWAVES); } while (0)
    const bool split_conv = (lo == 0 && hi == 12);
    if (IN(0)) {
        CONVERT_LIST(0, gw, NGW);
        if (!split_conv) { CONVERT_LIST(1, gw, NGW); CONVERT_LIST(2, gw, NGW); CONVERT_LIST(3, gw, NGW); }
        {
            f32x4 v[2][4], vn[2][4];
            auto xrow = [&](int m) -> const f32x4* { const float* xr = (m < MP) ? P.in[0] + (size_t)m * D : P.in[1] + (size_t)(m - MP) * D; return (const f32x4*)xr + lane; };
            int m0 = 2 * gw;
            if (m0 < M) {
#pragma unroll
                for (int q = 0; q < 2; ++q) { const f32x4* xv = xrow(m0 + q);
#pragma unroll
                    for (int j = 0; j < 4; ++j) v[q][j] = xv[64 * j]; }
            }
            for (; m0 < M; m0 += 2 * NGW) {
                const int mn = m0 + 2 * NGW; const bool more = mn < M;
                if (more) {
#pragma unroll
                    for (int q = 0; q < 2; ++q) { const f32x4* xv = xrow(mn + q);
#pragma unroll
                        for (int j = 0; j < 4; ++j) vn[q][j] = xv[64 * j]; }
                }
                float sq[2];
#pragma unroll
                for (int q = 0; q < 2; ++q) { float s2 = 0.f;
#pragma unroll
                    for (int j = 0; j < 4; ++j) s2 += (v[q][j][0] * v[q][j][0] + v[q][j][1] * v[q][j][1]) + (v[q][j][2] * v[q][j][2] + v[q][j][3] * v[q][j][3]);
                    sq[q] = wave_sum(s2); }
#pragma unroll
                for (int q = 0; q < 2; ++q) { const int m = m0 + q; u32x2* o8 = (u32x2*)(XA + (size_t)m * D) + lane;
#pragma unroll
                    for (int j = 0; j < 4; ++j) o8[64 * j] = (u32x2){cvtpk(v[q][j][0], v[q][j][1]), cvtpk(v[q][j][2], v[q][j][3])};
                    if (lane == 0) ssq0[(size_t)m * 16] = __builtin_amdgcn_rsqf(sq[q] * (1.0f / D) + EPS); }
                if (more) {
#pragma unroll
                    for (int q = 0; q < 2; ++q)
#pragma unroll
                        for (int j = 0; j < 4; ++j) v[q][j] = vn[q][j];
                }
            }
        }
    }
    SEAM(0);
    LAS float* rtab = (LAS float*)(lds + RING_BYTES + 2048);
#define RSTD_TABLE_FILL(S_, ssq_, DIRECT_) do { \
        const int rr_ = tid & 255, uh_ = tid >> 8; f32x4 tv_[4][4]; bool ok_[4];     \
        _Pragma("unroll") for (int j_ = 0; j_ < 4; ++j_) { pg8::Unit u_; ok_[j_] = (S_).next(2 * j_ + uh_, u_); const float* p_ = (ssq_) + (size_t)((ok_[j_] ? u_.pm : 0) * 256 + rr_) * 16; \
            _Pragma("unroll") for (int q_ = 0; q_ < ((DIRECT_) ? 1 : 4); ++q_) tv_[j_][q_] = *(const f32x4*)(p_ + 4 * q_); } \
        _Pragma("unroll") for (int j_ = 0; j_ < 4; ++j_) { float r_; \
            if (DIRECT_) r_ = tv_[j_][0][0]; \
            else { const f32x4 a_ = tv_[j_][0], b_ = tv_[j_][1], c_ = tv_[j_][2], d_ = tv_[j_][3]; \
                   const float s_ = ((a_[0] + a_[1]) + (a_[2] + a_[3])) + ((b_[0] + b_[1]) + (b_[2] + b_[3])) + ((c_[0] + c_[1]) + (c_[2] + c_[3])) + ((d_[0] + d_[1]) + (d_[2] + d_[3])); \
                   r_ = __builtin_amdgcn_rsqf(s_ * (1.0f / D) + EPS); } \
            if (ok_[j_]) rtab[(2 * j_ + uh_) * 256 + rr_] = r_; } \
        __syncthreads(); } while (0)
    if (IN(1)) {
        pg8::Gemm g{XA, Wup1, D, D, D, 0}; pg8::Sched S; S.init(M, NUP, G, bx, 0);
        RSTD_TABLE_FILL(S, ssq0, true);
        pg8::EpiSwiglu E{Hb, rtab};
        if (split_conv) { CONVERT_ON_LIGHT(1, (M / 256) * (NUP / 256)); __syncthreads(); }
        pg8::gemm_phase(lds, g, S, E);
    }
    SEAM(1);
    const bool stagger = (G == 256);
    const bool sk_early = stagger && ((bx >> 3) & 1) == 0;
    const int sk_piece = stagger ? (((bx >> 3) & 15) * 16 + 2 * (bx & 7) + (bx >> 7)) : bx;
    if (IN(2)) {
        pg8::Gemm g{Hb, Wdn1, FF, FF, FF, 0}; pg8::Sched S; S.init(MP, D, G, bx, 0);
        pg8::EpiResidual<true, false, true> E{XA, nullptr, nullptr, XA, ssq1, 0.5f};
        skinny::EpiResidual<true, false, true> Es{XA, nullptr, XA, 0.5f};
        if (sk_early) skinny::phase<1, FF / 256, false>(lds, Hb, FF, Wdn1, FF, 0, ssq1, G, sk_piece, Es);
        pg8::gemm_phase(lds, g, S, E);
        if (!sk_early) skinny::phase<1, FF / 256, false>(lds, Hb, FF, Wdn1, FF, 0, ssq1, G, sk_piece, Es);
    }
    SEAM(2);
    if (IN(3)) {
        pg8::Gemm g{XA, Win, D, D, D, 0}; pg8::Sched S; S.init(M, NIN_V, G, bx, 0);
        RSTD_TABLE_FILL(S, ssq1, false);
        pg8::EpiIn E{QK, Vb, Gb, AB, SKV, GA, rtab, P.in[13], P.in[14], out};
        if (split_conv) { CONVERT_ON_LIGHT(2, (M / 256) * (NIN_V / 256)); __syncthreads(); }
        pg8::gemm_phase(lds, g, S, E);
    }
    SEAM(3);
    if (IN(4)) {
#ifndef P4_SKIP_GLA
#ifndef P4_SKIP_GLA_A
#if defined(PROBE_GLAA)
        for (int it = bx; it < 240; it += G) { const int bh = it / 15, sc = it % 15, b = bh >> 2, hd = bh & 3;
            gla::span<false, false>(lds, b * SEQ + sc * 256, 4, 64, hd, QK, Vb, AB, GA, P.in[10], P.in[11], P.in[12], nullptr, DS + (size_t)it * 32768, DV + (size_t)it * 128); }
#endif
        for (int it = bx; it < 240; it += G) { const int bh = it / 15, sc = it % 15, b = bh >> 2, hd = bh & 3;
            gla::span<false, false>(lds, b * SEQ + sc * 256, 4, 64, hd, QK, Vb, AB, GA, P.in[10], P.in[11], P.in[12], nullptr, DS + (size_t)it * 32768, DV + (size_t)it * 128); }
#endif
#ifndef P4_SKIP_GLA_S
        const int ss0 = G == 256 ? (bx >= 240 ? 2 * (bx - 240) : bx >= 208 ? 32 + (bx - 208) : 64) : G - 1 - bx;
        const int ssn = G == 256 ? (bx >= 240 ? ss0 + 2 : ss0 + 1) : 64, sst = G == 256 ? 1 : G;
        for (int s = ss0; s < ssn && s < 64; s += sst) { const int db = s >> 2, hd = s & 3;
            gla::span<true, true>(lds, MP + db * 16, 1, 16, hd, QK, Vb, AB, GA, P.in[10], P.in[11], P.in[12], P.in[4] + (size_t)s * 32768, out + OUT_GS + (size_t)s * 32768, nullptr); }
#endif
#endif
#ifndef P4_SKIP_SWA
#if defined(PROBE_SWA)
        swa::phase(lds, bx, G, AB, (bf16_t*)(outb + 53 * MiB), SKV, P.in[2], P.in[3], P.in[15], P.in[16]);
#endif
        swa::phase(lds, bx, G, AB, nullptr, SKV, P.in[2], P.in[3], P.in[15], P.in[16]);
#endif
    }
    SEAM(4);
    if (IN(5)) {
        for (int gid = bx * NTHREADS + tid; gid < 16 * 8192; gid += G * NTHREADS) {
            const int bh = gid >> 13, e = gid & 8191, k = e >> 6;
            f32x4 ds[15]; float dd[15];
#pragma unroll
            for (int j = 0; j < 15; ++j) { ds[j] = *((const f32x4*)(DS + (size_t)(bh * 15 + j) * 32768) + e); dd[j] = DV[(size_t)(bh * 15 + j) * 128 + k]; }
            f32x4 Sv = (f32x4){0.f, 0.f, 0.f, 0.f};
#pragma unroll
            for (int j = 0; j < 15; ++j) { Sv = Sv * dd[j] + ds[j]; *((f32x4*)(DS + (size_t)(bh * 15 + j) * 32768) + e) = Sv; }
        }
    }
    SEAM(5);
    if (IN(6)) {
#if defined(PROBE_GLAC)
        for (int it = bx; it < 256; it += G) { const int bh = it >> 4, sc = it & 15, b = bh >> 2, hd = bh & 3;
            gla::span<true, false>(lds, b * SEQ + sc * 256, 4, 64, hd, QK, Vb, AB, GA, P.in[10], P.in[11], P.in[12], sc ? DS + (size_t)(bh * 15 + sc - 1) * 32768 : nullptr, nullptr, nullptr, (bf16_t*)(outb + 53 * MiB)); }
#endif
        for (int it = bx; it < 256; it += G) { const int bh = it >> 4, sc = it & 15, b = bh >> 2, hd = bh & 3;
            gla::span<true, false>(lds, b * SEQ + sc * 256, 4, 64, hd, QK, Vb, AB, GA, P.in[10], P.in[11], P.in[12], sc ? DS + (size_t)(bh * 15 + sc - 1) * 32768 : nullptr,
                            sc == 15 ? out + OUT_GP + (size_t)bh * 32768 : nullptr, nullptr); }
    }
    SEAM(6);
    if (IN(7)) {
        pg8::Gemm g{AB, Wbr, 2048, 2048, D, 1024}; pg8::Sched S; S.init(MP, D, G, bx, 1);
        pg8::EpiMerge E{Gb, Gb, 0x7fffffff};
        skinny::EpiMerge Es{Gb};
        if (sk_early) skinny::phase<2, D / 256, false>(lds, AB, 2048, Wbr, 2048, 1024, nullptr, G, sk_piece, Es);
        pg8::gemm_phase(lds, g, S, E);
        if (!sk_early) skinny::phase<2, D / 256, false>(lds, AB, 2048, Wbr, 2048, 1024, nullptr, G, sk_piece, Es);
    }
    SEAM(7);
    if (IN(8)) {
        pg8::Gemm g{Gb, Wout, 2048, D, D, 0}; pg8::Sched S; S.init(MP, D, G, bx, 0);
        pg8::EpiResidual<true, false, true> E{XA, nullptr, nullptr, QK, ssq2, 1.0f};
        skinny::EpiResidual<true, false, true> Es{XA, nullptr, QK, 1.0f};
        if (sk_early) skinny::phase<1, D / 256, false>(lds, Gb, 2048, Wout, D, 0, ssq2, G, sk_piece, Es);
        pg8::gemm_phase(lds, g, S, E);
        if (!sk_early) skinny::phase<1, D / 256, false>(lds, Gb, 2048, Wout, D, 0, ssq2, G, sk_piece, Es);
    }
    SEAM(8);
    if (IN(9)) {
        pg8::Gemm g{QK, Wup2, D, D, D, 0}; pg8::Sched S; S.init(M, NUP, G, bx, 0);
        RSTD_TABLE_FILL(S, ssq2, false);
        pg8::EpiSwiglu E{Hb, rtab};
        if (split_conv) { CONVERT_ON_LIGHT(3, (M / 256) * (NUP / 256)); __syncthreads(); }
        pg8::gemm_phase(lds, g, S, E);
    }
    SEAM(9);
    const bool fuse_final = (G == 256) && IN(10) && IN(11);
    if (IN(10)) {
        pg8::Gemm g{Hb, Wdn2, FF, FF, FF, 0}; pg8::Sched S; S.init(MP, D, G, bx, 0);
        unsigned* xcnt = (unsigned*)(ws + WS_CTL) + 4096;
        if (fuse_final) {
            pg8::EpiFinal E{QK, out + OUT_Y, P.in[22], ssq3, xcnt, 0.5f};
            skinny::EpiResidual<true, false, false> Es{QK, nullptr, nullptr, 0.5f};
            if (sk_early) skinny::phase<1, FF / 256, true>(lds, Hb, FF, Wdn2, FF, 0, ssq3, G, sk_piece, Es, P.in[22], out + OUT_Y, xcnt + 64 * 64);
            pg8::gemm_phase(lds, g, S, E);
            if (!sk_early) { __syncthreads();
                skinny::phase<1, FF / 256, true>(lds, Hb, FF, Wdn2, FF, 0, ssq3, G, sk_piece, Es, P.in[22], out + OUT_Y, xcnt + 64 * 64); }
        } else {
            pg8::EpiResidual<true, true, false> E{QK, nullptr, X2F, nullptr, ssq3, 0.5f};
            pg8::gemm_phase(lds, g, S, E);
            skinny::EpiResidual<true, true, false> Es{QK, X2F, nullptr, 0.5f};
            skinny::phase<1, FF / 256, false>(lds, Hb, FF, Wdn2, FF, 0, ssq3, G, bx, Es);
        }
    }
    if (!fuse_final) SEAM(10);
    if (IN(11) && !fuse_final) {
        const float* fn = P.in[22];
        for (int m = gw; m < M; m += NGW) {
            const float rs = row_rstd(ssq3, m);
            const f32x4* xv = (const f32x4*)(X2F + (size_t)m * D) + lane; f32x4* yv = (f32x4*)(out + OUT_Y + (size_t)m * D) + lane;
#pragma unroll
            for (int j = 0; j < 4; ++j) { const f32x4 g4 = *((const f32x4*)fn + lane + 64 * j); yv[64 * j] = xv[64 * j] * rs * g4; }
        }
    }
#undef IN
#undef SEAM
}

#ifndef N_LAUNCHES
#define N_LAUNCHES 1
#endif
extern "C" void kernel_launch(void* const* d_in, const int* in_sizes, int n_in, void* d_out, int out_size, void* d_ws, size_t ws_size, hipStream_t stream) {
    static int grid = 0;
    if (grid == 0) {
        if (n_in != 23 || ws_size < WS_END) { fprintf(stderr, "kernel_launch: unexpected inputs (n_in %d, ws %zu)\n", n_in, ws_size); grid = -1; return; }
        int dev = 0, cus = 0;
        if (hipGetDevice(&dev) != hipSuccess || hipDeviceGetAttribute(&cus, hipDeviceAttributeMultiprocessorCount, dev) != hipSuccess) { grid = -1; return; }
        if (hipFuncSetAttribute((const void*)fwd_kernel, hipFuncAttributeMaxDynamicSharedMemorySize, LDS_BYTES) != hipSuccess) { fprintf(stderr, "kernel_launch: hipFuncSetAttribute failed\n"); grid = -1; return; }
        (void)hipGetLastError();
        grid = cus;
    }
    if (grid < 0) return;
    (void)hipMemsetAsync((char*)d_ws + WS_CTL, 0, CTL_ZERO_BYTES, stream);
    Params p{};
    for (int i = 0; i < 23; ++i) p.in[i] = (const float*)d_in[i];
    p.out = (float*)d_out; p.ws = (unsigned char*)d_ws;
    if (N_LAUNCHES == 1) { p.ph_lo = 0; p.ph_hi = 12; hipLaunchKernelGGL(fwd_kernel, dim3(grid), dim3(NTHREADS), LDS_BYTES, stream, p); }
    else for (int k = 0; k < 12; ++k) { p.ph_lo = k; p.ph_hi = k + 1; hipLaunchKernelGGL(fwd_kernel, dim3(grid), dim3(NTHREADS), LDS_BYTES, stream, p); }
}
```
